# Optimizing an MI355X kernel written in HIP

```python
import jax, jax.numpy as jnp
from jax import lax
import numpy as np

D_MODEL = 1024
BATCH = 1
SEQ = 16384
DEPTH = 2
DEC_BATCH = 2
DEC_SEQ = 16384
PAST_LEN = 128

PLE_DIM = 256
POOL_GROUPS = 4
POOL_GROUP_DIM = D_MODEL // 8
POOL_WIDTH = POOL_GROUPS * POOL_GROUP_DIM
POOL_WINDOWS = (2, 4, 8, 16)
RET_HEADS = 4
RET_DK = D_MODEL // 8
RET_DV = 2 * RET_DK
RET_QK_WIDTH = RET_HEADS * RET_DK
RET_V_WIDTH = RET_HEADS * RET_DV
N_BRANCHES = 2
CHUNK = 128
D_FF = -(-8 * D_MODEL // (3 * 256)) * 256
IN_WIDTH = POOL_WIDTH + 2 * RET_QK_WIDTH + 2 * RET_V_WIDTH + N_BRANCHES * D_MODEL
IN_SPLITS = (POOL_WIDTH,
             POOL_WIDTH + RET_QK_WIDTH,
             POOL_WIDTH + 2 * RET_QK_WIDTH,
             POOL_WIDTH + 2 * RET_QK_WIDTH + RET_V_WIDTH,
             POOL_WIDTH + 2 * RET_QK_WIDTH + 2 * RET_V_WIDTH)
ROPE_BASE = 10000.0
RMS_EPS = 1e-6
GN_EPS = 1e-5

kernel_name = "hybrid_pool_retention_encoder"


def rmsnorm(x, g):
    xf = x.astype(jnp.float32)
    y = xf * lax.rsqrt(jnp.mean(xf * xf, axis=-1, keepdims=True) + RMS_EPS)
    return (y * g.astype(jnp.float32)).astype(x.dtype)


def rotary(x, pos):
    half = x.shape[-1] // 2
    inv = 1.0 / (ROPE_BASE ** (jnp.arange(half, dtype=jnp.float32) / half))
    ang = pos.astype(jnp.float32)[:, None] * inv[None, :]
    cos = jnp.cos(ang)[None, :, None, :]
    sin = jnp.sin(ang)[None, :, None, :]
    x1, x2 = x[..., :half], x[..., half:]
    return jnp.concatenate([x1 * cos - x2 * sin, x1 * sin + x2 * cos], axis=-1)


def pool_mixer(xa, pool_w, pool_scale):
    B, L, _ = xa.shape
    xf = xa.astype(jnp.float32)
    cs = jnp.concatenate([jnp.zeros((B, 1, POOL_WIDTH), jnp.float32),
                          lax.cumsum(xf, axis=1)], axis=1)
    t = jnp.arange(L)
    outs = []
    for g, w in enumerate(POOL_WINDOWS):
        sl = slice(g * POOL_GROUP_DIM, (g + 1) * POOL_GROUP_DIM)
        lo = jnp.clip(t - w // 2, 0, L)
        hi = jnp.clip(t + w // 2, 0, L)
        csg = cs[..., sl]
        cnt = (hi - lo).astype(jnp.float32)[None, :, None]
        mean = (jnp.take(csg, hi, axis=1) - jnp.take(csg, lo, axis=1)) / cnt
        outs.append(jnp.einsum('blc,cd->bld', mean - xf[..., sl], pool_w[g].astype(jnp.float32)))
    y = jnp.concatenate(outs, axis=-1) * pool_scale.astype(jnp.float32)
    return y.astype(xa.dtype)


def retention_direction(q, k, v, log_g, inclusive):
    B, L, H, _ = q.shape
    N = L // CHUNK
    idx = jnp.arange(CHUNK, dtype=jnp.float32)
    diff = idx[:, None] - idx[None, :]
    mask = (diff >= 0) if inclusive else (diff > 0)
    dmask = jnp.where(mask[None], jnp.exp(log_g[:, None, None] * jnp.maximum(diff, 0.0)[None]), 0.0)
    q_decay = jnp.exp((idx[:, None] + 1.0) * log_g[None, :])[..., None]
    k_decay = jnp.exp((CHUNK - 1.0 - idx)[:, None] * log_g[None, :])[..., None]
    chunk_decay = jnp.exp(CHUNK * log_g)[None, :, None, None]

    def to_chunks(a):
        return a.reshape(B, N, CHUNK, H, a.shape[-1]).transpose(1, 0, 2, 3, 4)

    def step(S, inp):
        qc, kc, vc = inp
        scores = jnp.einsum('bihd,bjhd->bhij', qc, kc) * dmask[None]
        intra = jnp.einsum('bhij,bjhe->bihe', scores, vc)
        inter = jnp.einsum('bihd,bhde->bihe', qc * q_decay, S)
        S = S * chunk_decay + jnp.einsum('bjhd,bjhe->bhde', kc * k_decay, vc)
        return S, intra + inter

    S0 = jnp.zeros((B, H, q.shape[-1], v.shape[-1]), jnp.float32)
    _, ys = lax.scan(step, S0, (to_chunks(q), to_chunks(k), to_chunks(v)))
    return ys.transpose(1, 0, 2, 3, 4).reshape(B, L, H, v.shape[-1])


def retention_mixer(xq, xk, xv, xg, decay_logit):
    B, L, _ = xq.shape
    pos = jnp.arange(L)
    q = rotary(xq.astype(jnp.float32).reshape(B, L, RET_HEADS, RET_DK), pos)
    k = rotary(xk.astype(jnp.float32).reshape(B, L, RET_HEADS, RET_DK), pos) * (RET_DK ** -0.5)
    v = xv.astype(jnp.float32).reshape(B, L, RET_HEADS, RET_DV)
    log_g = jax.nn.log_sigmoid(decay_logit.astype(jnp.float32))
    fwd = retention_direction(q, k, v, log_g[0], True)
    bwd = jnp.flip(retention_direction(jnp.flip(q, 1), jnp.flip(k, 1), jnp.flip(v, 1), log_g[1], False), 1)
    y = fwd + bwd
    mu = jnp.mean(y, axis=-1, keepdims=True)
    yc = y - mu
    yn = yc * lax.rsqrt(jnp.mean(yc * yc, axis=-1, keepdims=True) + GN_EPS)
    out = yn.reshape(B, L, RET_V_WIDTH) * jax.nn.silu(xg.astype(jnp.float32))
    return out.astype(xq.dtype)


def layer(x, p_i, g_mix, w_in, pool_w, pool_scale, decay_logit, w_pool_out, w_ret_out, w_o,
          g_ffn, w_ffn_in, w_ffn_out, g_ple, w_ple_gate, w_ple_proj):
    B, L, D = x.shape
    h = rmsnorm(x, g_mix)
    z = jnp.einsum('bld,de->ble', h, w_in)
    xa, xq, xk, xv, xg, zgate = jnp.split(z, list(IN_SPLITS), axis=-1)
    a = jnp.einsum('blc,cd->bld', pool_mixer(xa, pool_w, pool_scale), w_pool_out)
    r = jnp.einsum('blc,cd->bld', retention_mixer(xq, xk, xv, xg, decay_logit), w_ret_out)
    gates = jax.nn.sigmoid(zgate.astype(jnp.float32)).reshape(B, L, N_BRANCHES, D).astype(x.dtype)
    merged = gates[:, :, 0, :] * a + gates[:, :, 1, :] * r
    x = x + jnp.einsum('bld,de->ble', merged, w_o)
    h2 = rmsnorm(x, g_ffn)
    gt, up = jnp.split(jnp.einsum('bld,df->blf', h2, w_ffn_in), 2, axis=-1)
    x = x + jnp.einsum('blf,fd->bld', jax.nn.silu(gt) * up, w_ffn_out)
    ple_gate = jax.nn.sigmoid(jnp.einsum('bld,de->ble', rmsnorm(x, g_ple), w_ple_gate).astype(jnp.float32)).astype(x.dtype)
    x = x + jnp.einsum('blp,pd->bld', p_i, w_ple_proj) * ple_gate
    return x


def trunk(x, p, g_mix, w_in, pool_w, pool_scale, decay_logit, w_pool_out, w_ret_out, w_o,
          g_ffn, w_ffn_in, w_ffn_out, g_ple, w_ple_gate, w_ple_proj, g_final):
    for i in range(DEPTH):
        x = layer(x, p[i], g_mix[i], w_in[i], pool_w[i], pool_scale[i], decay_logit[i],
                  w_pool_out[i], w_ret_out[i], w_o[i], g_ffn[i], w_ffn_in[i], w_ffn_out[i],
                  g_ple[i], w_ple_gate[i], w_ple_proj[i])
    return rmsnorm(x, g_final)


def setup_inputs(seed: int = 0) -> dict:
    key = jax.random.key(seed)
    ks = jax.random.split(key, 24)
    f32 = jnp.float32

    def nrm(k, shape, fan_in, scale=1.0):
        return jax.random.normal(k, shape, f32) * (scale * fan_in ** -0.5)

    def gain(k, shape):
        return 1.0 + 0.02 * jax.random.normal(k, shape, f32)

    base_logit = jnp.log(2.0 ** (5.0 + jnp.arange(RET_HEADS, dtype=f32)) - 1.0)
    decay_logit = base_logit[None, None, :] + 0.1 * jax.random.normal(ks[6], (DEPTH, 2, RET_HEADS), f32)
    return {
        "x_prompt": jax.random.normal(ks[0], (BATCH, SEQ, D_MODEL), f32),
        "x_sample": jax.random.normal(ks[1], (DEC_BATCH, DEC_SEQ, D_MODEL), f32),
        "p_prompt": jax.random.normal(ks[2], (DEPTH, BATCH, SEQ, PLE_DIM), f32),
        "p_sample": jax.random.normal(ks[3], (DEPTH, DEC_BATCH, DEC_SEQ, PLE_DIM), f32),
        "g_mix": gain(ks[4], (DEPTH, D_MODEL)),
        "w_in": nrm(ks[5], (DEPTH, D_MODEL, IN_WIDTH), D_MODEL),
        "pool_w": nrm(ks[7], (DEPTH, POOL_GROUPS, POOL_GROUP_DIM, POOL_GROUP_DIM), POOL_GROUP_DIM),
        "pool_scale": gain(ks[8], (DEPTH, POOL_WIDTH)),
        "decay_logit": decay_logit,
        "w_pool_out": nrm(ks[9], (DEPTH, POOL_WIDTH, D_MODEL), POOL_WIDTH),
        "w_ret_out": nrm(ks[10], (DEPTH, RET_V_WIDTH, D_MODEL), RET_V_WIDTH),
        "w_o": nrm(ks[11], (DEPTH, D_MODEL, D_MODEL), D_MODEL, 0.5),
        "g_ffn": gain(ks[12], (DEPTH, D_MODEL)),
        "w_ffn_in": nrm(ks[13], (DEPTH, D_MODEL, 2 * D_FF), D_MODEL),
        "w_ffn_out": nrm(ks[14], (DEPTH, D_FF, D_MODEL), D_FF, 0.5),
        "g_ple": gain(ks[15], (DEPTH, D_MODEL)),
        "w_ple_gate": nrm(ks[16], (DEPTH, D_MODEL, D_MODEL), D_MODEL),
        "w_ple_proj": nrm(ks[17], (DEPTH, PLE_DIM, D_MODEL), PLE_DIM, 0.5),
        "g_final": gain(ks[18], (D_MODEL,)),
    }


def reference(x_prompt, x_sample, p_prompt, p_sample, g_mix, w_in, pool_w, pool_scale, decay_logit,
              w_pool_out, w_ret_out, w_o, g_ffn, w_ffn_in, w_ffn_out, g_ple, w_ple_gate, w_ple_proj,
              g_final):
    y_prompt = trunk(x_prompt, p_prompt, g_mix, w_in, pool_w, pool_scale, decay_logit, w_pool_out,
                     w_ret_out, w_o, g_ffn, w_ffn_in, w_ffn_out, g_ple, w_ple_gate, w_ple_proj, g_final)
    y_sample = trunk(x_sample, p_sample, g_mix, w_in, pool_w, pool_scale, decay_logit, w_pool_out,
                     w_ret_out, w_o, g_ffn, w_ffn_in, w_ffn_out, g_ple, w_ple_gate, w_ple_proj, g_final)
    return (y_prompt, y_sample)
```

```cpp
#include <hip/hip_runtime.h>
#include <hip/hip_cooperative_groups.h>
#include <cstdio>
namespace cg = cooperative_groups;

#ifndef SLOW_TR
#define SLOW_TR 0
#endif
#ifndef REP_MASK
#define REP_MASK 0
#endif
#ifndef MULTI_LAUNCH
#define MULTI_LAUNCH 0
#endif

#define LAS __attribute__((address_space(3)))
typedef unsigned short bf16_t;
typedef short bf16x8 __attribute__((ext_vector_type(8)));
typedef short s16x4 __attribute__((ext_vector_type(4)));
typedef float f32x4 __attribute__((ext_vector_type(4)));
typedef unsigned u32x4 __attribute__((ext_vector_type(4)));
typedef unsigned u32x2 __attribute__((ext_vector_type(2)));

constexpr int SEQ = 16384, DM = 1024, INW = 5632, DFF = 2816, PLE = 256;
constexpr int NPH = 58;
constexpr size_t W_IN = 0, W_PO = W_IN + (size_t)INW * DM * 2, W_RO = W_PO + (size_t)DM * 512 * 2, W_O = W_RO + (size_t)DM * DM * 2,
                 W_FFI = W_O + (size_t)DM * DM * 2, W_FFO = W_FFI + (size_t)INW * DM * 2, W_PG = W_FFO + (size_t)DM * DFF * 2,
                 W_PP = W_PG + (size_t)DM * DM * 2, W_PW = W_PP + (size_t)DM * PLE * 2, W_LAYER = W_PW + (size_t)4 * 128 * 128 * 2;
constexpr size_t WS_W = 0, WS_COS = WS_W + 2 * W_LAYER, WS_SIN = WS_COS + (size_t)SEQ * 64 * 4, WS_XB = WS_SIN + (size_t)SEQ * 64 * 4,
                 WS_SS = WS_XB + 2 * (size_t)SEQ * DM * 2, WS_Z = WS_SS + 2 * (size_t)SEQ * 16 * 4, WS_KV = WS_Z + (size_t)SEQ * INW * 2,
                 WS_PA = WS_KV + (size_t)128 * 4 * 2 * 256 * 128 * 2, WS_RG = WS_PA + (size_t)SEQ * 512 * 2, WS_PB = WS_RG + (size_t)SEQ * DM * 2,
                 WS_END = WS_PB + 2 * (size_t)SEQ * PLE * 2;
constexpr size_t WS_PROJ = WS_END + 16384, WS_END2 = WS_PROJ + (size_t)SEQ * DM * 2;
constexpr int LDS_BYTES = 147456;

typedef float f32x2_t __attribute__((ext_vector_type(2)));
typedef __bf16 bf16x2_t __attribute__((ext_vector_type(2)));
__device__ __forceinline__ unsigned cvt_pk_bf16(float lo, float hi) { const f32x2_t v = {lo, hi}; return __builtin_bit_cast(unsigned, __builtin_convertvector(v, bf16x2_t)); }
__device__ __forceinline__ float bf_lo(unsigned u) { return __uint_as_float(u << 16); }
__device__ __forceinline__ float bf_hi(unsigned u) { return __uint_as_float(u & 0xffff0000u); }
__device__ __forceinline__ float sigmoid_f(float x) { return __builtin_amdgcn_rcpf(1.0f + __expf(-x)); }
__device__ __forceinline__ float sigmoid_sc(float v, float nrl) { return __builtin_amdgcn_rcpf(1.0f + __builtin_amdgcn_exp2f(v * nrl)); }
__device__ __forceinline__ float silu_f(float x) { return x * sigmoid_f(x); }
__device__ __forceinline__ u32x2 pack4(f32x4 v) { u32x2 w; w.x = cvt_pk_bf16(v[0], v[1]); w.y = cvt_pk_bf16(v[2], v[3]); return w; }
__device__ __forceinline__ u32x4 pack8(f32x4 a, f32x4 b) { u32x4 w; w.x = cvt_pk_bf16(a[0], a[1]); w.y = cvt_pk_bf16(a[2], a[3]); w.z = cvt_pk_bf16(b[0], b[1]); w.w = cvt_pk_bf16(b[2], b[3]); return w; }
__device__ __forceinline__ f32x4 unpack_lo4(u32x4 w) { return (f32x4){bf_lo(w.x), bf_hi(w.x), bf_lo(w.y), bf_hi(w.y)}; }
__device__ __forceinline__ f32x4 unpack_hi4(u32x4 w) { return (f32x4){bf_lo(w.z), bf_hi(w.z), bf_lo(w.w), bf_hi(w.w)}; }
__device__ __forceinline__ f32x4 unpack4(u32x2 w) { return (f32x4){bf_lo(w.x), bf_hi(w.x), bf_lo(w.y), bf_hi(w.y)}; }
__device__ __forceinline__ float log2g(const float* logit) {
    const float x = *logit, u = __expf(-x);
    float l = u * (1.f - u * (0.5f - u * (0.33333334f - u * (0.25f - u * (0.2f - u * 0.16666667f)))));
    if (u > 0.0625f) l = __logf(1.0f + u);
    return -l * 1.4426950408889634f;
}
__device__ __forceinline__ float rstd_from_ss(const float* ss) {
    const f32x4* sp = (const f32x4*)ss; const f32x4 a = sp[0], b = sp[1], c = sp[2], d = sp[3];
    const f32x4 t = (a + b) + (c + d); const float s = (t[0] + t[1]) + (t[2] + t[3]);
    return __builtin_amdgcn_rsqf(s * (1.0f / 1024.0f) + 1e-6f);
}

__device__ __forceinline__ float shx(float v, int lane, int m) { return __int_as_float(__builtin_amdgcn_ds_bpermute((lane ^ m) << 2, __float_as_int(v))); }
__device__ __forceinline__ int lane_now() { int l; asm volatile("v_mbcnt_lo_u32_b32 %0, -1, 0\n\tv_mbcnt_hi_u32_b32 %0, -1, %0" : "=v"(l)); return l; }
namespace pg8 {
constexpr int BM = 256, BK = 64, HALF = 128, HTB = HALF * BK * 2, STAGE_BYTES = 8 * HTB, NXCD = 8, WGM = 8;
__host__ __device__ __forceinline__ int lds_byte(int r, int c) { const int st = (r >> 4) * 2 + (c >> 5), rr = r & 15, cc = c & 31, ob = rr * 64 + cc * 2; return st * 1024 + (ob ^ (((ob >> 9) & 1) << 5)); }
__host__ __device__ __forceinline__ void stage_rc(int b, int& R, int& C) { const int st = b / 1024, sb = b % 1024, swz = sb ^ (((sb >> 9) & 1) << 5); R = (st >> 1) * 16 + swz / 64; C = (st & 1) * 32 + (swz % 64) / 2; }
__host__ __device__ __forceinline__ int perm32(int rho) { const int n = rho >> 4, i = rho & 15; return 8 * (i >> 2) + 4 * n + (i & 3); }
struct Unit { int pm, pn; };
struct Gemm { const bf16_t* A; const bf16_t* Bt; int M, N, K; };
struct StaticOrder {
    int nM, nN, nwg, G, c, rot;
    __device__ void init(int M, int N, int G_, int c_, int rot_ = 0) { nM = M / BM; nN = N / BM; nwg = nM * nN; G = G_; c = c_; rot = rot_; }
    __device__ bool next(int i, Unit& u) const {
        const long L = (long)i * G + c; if (L >= nwg) return false;
        int wgid = (int)L; { const int q = nwg / NXCD, r = nwg % NXCD, xcd = wgid % NXCD, off = wgid / NXCD; wgid = (xcd < r ? xcd * (q + 1) : r * (q + 1) + (xcd - r) * q) + off; }
        const int nig = WGM * nN, gid = wgid / nig, fm = gid * WGM, gsz = (nM - fm) < WGM ? (nM - fm) : WGM;
        u.pm = fm + ((wgid % nig) % gsz); { const int p = (wgid % nig) / gsz + rot; u.pn = p >= nN ? p - nN : p; } return true;
    }
};
template <class Epi>
__device__ __forceinline__ void gemm_phase(const int tid, LAS unsigned char* lds, const Gemm g, const StaticOrder& S, const Epi& E) {
    const int wid = __builtin_amdgcn_readfirstlane(tid >> 6), lane = tid & 63, wr = wid >> 2, wc = wid & 3, fr = lane & 15, fq = lane >> 4;
    const int K = g.K, nt = K / BK;
    unsigned voffA[2], voffB[2];
#pragma unroll
    for (int i = 0; i < 2; ++i) { int R, C; stage_rc(tid * 16 + i * 8192, R, C); const int Rb = Epi::PERM ? ((R & ~31) + perm32(R & 31)) : R;
        voffA[i] = (unsigned)(R * K + C) * 2u; voffB[i] = (unsigned)(Rb * K + C) * 2u; }
    const size_t kstep = (size_t)(BK * 2);
    const size_t hstep = (size_t)HALF * K * 2;
    const size_t tstep = 2 * hstep;
    const unsigned ldsw = (unsigned)wid * 1024u;
    const int aoff = lds_byte(wr * 64 + fr, fq * 8), boff = lds_byte(wc * 32 + fr, fq * 8);
#define PG8_SA(b, h) (((b) * 2 + (h)) * HTB)
#define PG8_SB(b, h) ((4 + (b) * 2 + (h)) * HTB)
#define PG8_STAGE(bufoff, gbase, voff) do { _Pragma("unroll") for (int _i = 0; _i < 2; ++_i) { unsigned _vo = (voff)[_i]; asm volatile("" : "+v"(_vo)); \
        __builtin_amdgcn_global_load_lds((const unsigned*)((const char*)(gbase) + _vo), (LAS unsigned*)(lds + (bufoff) + ldsw + _i * 8192), 16, 0, 0); } } while (0)
#define PG8_LDA(dst, b, h) do { _Pragma("unroll") for (int m = 0; m < 4; ++m) _Pragma("unroll") for (int k = 0; k < 2; ++k) dst[m][k] = *(const LAS bf16x8*)(lds + PG8_SA(b, h) + aoff + m * 2048 + k * 1024); } while (0)
#define PG8_LDB(dst, b, h) do { _Pragma("unroll") for (int n = 0; n < 2; ++n) _Pragma("unroll") for (int k = 0; k < 2; ++k) dst[n][k] = *(const LAS bf16x8*)(lds + PG8_SB(b, h) + boff + n * 2048 + k * 1024); } while (0)
#define PG8_MMA(ai, bj, At, Bt) do { __builtin_amdgcn_s_setprio(1); _Pragma("unroll") for (int m = 0; m < 4; ++m) _Pragma("unroll") for (int n = 0; n < 2; ++n) _Pragma("unroll") for (int k = 0; k < 2; ++k) \
        acc[ai][bj][m][n] = __builtin_amdgcn_mfma_f32_16x16x32_bf16(Bt[n][k], At[m][k], acc[ai][bj][m][n], 0, 0, 0); __builtin_amdgcn_s_setprio(0); } while (0)
#define PG8_WAIT_V(n) asm volatile("s_waitcnt vmcnt(" #n ")" ::: "memory")
#define PG8_WAIT_L(n) asm volatile("s_waitcnt lgkmcnt(" #n ")" ::: "memory")
#define PG8_BAR __builtin_amdgcn_s_barrier()
#define PG8_SCHED __builtin_amdgcn_sched_barrier(0)
    Unit cur, nxt; int ui = 0;
    if (!S.next(0, cur)) return;
    f32x4 acc[2][2][4][2];
#pragma unroll
    for (int a = 0; a < 2; ++a)
#pragma unroll
        for (int b = 0; b < 2; ++b)
#pragma unroll
            for (int m = 0; m < 4; ++m)
#pragma unroll
                for (int n = 0; n < 2; ++n) acc[a][b][m][n] = (f32x4){0.f, 0.f, 0.f, 0.f};
    bf16x8 At[4][2], B0[2][2], B1[2][2];
    const char* cA = (const char*)g.A + (size_t)cur.pm * tstep; const char* cB = (const char*)g.Bt + (size_t)cur.pn * tstep;
    PG8_STAGE(PG8_SB(0, 0), cB, voffB); PG8_STAGE(PG8_SA(0, 0), cA, voffA); PG8_STAGE(PG8_SB(0, 1), cB + hstep, voffB); PG8_STAGE(PG8_SA(0, 1), cA + hstep, voffA);
    if (wr == 1) PG8_BAR;
    PG8_WAIT_V(4); PG8_BAR;
    PG8_STAGE(PG8_SB(1, 0), cB + kstep, voffB); PG8_STAGE(PG8_SA(1, 0), cA + kstep, voffA); PG8_STAGE(PG8_SB(1, 1), cB + hstep + kstep, voffB);
    PG8_WAIT_V(6); PG8_BAR;
    for (;;) {
        const bool has_next = S.next(ui + 1, nxt);
        const char* nA = has_next ? (const char*)g.A + (size_t)nxt.pm * tstep : cA; const char* nB = has_next ? (const char*)g.Bt + (size_t)nxt.pn * tstep : cB;
        for (int t = 0; t < nt; t += 2) {
            const bool last = (t == nt - 2);
            const char* a1 = cA + (size_t)(t + 1) * kstep;
            const char* a2 = last ? nA : cA + (size_t)(t + 2) * kstep; const char* b2 = last ? nB : cB + (size_t)(t + 2) * kstep;
            const char* a3 = a2 + kstep; const char* b3 = b2 + kstep;
            PG8_LDB(B0, 0, 0); PG8_SCHED; PG8_LDA(At, 0, 0); PG8_STAGE(PG8_SA(1, 1), a1 + hstep, voffA);
            PG8_WAIT_L(8); PG8_BAR; PG8_WAIT_L(0); PG8_MMA(0, 0, At, B0); PG8_BAR; PG8_SCHED;
            PG8_LDB(B1, 0, 1); PG8_STAGE(PG8_SB(0, 0), b2, voffB);
            PG8_BAR; PG8_WAIT_L(0); PG8_MMA(0, 1, At, B1); PG8_BAR;
            PG8_LDA(At, 0, 1); PG8_STAGE(PG8_SA(0, 0), a2, voffA);
            PG8_BAR; PG8_WAIT_L(0); PG8_MMA(1, 0, At, B0); PG8_BAR; PG8_SCHED;
            PG8_STAGE(PG8_SB(0, 1), b2 + hstep, voffB);
            PG8_WAIT_V(6); PG8_BAR; PG8_MMA(1, 1, At, B1); PG8_BAR;
            PG8_LDB(B0, 1, 0); PG8_SCHED; PG8_LDA(At, 1, 0); PG8_STAGE(PG8_SA(0, 1), a2 + hstep, voffA);
            PG8_WAIT_L(8); PG8_BAR; PG8_WAIT_L(0); PG8_MMA(0, 0, At, B0); PG8_BAR; PG8_SCHED;
            PG8_LDB(B1, 1, 1); PG8_STAGE(PG8_SB(1, 0), b3, voffB);
            PG8_BAR; PG8_WAIT_L(0); PG8_MMA(0, 1, At, B1); PG8_BAR;
            PG8_LDA(At, 1, 1); PG8_STAGE(PG8_SA(1, 0), a3, voffA);
            PG8_BAR; PG8_WAIT_L(0); PG8_MMA(1, 0, At, B0); PG8_BAR; PG8_SCHED;
            PG8_STAGE(PG8_SB(1, 1), b3 + hstep, voffB);
            PG8_WAIT_V(6); PG8_BAR; PG8_MMA(1, 1, At, B1); PG8_BAR;
        }
        E(acc, cur, wr, wc, fr, fq);
        if (!has_next) break;
#pragma unroll
        for (int a = 0; a < 2; ++a)
#pragma unroll
            for (int b = 0; b < 2; ++b)
#pragma unroll
                for (int m = 0; m < 4; ++m)
#pragma unroll
                    for (int n = 0; n < 2; ++n) acc[a][b][m][n] = (f32x4){0.f, 0.f, 0.f, 0.f};
        cur = nxt; cA = nA; cB = nB; ++ui;
    }
    PG8_WAIT_V(0);
    if (wr == 0) PG8_BAR;
    PG8_BAR;
#undef PG8_SA
#undef PG8_SB
#undef PG8_STAGE
#undef PG8_LDA
#undef PG8_LDB
#undef PG8_MMA
#undef PG8_WAIT_V
#undef PG8_WAIT_L
#undef PG8_BAR
#undef PG8_SCHED
}
}
using pg8::Unit;

__device__ __forceinline__ void load_rstd8(const float* SS, int row0, int fr, int fq, float (&rstd)[8]) {
    const int ln = fq * 16 + fr;
    f32x4 q[8];
    const float* p0 = SS + (size_t)row0 * 16 + fq * 4;
#pragma unroll
    for (int i = 0; i < 8; ++i) q[i] = *(const f32x4*)(p0 + ((i >> 2) * 128 + (i & 3) * 16) * 16);
#pragma unroll
    for (int i = 0; i < 8; ++i) { float s = (q[i][0] + q[i][1]) + (q[i][2] + q[i][3]); s += shx(s, ln, 16); s += shx(s, ln, 32); rstd[i] = __builtin_amdgcn_rsqf(s * (1.0f / 1024.0f) + 1e-6f); }
}

struct EpiZ {
    static constexpr bool PERM = true;
    bf16_t* Z; const float* SS; const float* COS; const float* SIN;
    __device__ __forceinline__ void operator()(const f32x4 (&acc)[2][2][4][2], const Unit& u, int wr, int wc, int fr, int fq) const {
        { const int l_ = lane_now(); fr = l_ & 15; fq = l_ >> 4; }
        const int row0 = u.pm * 256 + wr * 64 + fr, pn = u.pn, colw = wc * 32 + 8 * fq;
        float rs[8]; load_rstd8(SS, row0, fr, fq, rs);
#pragma unroll
        for (int ai = 0; ai < 2; ++ai)
#pragma unroll
            for (int m = 0; m < 4; ++m) {
                const int row = row0 + ai * 128 + m * 16;
                const float rstd = rs[ai * 4 + m];
                bf16_t* rowp = Z + (size_t)row * INW + pn * 256 + colw;
                if (pn >= 2 && pn < 6) {
                    const int i1 = 16 * wc + 4 * fq;
                    const f32x4 cs = *(const f32x4*)(COS + (size_t)row * 64 + i1), sn = *(const f32x4*)(SIN + (size_t)row * 64 + i1);
                    const float sc = rstd * (pn >= 4 ? 0.08838834764831845f : 1.0f);
#pragma unroll
                    for (int bj = 0; bj < 2; ++bj) {
                        const f32x4 x1 = acc[ai][bj][m][0] * sc, x2 = acc[ai][bj][m][1] * sc;
                        const f32x4 o1 = x1 * cs - x2 * sn, o2 = x1 * sn + x2 * cs;
                        *(u32x4*)(rowp + bj * 128) = pack8(o1, o2);
                    }
                } else {
#pragma unroll
                    for (int bj = 0; bj < 2; ++bj) {
                        f32x4 v0 = acc[ai][bj][m][0], v1 = acc[ai][bj][m][1];
                        const float nrl = rstd * -1.4426950408889634f;
                        if (pn >= 14) {
#pragma unroll
                            for (int j = 0; j < 4; ++j) { v0[j] = sigmoid_sc(v0[j], nrl); v1[j] = sigmoid_sc(v1[j], nrl); }
                        } else if (pn >= 10) {
#pragma unroll
                            for (int j = 0; j < 4; ++j) { v0[j] = v0[j] * rstd * sigmoid_sc(v0[j], nrl); v1[j] = v1[j] * rstd * sigmoid_sc(v1[j], nrl); }
                        } else { v0 = v0 * rstd; v1 = v1 * rstd; }
                        *(u32x4*)(rowp + bj * 128) = pack8(v0, v1);
                    }
                }
            }
    }
};
struct EpiSwiGLU {
    static constexpr bool PERM = true;
    bf16_t* ACT; const float* SS;
    __device__ __forceinline__ void operator()(const f32x4 (&acc)[2][2][4][2], const Unit& u, int wr, int wc, int fr, int fq) const {
        { const int l_ = lane_now(); fr = l_ & 15; fq = l_ >> 4; }
        const int row0 = u.pm * 256 + wr * 64 + fr, col = u.pn * 128 + wc * 32 + 8 * fq;
        float rs[8]; load_rstd8(SS, row0, fr, fq, rs);
#pragma unroll
        for (int ai = 0; ai < 2; ++ai)
#pragma unroll
            for (int m = 0; m < 4; ++m) {
                const int row = row0 + ai * 128 + m * 16;
                const float rstd = rs[ai * 4 + m];
                f32x4 o[2];
                const float r2 = rstd * rstd, nrl = rstd * -1.4426950408889634f;
#pragma unroll
                for (int n = 0; n < 2; ++n) { const f32x4 gt = acc[ai][0][m][n], up = acc[ai][1][m][n];
#pragma unroll
                    for (int j = 0; j < 4; ++j) o[n][j] = (gt[j] * up[j]) * (r2 * sigmoid_sc(gt[j], nrl)); }
                *(u32x4*)(ACT + (size_t)row * DFF + col) = pack8(o[0], o[1]);
            }
    }
};
template <int MODE> struct EpiGen {
    static constexpr bool PERM = true;
    bf16_t* O; const bf16_t* T; const bf16_t* G; const float* SS;
    __device__ __forceinline__ void operator()(const f32x4 (&acc)[2][2][4][2], const Unit& u, int wr, int wc, int fr, int fq) const {
        { const int l_ = lane_now(); fr = l_ & 15; fq = l_ >> 4; }
        const int row0 = u.pm * 256 + wr * 64 + fr, col0 = u.pn * 256 + wc * 32 + 8 * fq;
        if (MODE == 2) {
            float rs[8]; load_rstd8(SS, row0, fr, fq, rs);
#pragma unroll
            for (int rg = 0; rg < 8; ++rg) {
                const int ai = rg >> 2, m = rg & 3, row = row0 + ai * 128 + m * 16; const float rstd = rs[rg];
#pragma unroll
                for (int bj = 0; bj < 2; ++bj) {
                    f32x4 v0 = acc[ai][bj][m][0], v1 = acc[ai][bj][m][1];
#pragma unroll
                    for (int j = 0; j < 4; ++j) { v0[j] = sigmoid_sc(v0[j], rstd * -1.4426950408889634f); v1[j] = sigmoid_sc(v1[j], rstd * -1.4426950408889634f); }
                    *(u32x4*)(O + (size_t)row * DM + col0 + bj * 128) = pack8(v0, v1);
                }
            }
        } else {
            constexpr int NB = (MODE == 1) ? 2 : 1, RGP = 8 / NB;
#pragma unroll
            for (int b = 0; b < NB; ++b) {
                u32x4 gw[RGP][2], tw[RGP][2];
#pragma unroll
                for (int q = 0; q < RGP; ++q)
#pragma unroll
                    for (int bj = 0; bj < 2; ++bj) {
                        const int rg = b * RGP + q, row = row0 + (rg >> 2) * 128 + (rg & 3) * 16, col = col0 + bj * 128;
                        gw[q][bj] = *(const u32x4*)(G + (size_t)row * INW + col);
                        if (MODE == 1) tw[q][bj] = *(const u32x4*)(T + (size_t)row * DM + col);
                    }
#pragma unroll
                for (int q = 0; q < RGP; ++q)
#pragma unroll
                    for (int bj = 0; bj < 2; ++bj) {
                        const int rg = b * RGP + q, ai = rg >> 2, m = rg & 3, row = row0 + ai * 128 + m * 16, col = col0 + bj * 128;
                        f32x4 v0 = acc[ai][bj][m][0] * unpack_lo4(gw[q][bj]), v1 = acc[ai][bj][m][1] * unpack_hi4(gw[q][bj]);
                        if (MODE == 1) { v0 = v0 + unpack_lo4(tw[q][bj]); v1 = v1 + unpack_hi4(tw[q][bj]); }
                        *(u32x4*)(O + (size_t)row * DM + col) = pack8(v0, v1);
                    }
                asm volatile("" ::: "memory");
            }
        }
    }
};
template <bool MUL, bool SRC32> struct EpiResid {
    static constexpr bool PERM = true;
    const float* x32; const bf16_t* xb; bf16_t* XBo; float* SSo; const bf16_t* T;
    __device__ __forceinline__ void operator()(const f32x4 (&acc)[2][2][4][2], const Unit& u, int wr, int wc, int fr, int fq) const {
        { const int l_ = lane_now(); fr = l_ & 15; fq = l_ >> 4; }
        const int row0 = u.pm * 256 + wr * 64 + fr, col0 = u.pn * 256 + wc * 32 + 8 * fq;
        constexpr int NB = SRC32 ? 4 : (MUL ? 2 : 1), RG_PER = 8 / NB;
#pragma unroll
        for (int b = 0; b < NB; ++b) {
            f32x4 xr[RG_PER][2][2]; u32x4 xw[RG_PER][2], tw[RG_PER][2];
#pragma unroll
            for (int q = 0; q < RG_PER; ++q)
#pragma unroll
                for (int bj = 0; bj < 2; ++bj) {
                    const int rg = b * RG_PER + q;
                    const size_t off = (size_t)(row0 + (rg >> 2) * 128 + (rg & 3) * 16) * DM + col0 + bj * 128;
                    if (SRC32) { xr[q][bj][0] = *(const f32x4*)(x32 + off); xr[q][bj][1] = *(const f32x4*)(x32 + off + 4); } else xw[q][bj] = *(const u32x4*)(xb + off);
                    if (MUL) tw[q][bj] = *(const u32x4*)(T + off);
                }
#pragma unroll
            for (int q = 0; q < RG_PER; ++q) {
                const int rg = b * RG_PER + q, ai = rg >> 2, m = rg & 3, row = row0 + ai * 128 + m * 16;
                float ss = 0.f;
#pragma unroll
                for (int bj = 0; bj < 2; ++bj) {
                    const size_t off = (size_t)row * DM + col0 + bj * 128;
                    f32x4 v0 = acc[ai][bj][m][0], v1 = acc[ai][bj][m][1];
                    if (MUL) { v0 = v0 * unpack_lo4(tw[q][bj]); v1 = v1 * unpack_hi4(tw[q][bj]); }
                    if (SRC32) { v0 = v0 + xr[q][bj][0]; v1 = v1 + xr[q][bj][1]; } else { v0 = v0 + unpack_lo4(xw[q][bj]); v1 = v1 + unpack_hi4(xw[q][bj]); }
                    *(u32x4*)(XBo + off) = pack8(v0, v1);
                    ss += (v0[0] * v0[0] + v0[1] * v0[1]) + (v0[2] * v0[2] + v0[3] * v0[3]) + (v1[0] * v1[0] + v1[1] * v1[1]) + (v1[2] * v1[2] + v1[3] * v1[3]);
                }
                { const int ln = fq * 16 + fr; ss += shx(ss, ln, 16); ss += shx(ss, ln, 32); }
                if (fq == 0) SSo[(size_t)row * 16 + u.pn * 4 + wc] = ss;
            }
            asm volatile("" ::: "memory");
        }
    }
};

struct EpiStore {
    static constexpr bool PERM = true;
    bf16_t* O;
    __device__ __forceinline__ void operator()(const f32x4 (&acc)[2][2][4][2], const Unit& u, int wr, int wc, int fr, int fq) const {
        { const int l_ = lane_now(); fr = l_ & 15; fq = l_ >> 4; }
        const int row0 = u.pm * 256 + wr * 64 + fr, col0 = u.pn * 256 + wc * 32 + 8 * fq;
#pragma unroll
        for (int ai = 0; ai < 2; ++ai)
#pragma unroll
            for (int m = 0; m < 4; ++m)
#pragma unroll
                for (int bj = 0; bj < 2; ++bj)
                    *(u32x4*)(O + (size_t)(row0 + ai * 128 + m * 16) * DM + col0 + bj * 128) = pack8(acc[ai][bj][m][0], acc[ai][bj][m][1]);
    }
};
struct EpiPle {
    static constexpr bool PERM = true;
    const bf16_t* xb; bf16_t* XBo; float* SSo; const bf16_t* PJ; const float* SS;
    __device__ __forceinline__ void operator()(const f32x4 (&acc)[2][2][4][2], const Unit& u, int wr, int wc, int fr, int fq) const {
        { const int l_ = lane_now(); fr = l_ & 15; fq = l_ >> 4; }
        const int row0 = u.pm * 256 + wr * 64 + fr, col0 = u.pn * 256 + wc * 32 + 8 * fq;
        float rs[8]; load_rstd8(SS, row0, fr, fq, rs);
#pragma unroll
        for (int b = 0; b < 2; ++b) {
            u32x4 xw[4][2], pw[4][2];
#pragma unroll
            for (int q = 0; q < 4; ++q)
#pragma unroll
                for (int bj = 0; bj < 2; ++bj) { const size_t off = (size_t)(row0 + b * 128 + q * 16) * DM + col0 + bj * 128; xw[q][bj] = *(const u32x4*)(xb + off); pw[q][bj] = *(const u32x4*)(PJ + off); }
#pragma unroll
            for (int q = 0; q < 4; ++q) {
                const int row = row0 + b * 128 + q * 16; const float nrl = rs[b * 4 + q] * -1.4426950408889634f;
                float ss = 0.f;
#pragma unroll
                for (int bj = 0; bj < 2; ++bj) {
                    const size_t off = (size_t)row * DM + col0 + bj * 128;
                    f32x4 v0 = acc[b][bj][q][0], v1 = acc[b][bj][q][1];
#pragma unroll
                    for (int j = 0; j < 4; ++j) { v0[j] = sigmoid_sc(v0[j], nrl); v1[j] = sigmoid_sc(v1[j], nrl); }
                    v0 = v0 * unpack_lo4(pw[q][bj]) + unpack_lo4(xw[q][bj]); v1 = v1 * unpack_hi4(pw[q][bj]) + unpack_hi4(xw[q][bj]);
                    *(u32x4*)(XBo + off) = pack8(v0, v1);
                    ss += (v0[0] * v0[0] + v0[1] * v0[1]) + (v0[2] * v0[2] + v0[3] * v0[3]) + (v1[0] * v1[0] + v1[1] * v1[1]) + (v1[2] * v1[2] + v1[3] * v1[3]);
                }
                { const int ln = fq * 16 + fr; ss += shx(ss, ln, 16); ss += shx(ss, ln, 32); }
                if (fq == 0) SSo[(size_t)row * 16 + u.pn * 4 + wc] = ss;
            }
            asm volatile("" ::: "memory");
        }
    }
};

struct Params { const float* in[19]; float* out; unsigned char* ws; int ph_lo, ph_hi; };
typedef const __attribute__((address_space(4))) Params* KPtr;
struct Ctx {
    KPtr P; float* out; unsigned char* ws; int wv, bid, G;
    __device__ __forceinline__ int ftid() const { return wv * 64 + lane_now(); }
    __device__ __forceinline__ bf16_t* W(int layer, size_t off) const { return (bf16_t*)(ws + WS_W + (size_t)layer * W_LAYER + off); }
    __device__ __forceinline__ float* COS() const { return (float*)(ws + WS_COS); }
    __device__ __forceinline__ float* SIN() const { return (float*)(ws + WS_SIN); }
    __device__ __forceinline__ bf16_t* XB(int i) const { return (bf16_t*)(ws + WS_XB + (size_t)i * SEQ * DM * 2); }
    __device__ __forceinline__ float* SS(int i) const { return (float*)(ws + WS_SS + (size_t)i * SEQ * 16 * 4); }
    __device__ __forceinline__ bf16_t* Z() const { return (bf16_t*)(ws + WS_Z); }
    __device__ __forceinline__ bf16_t* KV() const { return (bf16_t*)(ws + WS_KV); }
    __device__ __forceinline__ bf16_t* TMP() const { return (bf16_t*)(ws + WS_KV); }
    __device__ __forceinline__ bf16_t* MG() const { return (bf16_t*)(ws + WS_KV + (size_t)SEQ * DM * 2); }
    __device__ __forceinline__ bf16_t* PA() const { return (bf16_t*)(ws + WS_PA); }
    __device__ __forceinline__ bf16_t* RG() const { return (bf16_t*)(ws + WS_RG); }
    __device__ __forceinline__ bf16_t* PROJ() const { return (bf16_t*)(ws + WS_PROJ); }
    __device__ __forceinline__ bf16_t* PB(int layer) const { return (bf16_t*)(ws + WS_PB + (size_t)layer * SEQ * PLE * 2); }
    __device__ __forceinline__ const float* xin(int s) const { return s == 0 ? P->in[0] : P->in[1] + (size_t)(s - 1) * SEQ * DM; }
    __device__ __forceinline__ const float* pin(int s, int layer) const { return s == 0 ? P->in[2] + (size_t)layer * SEQ * PLE : P->in[3] + (size_t)(layer * 2 + (s - 1)) * SEQ * PLE; }
    __device__ __forceinline__ float* xout(int s) const { return out + (size_t)s * SEQ * DM; }
};

__device__ __forceinline__ int dperm(int c) { return ((c >> 2) & 1) * 64 + 16 * (c >> 5) + 4 * ((c >> 3) & 3) + (c & 3); }
struct MatDesc { const float* W; int ldw, K, N; bf16_t* out; const float* gk; const float* gn; int cm; };
__device__ __forceinline__ MatDesc mat_desc(const Ctx& C, int l, int j) {
    switch (j) {
    case 0: return MatDesc{C.P->in[5] + (size_t)l * DM * INW, INW, DM, INW, C.W(l, W_IN), C.P->in[4] + l * DM, nullptr, 1};
    case 1: return MatDesc{C.P->in[9] + (size_t)l * 512 * DM, DM, 512, DM, C.W(l, W_PO), nullptr, nullptr, 0};
    case 2: return MatDesc{C.P->in[10] + (size_t)l * DM * DM, DM, DM, DM, C.W(l, W_RO), nullptr, nullptr, 0};
    case 3: return MatDesc{C.P->in[11] + (size_t)l * DM * DM, DM, DM, DM, C.W(l, W_O), nullptr, nullptr, 0};
    case 4: return MatDesc{C.P->in[13] + (size_t)l * DM * INW, INW, DM, INW, C.W(l, W_FFI), C.P->in[12] + l * DM, nullptr, 2};
    case 5: return MatDesc{C.P->in[14] + (size_t)l * DFF * DM, DM, DFF, DM, C.W(l, W_FFO), nullptr, nullptr, 0};
    case 6: return MatDesc{C.P->in[16] + (size_t)l * DM * DM, DM, DM, DM, C.W(l, W_PG), C.P->in[15] + l * DM, nullptr, 0};
    case 7: return MatDesc{C.P->in[17] + (size_t)l * PLE * DM, DM, PLE, DM, C.W(l, W_PP), nullptr, nullptr, 0};
    default: { const int g = j - 8; return MatDesc{C.P->in[6] + (size_t)(l * 4 + g) * 128 * 128, 128, 128, 128, C.W(l, W_PW) + g * 128 * 128, nullptr, C.P->in[7] + l * 512 + g * 128, 0}; }
    }
}
__device__ __forceinline__ int mat_items(int j) { return (j == 0 || j == 4) ? (DM / 32) * INW : (j == 1) ? (512 / 32) * DM : (j == 5) ? (DFF / 32) * DM : (j == 7) ? (PLE / 32) * DM : (j >= 8) ? (128 / 32) * 128 : (DM / 32) * DM; }
__device__ void conv_range(const Ctx& C, int l, int jlo, int jhi, int w, int nw) {
    int total = 0;
    for (int j = jlo; j < jhi; ++j) total += mat_items(j);
    for (int it0 = w; it0 < total; it0 += nw) {
        int it = it0, j = jlo;
        for (; j < jhi - 1; ++j) { const int cnt = mat_items(j); if (it < cnt) break; it -= cnt; }
        const MatDesc md = mat_desc(C, l, j);
        const int N = md.N, K = md.K, kb = it / N, n = it - kb * N, k0 = kb * 32;
        int src = n;
        if (md.cm == 1) { if (n >= 512 && n < 1536) { const int sec = (n - 512) >> 7, c = (n - 512) & 127; src = 512 + sec * 128 + dperm(c); } }
        if (md.cm == 2) { const int pn = n >> 8, r = n & 255; src = (r < 128) ? (128 * pn + r) : (DFF + 128 * pn + (r - 128)); }
        const float sn = md.gn ? md.gn[n] : 1.0f;
        const float* wp = md.W + (size_t)k0 * md.ldw + src;
        float v[32];
#pragma unroll
        for (int i = 0; i < 32; ++i) v[i] = wp[(size_t)i * md.ldw];
        if (md.gk) {
#pragma unroll
            for (int i = 0; i < 32; i += 4) { const f32x4 g4 = *(const f32x4*)(md.gk + k0 + i); v[i] *= g4[0]; v[i + 1] *= g4[1]; v[i + 2] *= g4[2]; v[i + 3] *= g4[3]; }
        }
        u32x4* op = (u32x4*)(md.out + (size_t)n * K + k0);
#pragma unroll
        for (int i = 0; i < 4; ++i) { u32x4 wv; wv.x = cvt_pk_bf16(v[8 * i] * sn, v[8 * i + 1] * sn); wv.y = cvt_pk_bf16(v[8 * i + 2] * sn, v[8 * i + 3] * sn);
            wv.z = cvt_pk_bf16(v[8 * i + 4] * sn, v[8 * i + 5] * sn); wv.w = cvt_pk_bf16(v[8 * i + 6] * sn, v[8 * i + 7] * sn); op[i] = wv; }
    }
}
__device__ void phase_p0(const Ctx& C, LAS unsigned char* lds) {
    (void)lds;
    {
        const int w = C.bid * 512 + C.ftid(), nw = C.G * 512;
        conv_range(C, 0, 0, 4, w, nw); conv_range(C, 0, 8, 12, w, nw); conv_range(C, 1, 8, 12, w, nw);
        if (C.G != 256) { conv_range(C, 0, 4, 8, w, nw); conv_range(C, 1, 0, 8, w, nw); }
    }
    float* COS = C.COS(); float* SIN = C.SIN();
    for (int e = C.bid * 512 + C.ftid(); e < SEQ * 64; e += C.G * 512) {
        const int pos = e >> 6, i = e & 63;
        double inv = 1.0; for (int k = 0; k < i; ++k) inv *= 0.8659643233600653;
        const double x = (double)pos * inv;
        const double n = rint(x * 0.15915494309189535);
        const double r = fma(-n, 2.4492935982947064e-16, fma(-n, 6.283185307179586, x));
        const double r2 = r * r;
        double s = 1.0, c = 1.0;
#pragma unroll
        for (int k = 17; k >= 1; --k) { s = 1.0 - s * r2 * (1.0 / (double)((2 * k) * (2 * k + 1))); c = 1.0 - c * r2 * (1.0 / (double)((2 * k - 1) * (2 * k))); }
        COS[e] = (float)c; SIN[e] = (float)(s * r);
    }
}
__device__ void phase_rows(const Ctx& C, int s_fin, int s_pre) {
    const int tid0 = C.ftid(), wid = tid0 >> 6, lane = tid0 & 63;
    float* SS0 = C.SS(0); bf16_t* XB0 = C.XB(0);
    for (int row = C.bid * 8 + wid; row < SEQ; row += C.G * 8) {
        if (s_fin >= 0) {
            float* x = C.xout(s_fin) + (size_t)row * DM; const float* gf = C.P->in[18];
            const float rstd = rstd_from_ss(SS0 + (size_t)row * 16);
#pragma unroll
            for (int i = 0; i < 4; ++i) { const int col = lane * 4 + 256 * i; const f32x4 v = unpack4(*(const u32x2*)(XB0 + (size_t)row * DM + col)), g = *(const f32x4*)(gf + col); *(f32x4*)(x + col) = v * rstd * g; }
        }
        if (s_pre >= 0) {
            const float* x = C.xin(s_pre) + (size_t)row * DM; float ss = 0.f;
#pragma unroll
            for (int i = 0; i < 4; ++i) { const int col = lane * 4 + 256 * i; const f32x4 v = *(const f32x4*)(x + col);
                ss += (v[0] * v[0] + v[1] * v[1]) + (v[2] * v[2] + v[3] * v[3]); *(u32x2*)(XB0 + (size_t)row * DM + col) = pack4(v); }
#pragma unroll
            for (int o = 32; o >= 1; o >>= 1) ss += shx(ss, lane, o);
            if (lane < 16) SS0[(size_t)row * 16 + lane] = (lane == 0) ? ss : 0.f;
#pragma unroll
            for (int l = 0; l < 2; ++l) { const f32x4 v = *(const f32x4*)(C.pin(s_pre, l) + (size_t)row * PLE + lane * 4); *(u32x2*)(C.PB(l) + (size_t)row * PLE + lane * 4) = pack4(v); }
        }
    }
}

__device__ __forceinline__ bf16x8 tr_frag(const LAS bf16_t* T, int pitch, int r0, int c0, int fr, int fq) {
#if SLOW_TR
    bf16x8 f;
#pragma unroll
    for (int j = 0; j < 8; ++j) f[j] = (short)T[(r0 + 8 * fq + j) * pitch + c0 + fr];
    return f;
#endif
    const int q = fr >> 2, p = fr & 3;
    const LAS bf16_t* a = T + (r0 + 8 * fq + q) * pitch + c0 + 4 * p;
    const s16x4 lo = __builtin_amdgcn_ds_read_tr16_b64_v4i16((LAS s16x4*)a);
    const s16x4 hi = __builtin_amdgcn_ds_read_tr16_b64_v4i16((LAS s16x4*)(a + 4 * pitch));
    return __builtin_shufflevector(lo, hi, 0, 1, 2, 3, 4, 5, 6, 7);
}
#define MFMA16(a, b, c) __builtin_amdgcn_mfma_f32_16x16x32_bf16((a), (b), (c), 0, 0, 0)

template <int W2> __device__ __forceinline__ void pool_window(const bf16_t* col, int tpos, f32x4& s0, f32x4& s1) {
    u32x4 d[2 * W2];
#pragma unroll
    for (int k = 0; k < 2 * W2; ++k) { const int sp = tpos - W2 + k; const int sc = ((unsigned)sp < (unsigned)SEQ) ? sp : tpos; d[k] = *(const u32x4*)(col + (size_t)sc * INW); }
#pragma unroll
    for (int k = 0; k < 2 * W2; ++k) { const int sp = tpos - W2 + k; const float m = ((unsigned)sp < (unsigned)SEQ) ? 1.0f : 0.0f; s0 = s0 + unpack_lo4(d[k]) * m; s1 = s1 + unpack_hi4(d[k]) * m; }
}
__device__ void phase_a(const Ctx& C, LAS unsigned char* lds, int layer) {
    const int tid = C.ftid(), wid = __builtin_amdgcn_readfirstlane(tid >> 6), lane = tid & 63, fr = lane & 15, fq = lane >> 4;
    LAS bf16_t* Vs = (LAS bf16_t*)lds;
    LAS bf16_t* Kf = Vs + 128 * 264;
    LAS bf16_t* Kb = Kf + 128 * 136;
    const bf16_t* Z = C.Z();
    for (int t = C.bid; t < 1024; t += C.G) {
        __syncthreads();
        if (t < 512) {
            const int c = t >> 2, h = t & 3;
            const float lgf = log2g(C.P->in[8] + layer * 8 + h), lgb = log2g(C.P->in[8] + layer * 8 + 4 + h);
            const bf16_t* zrow = Z + (size_t)(c * 128) * INW;
#pragma unroll
            for (int i = 0; i < 8; ++i) { const int idx = tid + i * 512, r = idx >> 5, v = idx & 31;
                *(LAS u32x4*)(Vs + r * 264 + v * 8) = *(const u32x4*)(zrow + (size_t)r * INW + 1536 + h * 256 + v * 8); }
#pragma unroll
            for (int i = 0; i < 4; ++i) { const int idx = tid + i * 512, r = idx >> 4, v = idx & 15;
                const u32x4 d = *(const u32x4*)(zrow + (size_t)r * INW + 1024 + h * 128 + v * 8);
                const float wf = exp2f(lgf * (float)(127 - r)), wb = exp2f(lgb * (float)r);
                const f32x4 a = unpack_lo4(d), b = unpack_hi4(d);
                *(LAS u32x4*)(Kf + r * 136 + v * 8) = pack8(a * wf, b * wf);
                *(LAS u32x4*)(Kb + r * 136 + v * 8) = pack8(a * wb, b * wb); }
            __syncthreads();
            f32x4 acc[2][8][2];
#pragma unroll
            for (int a = 0; a < 2; ++a)
#pragma unroll
                for (int b = 0; b < 8; ++b) { acc[a][b][0] = (f32x4){0.f, 0.f, 0.f, 0.f}; acc[a][b][1] = (f32x4){0.f, 0.f, 0.f, 0.f}; }
#pragma unroll 1
            for (int kk = 0; kk < 4; ++kk) {
                int fr = lane & 15, fq = lane >> 4; asm volatile("" : "+v"(fr), "+v"(fq));
                bf16x8 vf[2];
#pragma unroll
                for (int et = 0; et < 2; ++et) vf[et] = tr_frag(Vs, 264, 32 * kk, 32 * wid + 16 * et, fr, fq);
#pragma unroll
                for (int dir = 0; dir < 2; ++dir)
#pragma unroll
                    for (int dt = 0; dt < 8; ++dt) {
                        const bf16x8 kf = tr_frag(dir ? Kb : Kf, 136, 32 * kk, 16 * dt, fr, fq);
                        acc[dir][dt][0] = MFMA16(kf, vf[0], acc[dir][dt][0]);
                        acc[dir][dt][1] = MFMA16(kf, vf[1], acc[dir][dt][1]);
                    }
            }
            bf16_t* KV = C.KV();
#pragma unroll
            for (int dir = 0; dir < 2; ++dir)
#pragma unroll
                for (int dt = 0; dt < 8; ++dt)
#pragma unroll
                    for (int et = 0; et < 2; ++et) {
                        const int e = 32 * wid + 16 * et + fr, d = 16 * dt + 4 * fq;
                        *(u32x2*)(KV + ((size_t)(((c * 4 + h) * 2 + dir) * 256 + e)) * 128 + d) = pack4(acc[dir][dt][et]);
                    }
        } else {
            const int pt = t - 512, tb = pt >> 2, g = (pt >= 256) ? 3 - (pt & 3) : (pt & 3), w2 = 1 << g;
            LAS bf16_t* Ds = (LAS bf16_t*)lds;
#pragma unroll 1
            for (int i = 0; i < 4; ++i) {
                const int idx = tid + i * 512, r = idx >> 4, v = idx & 15, tpos = tb * 128 + r;
                const int lo = max(tpos - w2, 0), hi = min(tpos + w2, SEQ);
                const bf16_t* col = Z + g * 128 + v * 8;
                f32x4 s0 = (f32x4){0.f, 0.f, 0.f, 0.f}, s1 = s0;
                if (g == 3) pool_window<8>(col, tpos, s0, s1); else if (g == 2) pool_window<4>(col, tpos, s0, s1); else if (g == 1) pool_window<2>(col, tpos, s0, s1); else pool_window<1>(col, tpos, s0, s1);
                const float inv = 1.0f / (float)(hi - lo);
                const u32x4 d = *(const u32x4*)(col + (size_t)tpos * INW);
                *(LAS u32x4*)(Ds + r * 136 + v * 8) = pack8(s0 * inv - unpack_lo4(d), s1 * inv - unpack_hi4(d));
            }
            __syncthreads();
            const bf16_t* PW = C.W(layer, W_PW) + g * 128 * 128;
            f32x4 acc[8];
#pragma unroll
            for (int dt = 0; dt < 8; ++dt) acc[dt] = (f32x4){0.f, 0.f, 0.f, 0.f};
#pragma unroll 1
            for (int kk = 0; kk < 4; ++kk) {
                const bf16x8 df = *(const LAS bf16x8*)(Ds + (16 * wid + fr) * 136 + 32 * kk + 8 * fq);
#pragma unroll
                for (int dt = 0; dt < 8; ++dt) { const bf16x8 wf = *(const bf16x8*)(PW + (16 * dt + fr) * 128 + 32 * kk + 8 * fq); acc[dt] = MFMA16(wf, df, acc[dt]); }
            }
            bf16_t* PA = C.PA();
            const int row = tb * 128 + 16 * wid + fr;
#pragma unroll
            for (int dt = 0; dt < 8; ++dt) *(u32x2*)(PA + (size_t)row * 512 + g * 128 + 16 * dt + 4 * fq) = pack4(acc[dt]);
        }
    }
}
__device__ void phase_b(const Ctx& C, int layer) {
    u32x4* KV = (u32x4*)C.KV();
    const int tid = C.ftid();
    if (tid >= 128) return;
    for (int it = C.bid * 128 + tid; it < 32768; it += C.G * 128) {
        const int idx = it * 8, h = idx >> 16, dir = (idx >> 15) & 1;
        const float cd = exp2f(log2g(C.P->in[8] + layer * 8 + dir * 4 + h) * 128.0f);
        u32x4* base = KV + it;
        f32x4 ra = (f32x4){0.f, 0.f, 0.f, 0.f}, rb = ra;
        const int c0 = dir ? 127 : 0, st = dir ? -1 : 1;
        for (int cc = 0; cc < 128; cc += 8) { u32x4 v[8];
#pragma unroll
            for (int i = 0; i < 8; ++i) v[i] = base[(size_t)(c0 + st * (cc + i)) * 32768];
#pragma unroll
            for (int i = 0; i < 8; ++i) { base[(size_t)(c0 + st * (cc + i)) * 32768] = pack8(ra, rb); ra = ra * cd + unpack_lo4(v[i]); rb = rb * cd + unpack_hi4(v[i]); } }
    }
}
__device__ void phase_c(const Ctx& C, LAS unsigned char* lds, int layer) {
    const int tid0 = C.ftid(), wid = __builtin_amdgcn_readfirstlane(tid0 >> 6), lane = tid0 & 63;
    LAS bf16_t* Qs = (LAS bf16_t*)lds;
    LAS bf16_t* Ps = Qs + 128 * 136;
    LAS bf16_t* Vs = Ps + 128 * 136;
    LAS float* St = (LAS float*)(Vs + 128 * 264);
    const bf16_t* Z = C.Z(); const bf16_t* KV = C.KV(); bf16_t* RG = C.RG();
    for (int t = C.bid; t < 512; t += C.G) {
        const int c = t >> 2, h = t & 3;
        const float lgf = log2g(C.P->in[8] + layer * 8 + h), lgb = log2g(C.P->in[8] + layer * 8 + 4 + h);
        const bf16_t* zrow = Z + (size_t)(c * 128) * INW;
        const int e0 = 32 * wid;
        int fr = lane & 15, fq = lane >> 4;
        asm volatile("" : "+v"(fr), "+v"(fq));
        bf16x8 sf[2][2][4];
#pragma unroll
        for (int dir = 0; dir < 2; ++dir) {
            const bf16_t* sb = KV + (size_t)(((c * 4 + h) * 2 + dir) * 256) * 128;
#pragma unroll
            for (int et = 0; et < 2; ++et)
#pragma unroll
                for (int kk = 0; kk < 4; ++kk) sf[dir][et][kk] = *(const bf16x8*)(sb + (size_t)(e0 + 16 * et + fr) * 128 + 32 * kk + 8 * fq);
        }
        __syncthreads();
        { const int tid = C.ftid();
#pragma unroll
        for (int i = 0; i < 8; ++i) { const int idx = tid + i * 512, r = idx >> 5, v = idx & 31;
            *(LAS u32x4*)(Vs + r * 264 + v * 8) = *(const u32x4*)(zrow + (size_t)r * INW + 1536 + h * 256 + v * 8); }
#pragma unroll
        for (int i = 0; i < 4; ++i) { const int idx = tid + i * 512, r = idx >> 4, v = idx & 15;
            *(LAS u32x4*)(Qs + r * 136 + v * 8) = *(const u32x4*)(zrow + (size_t)r * INW + 512 + h * 128 + v * 8);
            *(LAS u32x4*)(Ps + r * 136 + v * 8) = *(const u32x4*)(zrow + (size_t)r * INW + 1024 + h * 128 + v * 8); }
        }
        __syncthreads();
        asm volatile("" : "+v"(fr), "+v"(fq));
        f32x4 sc[8];
        {
            const int i0 = 16 * wid;
            bf16x8 qf[4];
#pragma unroll
            for (int kk = 0; kk < 4; ++kk) qf[kk] = *(const LAS bf16x8*)(Qs + (i0 + fr) * 136 + 32 * kk + 8 * fq);
#pragma unroll
            for (int jt = 0; jt < 8; ++jt) {
                f32x4 a = (f32x4){0.f, 0.f, 0.f, 0.f};
#pragma unroll
                for (int kk = 0; kk < 4; ++kk) { const bf16x8 kf = *(const LAS bf16x8*)(Ps + (16 * jt + fr) * 136 + 32 * kk + 8 * fq); a = MFMA16(kf, qf[kk], a); }
                const int i = i0 + fr;
#pragma unroll
                for (int r = 0; r < 4; ++r) { const int j = 16 * jt + 4 * fq + r, dl = i - j; a[r] *= (dl >= 0) ? exp2f(lgf * (float)dl) : exp2f(lgb * (float)(-dl)); }
                sc[jt] = a;
            }
        }
        __syncthreads();
        {
            const int i = 16 * wid + fr;
#pragma unroll
            for (int jt = 0; jt < 8; ++jt) *(LAS u32x2*)(Ps + i * 136 + 16 * jt + 4 * fq) = pack4(sc[jt]);
        }
        __syncthreads();
        asm volatile("" : "+v"(fr), "+v"(fq));
        f32x4 y[8][2];
#pragma unroll
        for (int m = 0; m < 8; ++m) { y[m][0] = (f32x4){0.f, 0.f, 0.f, 0.f}; y[m][1] = (f32x4){0.f, 0.f, 0.f, 0.f}; }
#pragma unroll 1
        for (int kk = 0; kk < 4; ++kk) {
            bf16x8 vf[2];
#pragma unroll
            for (int et = 0; et < 2; ++et) vf[et] = tr_frag(Vs, 264, 32 * kk, e0 + 16 * et, fr, fq);
#pragma unroll
            for (int m = 0; m < 8; ++m) { const bf16x8 pf = *(const LAS bf16x8*)(Ps + (16 * m + fr) * 136 + 32 * kk + 8 * fq);
                y[m][0] = MFMA16(vf[0], pf, y[m][0]); y[m][1] = MFMA16(vf[1], pf, y[m][1]); }
        }
#pragma unroll
        for (int dir = 0; dir < 2; ++dir) {
            asm volatile("" : "+v"(fr), "+v"(fq));
#pragma unroll
            for (int m = 0; m < 8; ++m) {
                f32x4 t0 = (f32x4){0.f, 0.f, 0.f, 0.f}, t1 = t0;
#pragma unroll
                for (int kk = 0; kk < 4; ++kk) { const bf16x8 qq = *(const LAS bf16x8*)(Qs + (16 * m + fr) * 136 + 32 * kk + 8 * fq); t0 = MFMA16(sf[dir][0][kk], qq, t0); t1 = MFMA16(sf[dir][1][kk], qq, t1); }
                const int i = 16 * m + fr;
                const float scl = (dir == 0) ? exp2f(lgf * (float)(i + 1)) : exp2f(lgb * (float)(128 - i));
                y[m][0] = y[m][0] + t0 * scl; y[m][1] = y[m][1] + t1 * scl;
                if (m & 1) asm volatile("" ::: "memory");
            }
        }
        asm volatile("" : "+v"(fr), "+v"(fq));
        u32x2 gsw[8][2];
#pragma unroll
        for (int m = 0; m < 8; ++m)
#pragma unroll
            for (int et = 0; et < 2; ++et) gsw[m][et] = *(const u32x2*)(zrow + (size_t)(16 * m + fr) * INW + 2560 + h * 256 + e0 + 16 * et + 4 * fq);
#pragma unroll
        for (int m = 0; m < 8; ++m) {
            const f32x4 a = y[m][0], b = y[m][1];
            float s = (a[0] + a[1]) + (a[2] + a[3]) + (b[0] + b[1]) + (b[2] + b[3]);
            float q = (a[0] * a[0] + a[1] * a[1]) + (a[2] * a[2] + a[3] * a[3]) + (b[0] * b[0] + b[1] * b[1]) + (b[2] * b[2] + b[3] * b[3]);
            { const int ln = fq * 16 + fr; s += shx(s, ln, 16); s += shx(s, ln, 32); q += shx(q, ln, 16); q += shx(q, ln, 32); }
            if (fq == 0) { St[(16 * m + fr) * 16 + wid * 2] = s; St[(16 * m + fr) * 16 + wid * 2 + 1] = q; }
        }
        __syncthreads();
#pragma unroll
        for (int m = 0; m < 8; ++m) {
            const int i = 16 * m + fr;
            const LAS f32x4* sp = (const LAS f32x4*)(St + i * 16);
            const f32x4 p0 = sp[0], p1 = sp[1], p2 = sp[2], p3 = sp[3];
            const float s = (p0[0] + p0[2]) + (p1[0] + p1[2]) + (p2[0] + p2[2]) + (p3[0] + p3[2]);
            const float q = (p0[1] + p0[3]) + (p1[1] + p1[3]) + (p2[1] + p2[3]) + (p3[1] + p3[3]);
            const float mean = s * (1.0f / 256.0f), var = fmaxf(q * (1.0f / 256.0f) - mean * mean, 0.f);
            const float rstd = __builtin_amdgcn_rsqf(var + 1e-5f);
            const size_t row = (size_t)(c * 128 + i);
#pragma unroll
            for (int et = 0; et < 2; ++et) {
                const int e = e0 + 16 * et + 4 * fq;
                *(u32x2*)(RG + row * DM + h * 256 + e) = pack4((y[m][et] - mean) * rstd * unpack4(gsw[m][et]));
            }
        }
    }
}

__device__ __forceinline__ void run_phase(const Ctx& C, LAS unsigned char* lds, int ph) {
    if (ph == 0) { phase_p0(C, lds); phase_rows(C, -1, 0); return; }
    const int q = ph - 1, s = q / 19, r = q % 19;
    if (r == 18) { phase_rows(C, s, s < 2 ? s + 1 : -1); return; }
    const int layer = r / 9, st = r % 9, cur = layer, G = C.G, bid = C.bid;
    pg8::StaticOrder S;
    switch (st) {
    case 0: { pg8::Gemm g{C.XB(cur), C.W(layer, W_IN), SEQ, INW, DM}; S.init(SEQ, INW, G, bid, 2);
              EpiZ E{C.Z(), C.SS(cur), C.COS(), C.SIN()}; pg8::gemm_phase(C.ftid(), lds, g, S, E);
              if (s == 0 && G == 256 && bid >= 128) conv_range(C, layer, 4, 8, (bid - 128) * 512 + C.ftid(), 128 * 512); } break;
    case 1: phase_a(C, lds, layer); break;
    case 2: phase_b(C, layer); break;
    case 3: phase_c(C, lds, layer); break;
    case 4: { S.init(SEQ, DM, G, bid);
              { pg8::Gemm g{C.PA(), C.W(layer, W_PO), SEQ, DM, 512}; EpiGen<0> E{C.TMP(), nullptr, C.Z() + 3584, nullptr}; pg8::gemm_phase(C.ftid(), lds, g, S, E); }
              { pg8::Gemm g{C.RG(), C.W(layer, W_RO), SEQ, DM, DM}; EpiGen<1> E{C.MG(), C.TMP(), C.Z() + 3584 + 1024, nullptr}; pg8::gemm_phase(C.ftid(), lds, g, S, E); } } break;
    case 5: { pg8::Gemm g{C.MG(), C.W(layer, W_O), SEQ, DM, DM}; S.init(SEQ, DM, G, bid);
              if (layer == 0) { EpiResid<false, true> E{C.xin(s), nullptr, C.XB(cur ^ 1), C.SS(cur ^ 1), nullptr}; pg8::gemm_phase(C.ftid(), lds, g, S, E); }
              else { EpiResid<false, false> E{nullptr, C.XB(cur), C.XB(cur ^ 1), C.SS(cur ^ 1), nullptr}; pg8::gemm_phase(C.ftid(), lds, g, S, E); } } break;
    case 6: { pg8::Gemm g{C.XB(cur ^ 1), C.W(layer, W_FFI), SEQ, INW, DM}; S.init(SEQ, INW, G, bid);
              EpiSwiGLU E{C.Z(), C.SS(cur ^ 1)}; pg8::gemm_phase(C.ftid(), lds, g, S, E);
              if (s == 0 && layer == 0 && G == 256 && bid >= 128) conv_range(C, 1, 0, 4, (bid - 128) * 512 + C.ftid(), 128 * 512);
              if (G != 256 || bid >= 128) {
                  pg8::StaticOrder S2; if (G == 256) S2.init(SEQ, DM, 128, bid - 128); else S2.init(SEQ, DM, G, bid);
                  pg8::Gemm g2{C.PB(layer), C.W(layer, W_PP), SEQ, DM, PLE}; EpiStore E2{C.PROJ()}; pg8::gemm_phase(C.ftid(), lds, g2, S2, E2); } } break;
    case 7: { pg8::Gemm g{C.Z(), C.W(layer, W_FFO), SEQ, DM, DFF}; S.init(SEQ, DM, G, bid);
              EpiResid<false, false> E{nullptr, C.XB(cur ^ 1), C.XB(cur), C.SS(cur), nullptr}; pg8::gemm_phase(C.ftid(), lds, g, S, E); } break;
    default: { S.init(SEQ, DM, G, bid);
              pg8::Gemm g{C.XB(cur), C.W(layer, W_PG), SEQ, DM, DM}; EpiPle E{C.XB(cur), C.XB(cur ^ 1), C.SS(cur ^ 1), C.PROJ(), C.SS(cur)}; pg8::gemm_phase(C.ftid(), lds, g, S, E); } break;
    }
}


#define XB_TMO      128
#define XB_XCNT(j)  (256  + 64 * (j))
#define XB_XSUB(j)  (1280 + 64 * (j))
#define XB_XGEN(j)  (2304 + 64 * (j))
#define XB_TOP      3328
#define XB_TOPGEN   3392
#define XCD_BAR_WORDS 3456
#define XB_SPIN_CAP (1u << 18)
__device__ __forceinline__ unsigned xb_ld(unsigned* p)              { return __hip_atomic_load(p, __ATOMIC_RELAXED, __HIP_MEMORY_SCOPE_AGENT); }
__device__ __forceinline__ unsigned xb_add(unsigned* p, unsigned v) { return __hip_atomic_fetch_add(p, v, __ATOMIC_RELAXED, __HIP_MEMORY_SCOPE_AGENT); }
__device__ __forceinline__ unsigned xb_xcc_id() { return (unsigned)__builtin_amdgcn_s_getreg((3 << 11) | 20) & 0xFu; }
#define XB_SPIN(cond, bar) do { unsigned _sp = 0; while (cond) { __builtin_amdgcn_s_sleep(1); \
    if ((++_sp & 255u) == 0u) { if (xb_ld(&(bar)[XB_TMO])) break; if (_sp > XB_SPIN_CAP) { atomicAdd(&(bar)[XB_TMO], 1u); break; } } } } while (0)
struct XcdBarrier { unsigned* bar; unsigned x; volatile LAS unsigned* st; };
__device__ __forceinline__ XcdBarrier xcd_barrier_post(unsigned* bar, volatile LAS unsigned* st, bool leader) {
    XcdBarrier b; b.bar = bar; b.x = xb_xcc_id(); b.st = st;
    if (leader) (void)xb_add(&bar[XB_XCNT(b.x)], 1u);
    return b;
}
__device__ __forceinline__ void xcd_barrier_complete(unsigned* bar, unsigned x, unsigned& nloc, unsigned& nx) {
    const unsigned G = gridDim.x * gridDim.y * gridDim.z;
    unsigned sum, cnt, mine, sp = 0u;
    for (;;) {
        sum = 0u; cnt = 0u; mine = 0u;
#pragma unroll
        for (unsigned j = 0; j < 16; ++j) { const unsigned c = xb_ld(&bar[XB_XCNT(j)]); sum += c; cnt += (c > 0u) ? 1u : 0u; mine = (j == x) ? c : mine; }
        if (sum == G) break;
        __builtin_amdgcn_s_sleep(1);
        if ((++sp & 255u) == 0u) { if (xb_ld(&bar[XB_TMO])) break; if (sp > XB_SPIN_CAP) { atomicAdd(&bar[XB_TMO], 1u); break; } }
    }
    nloc = mine > 0u ? mine : 1u; nx = cnt > 0u ? cnt : 1u;
}
__device__ __forceinline__ void xcd_barrier(const XcdBarrier& b, int wv) {
    asm volatile("s_waitcnt vmcnt(0)" ::: "memory");
    __syncthreads();
    if (wv == 0 && lane_now() == 0) {
        unsigned* bar = b.bar;
        __builtin_amdgcn_s_waitcnt(0);
        unsigned nloc = b.st[0], nx = b.st[1];
        if (nloc == 0u) { xcd_barrier_complete(bar, b.x, nloc, nx); b.st[0] = nloc; b.st[1] = nx; }
        const unsigned old = xb_add(&bar[XB_XSUB(b.x)], 1u);
        const unsigned gen = old / nloc;
        if (old + 1u == (gen + 1u) * nloc) {
            __builtin_amdgcn_fence(__ATOMIC_RELEASE, "agent");
            asm volatile("s_waitcnt vmcnt(0)" ::: "memory");
            const unsigned og = xb_add(&bar[XB_TOP], 1u);
            const unsigned tg = og / nx;
            if (og + 1u == (tg + 1u) * nx) xb_add(&bar[XB_TOPGEN], 1u);
            else XB_SPIN(xb_ld(&bar[XB_TOPGEN]) == tg, bar);
            __builtin_amdgcn_fence(__ATOMIC_ACQUIRE, "agent");
            xb_add(&bar[XB_XGEN(b.x)], 1u);
            asm volatile("s_waitcnt vmcnt(0)" ::: "memory");
        } else {
            XB_SPIN(xb_ld(&bar[XB_XGEN(b.x)]) == gen, bar);
            __builtin_amdgcn_fence(__ATOMIC_ACQUIRE, "agent");
            asm volatile("s_waitcnt vmcnt(0)" ::: "memory");
        }
    }
    __syncthreads();
}

__global__ void __launch_bounds__(512, 2) mk_fwd(Params P) {
    extern __shared__ __attribute__((aligned(16))) unsigned char lds_raw[];
    LAS unsigned char* lds = (LAS unsigned char*)lds_raw;
    const int wv0 = __builtin_amdgcn_readfirstlane((int)threadIdx.x >> 6);
    const bool leader0 = (threadIdx.x == 0);
    volatile LAS unsigned* bst = (volatile LAS unsigned*)(lds + LDS_BYTES - 16);
    XcdBarrier bar; bar.bar = (unsigned*)(P.ws + WS_END); bar.x = 0; bar.st = bst;
    if (P.ph_hi - P.ph_lo > 1) {
        if (leader0) { bst[0] = 0u; bst[1] = 0u; }
        __syncthreads();
        bar = xcd_barrier_post((unsigned*)(P.ws + WS_END), bst, leader0);
    }
    for (int ph = P.ph_lo; ph < P.ph_hi; ++ph) {
        int wv = wv0, bid = blockIdx.x, G = gridDim.x;
        asm volatile("" : "+s"(wv), "+s"(bid), "+s"(G));
        KPtr pp = (KPtr)__builtin_amdgcn_kernarg_segment_ptr();
        asm volatile("" : "+s"(pp));
        Ctx C{pp, pp->out, pp->ws, wv, bid, G};
        run_phase(C, lds, ph);
#if REP_MASK
        { int cls; if (ph == 0) cls = 10; else { const int r = (ph - 1) % 19; cls = (r == 18) ? 9 : (r % 9); }
          if ((REP_MASK >> cls) & 1) { __syncthreads(); run_phase(C, lds, ph); } }
#endif
        if (ph + 1 < P.ph_hi) { if (ph == P.ph_lo) cg::this_grid().sync(); else xcd_barrier(bar, wv0); }
    }
}

extern "C" void kernel_launch(void* const* d_in, const int* in_sizes, int n_in, void* d_out, int out_size, void* d_ws, size_t ws_size, hipStream_t stream) {
    static int grid = 0;
    if (grid == 0) {
        if (n_in != 19 || ws_size < WS_END2) { fprintf(stderr, "kernel_launch: unexpected n_in %d / ws %zu (need %zu)\n", n_in, ws_size, (size_t)WS_END); grid = -1; return; }
        int dev = 0, cus = 0, per_cu = 0;
        hipGetDevice(&dev); hipDeviceGetAttribute(&cus, hipDeviceAttributeMultiprocessorCount, dev);
        hipFuncSetAttribute((const void*)mk_fwd, hipFuncAttributeMaxDynamicSharedMemorySize, LDS_BYTES);
        hipOccupancyMaxActiveBlocksPerMultiprocessor(&per_cu, (const void*)mk_fwd, 512, LDS_BYTES);
        if (per_cu < 1) per_cu = 1;
        (void)hipGetLastError();
        grid = cus * per_cu;
    }
    if (grid < 0) return;
    if (hipMemsetAsync((char*)d_ws + WS_END, 0, XCD_BAR_WORDS * 4, stream) != hipSuccess) { fprintf(stderr, "kernel_launch: memset of barrier words failed\n"); return; }
    Params p{};
    for (int i = 0; i < 19; ++i) p.in[i] = (const float*)d_in[i];
    p.out = (float*)d_out; p.ws = (unsigned char*)d_ws;
#if MULTI_LAUNCH
    for (int ph = 0; ph < NPH; ++ph) { p.ph_lo = ph; p.ph_hi = ph + 1; hipLaunchKernelGGL(mk_fwd, dim3(grid), dim3(512), LDS_BYTES, stream, p); }
#else
    p.ph_lo = 0; p.ph_hi = NPH;
    void* args[] = {&p};
    hipError_t e = hipLaunchCooperativeKernel((const void*)mk_fwd, dim3(grid), dim3(512), args, LDS_BYTES, stream);
    if (e != hipSuccess) fprintf(stderr, "cooperative launch failed: %s (grid %d)\n", hipGetErrorString(e), grid);
#endif
}
```

```cpp
#include <hip/hip_runtime.h>
#include <hip/hip_cooperative_groups.h>
#include <cstdio>
namespace cg = cooperative_groups;

#ifndef SLOW_TR
#define SLOW_TR 0
#endif
#ifndef REP_MASK
#define REP_MASK 0
#endif
#ifndef MULTI_LAUNCH
#define MULTI_LAUNCH 0
#endif

#define LAS __attribute__((address_space(3)))
typedef unsigned short bf16_t;
typedef short bf16x8 __attribute__((ext_vector_type(8)));
typedef short s16x4 __attribute__((ext_vector_type(4)));
typedef float f32x4 __attribute__((ext_vector_type(4)));
typedef unsigned u32x4 __attribute__((ext_vector_type(4)));
typedef unsigned u32x2 __attribute__((ext_vector_type(2)));

constexpr int SEQ = 16384, DM = 1024, INW = 5632, DFF = 2816, PLE = 256;
constexpr int NPH = 58;
constexpr size_t W_IN = 0, W_PO = W_IN + (size_t)INW * DM * 2, W_RO = W_PO + (size_t)DM * 512 * 2, W_O = W_RO + (size_t)DM * DM * 2,
                 W_FFI = W_O + (size_t)DM * DM * 2, W_FFO = W_FFI + (size_t)INW * DM * 2, W_PG = W_FFO + (size_t)DM * DFF * 2,
                 W_PP = W_PG + (size_t)DM * DM * 2, W_PW = W_PP + (size_t)DM * PLE * 2, W_LAYER = W_PW + (size_t)4 * 128 * 128 * 2;
constexpr size_t WS_W = 0, WS_COS = WS_W + 2 * W_LAYER, WS_SIN = WS_COS + (size_t)SEQ * 64 * 4, WS_XB = WS_SIN + (size_t)SEQ * 64 * 4,
                 WS_SS = WS_XB + 2 * (size_t)SEQ * DM * 2, WS_Z = WS_SS + 2 * (size_t)SEQ * 16 * 4, WS_KV = WS_Z + (size_t)SEQ * INW * 2,
                 WS_PA = WS_KV + (size_t)128 * 4 * 2 * 256 * 128 * 2, WS_RG = WS_PA + (size_t)SEQ * 512 * 2, WS_PB = WS_RG + (size_t)SEQ * DM * 2,
                 WS_END = WS_PB + 2 * (size_t)SEQ * PLE * 2;
constexpr size_t WS_PROJ = WS_END + 16384, WS_END2 = WS_PROJ + (size_t)SEQ * DM * 2;
constexpr int LDS_BYTES = 147456;

typedef float f32x2_t __attribute__((ext_vector_type(2)));
typedef __bf16 bf16x2_t __attribute__((ext_vector_type(2)));
__device__ __forceinline__ unsigned cvt_pk_bf16(float lo, float hi) { const f32x2_t v = {lo, hi}; return __builtin_bit_cast(unsigned, __builtin_convertvector(v, bf16x2_t)); }
__device__ __forceinline__ float bf_lo(unsigned u) { return __uint_as_float(u << 16); }
__device__ __forceinline__ float bf_hi(unsigned u) { return __uint_as_float(u & 0xffff0000u); }
__device__ __forceinline__ float sigmoid_f(float x) { return __builtin_amdgcn_rcpf(1.0f + __expf(-x)); }
__device__ __forceinline__ float sigmoid_sc(float v, float nrl) { return __builtin_amdgcn_rcpf(1.0f + __builtin_amdgcn_exp2f(v * nrl)); }
__device__ __forceinline__ float silu_f(float x) { return x * sigmoid_f(x); }
__device__ __forceinline__ u32x2 pack4(f32x4 v) { u32x2 w; w.x = cvt_pk_bf16(v[0], v[1]); w.y = cvt_pk_bf16(v[2], v[3]); return w; }
__device__ __forceinline__ u32x4 pack8(f32x4 a, f32x4 b) { u32x4 w; w.x = cvt_pk_bf16(a[0], a[1]); w.y = cvt_pk_bf16(a[2], a[3]); w.z = cvt_pk_bf16(b[0], b[1]); w.w = cvt_pk_bf16(b[2], b[3]); return w; }
__device__ __forceinline__ f32x4 unpack_lo4(u32x4 w) { return (f32x4){bf_lo(w.x), bf_hi(w.x), bf_lo(w.y), bf_hi(w.y)}; }
__device__ __forceinline__ f32x4 unpack_hi4(u32x4 w) { return (f32x4){bf_lo(w.z), bf_hi(w.z), bf_lo(w.w), bf_hi(w.w)}; }
__device__ __forceinline__ f32x4 unpack4(u32x2 w) { return (f32x4){bf_lo(w.x), bf_hi(w.x), bf_lo(w.y), bf_hi(w.y)}; }
__device__ __forceinline__ float log2g(const float* logit) {
    const float x = *logit, u = __expf(-x);
    float l = u * (1.f - u * (0.5f - u * (0.33333334f - u * (0.25f - u * (0.2f - u * 0.16666667f)))));
    if (u > 0.0625f) l = __logf(1.0f + u);
    return -l * 1.4426950408889634f;
}
__device__ __forceinline__ float rstd_from_ss(const float* ss) {
    const f32x4* sp = (const f32x4*)ss; const f32x4 a = sp[0], b = sp[1], c = sp[2], d = sp[3];
    const f32x4 t = (a + b) + (c + d); const float s = (t[0] + t[1]) + (t[2] + t[3]);
    return __builtin_amdgcn_rsqf(s * (1.0f / 1024.0f) + 1e-6f);
}

__device__ __forceinline__ float shx(float v, int lane, int m) { return __int_as_float(__builtin_amdgcn_ds_bpermute((lane ^ m) << 2, __float_as_int(v))); }
__device__ __forceinline__ int lane_now() { int l; asm volatile("v_mbcnt_lo_u32_b32 %0, -1, 0\n\tv_mbcnt_hi_u32_b32 %0, -1, %0" : "=v"(l)); return l; }
namespace pg8 {
constexpr int BM = 256, BK = 64, HALF = 128, HTB = HALF * BK * 2, STAGE_BYTES = 8 * HTB, NXCD = 8, WGM = 8;
__host__ __device__ __forceinline__ int lds_byte(int r, int c) { const int st = (r >> 4) * 2 + (c >> 5), rr = r & 15, cc = c & 31, ob = rr * 64 + cc * 2; return st * 1024 + (ob ^ (((ob >> 9) & 1) << 5)); }
__host__ __device__ __forceinline__ void stage_rc(int b, int& R, int& C) { const int st = b / 1024, sb = b % 1024, swz = sb ^ (((sb >> 9) & 1) << 5); R = (st >> 1) * 16 + swz / 64; C = (st & 1) * 32 + (swz % 64) / 2; }
__host__ __device__ __forceinline__ int perm32(int rho) { const int n = rho >> 4, i = rho & 15; return 8 * (i >> 2) + 4 * n + (i & 3); }
struct Unit { int pm, pn; };
struct Gemm { const bf16_t* A; const bf16_t* Bt; int M, N, K; };
struct StaticOrder {
    int nM, nN, nwg, G, c, rot, ioff, imax;
    __device__ void init(int M, int N, int G_, int c_, int rot_ = 0, int ioff_ = 0, int imax_ = 1 << 30) { nM = M / BM; nN = N / BM; nwg = nM * nN; G = G_; c = c_; rot = rot_; ioff = ioff_; imax = imax_; }
    __device__ bool next(int i, Unit& u) const {
        const int ii = i + ioff; if (ii >= imax) return false;
        const long L = (long)ii * G + c; if (L >= nwg) return false;
        int wgid = (int)L; { const int q = nwg / NXCD, r = nwg % NXCD, xcd = wgid % NXCD, off = wgid / NXCD; wgid = (xcd < r ? xcd * (q + 1) : r * (q + 1) + (xcd - r) * q) + off; }
        const int nig = WGM * nN, gid = wgid / nig, fm = gid * WGM, gsz = (nM - fm) < WGM ? (nM - fm) : WGM;
        u.pm = fm + ((wgid % nig) % gsz); { const int p = (wgid % nig) / gsz + rot; u.pn = p >= nN ? p - nN : p; } return true;
    }
};
template <class Epi>
__device__ __forceinline__ void gemm_phase(const int tid, LAS unsigned char* lds, const Gemm g, const StaticOrder& S, const Epi& E) {
    const int wid = __builtin_amdgcn_readfirstlane(tid >> 6), lane = tid & 63, wr = wid >> 2, wc = wid & 3, fr = lane & 15, fq = lane >> 4;
    const int K = g.K, nt = K / BK;
    unsigned voffA[2], voffB[2];
#pragma unroll
    for (int i = 0; i < 2; ++i) { int R, C; stage_rc(tid * 16 + i * 8192, R, C); const int Rb = Epi::PERM ? ((R & ~31) + perm32(R & 31)) : R;
        voffA[i] = (unsigned)(R * K + C) * 2u; voffB[i] = (unsigned)(Rb * K + C) * 2u; }
    const size_t kstep = (size_t)(BK * 2);
    const size_t hstep = (size_t)HALF * K * 2;
    const size_t tstep = 2 * hstep;
    const unsigned ldsw = (unsigned)wid * 1024u;
    const int aoff = lds_byte(wr * 64 + fr, fq * 8), boff = lds_byte(wc * 32 + fr, fq * 8);
#define PG8_SA(b, h) (((b) * 2 + (h)) * HTB)
#define PG8_SB(b, h) ((4 + (b) * 2 + (h)) * HTB)
#define PG8_STAGE(bufoff, gbase, voff) do { _Pragma("unroll") for (int _i = 0; _i < 2; ++_i) { unsigned _vo = (voff)[_i]; asm volatile("" : "+v"(_vo)); \
        __builtin_amdgcn_global_load_lds((const unsigned*)((const char*)(gbase) + _vo), (LAS unsigned*)(lds + (bufoff) + ldsw + _i * 8192), 16, 0, 0); } } while (0)
#define PG8_LDA(dst, b, h) do { _Pragma("unroll") for (int m = 0; m < 4; ++m) _Pragma("unroll") for (int k = 0; k < 2; ++k) dst[m][k] = *(const LAS bf16x8*)(lds + PG8_SA(b, h) + aoff + m * 2048 + k * 1024); } while (0)
#define PG8_LDB(dst, b, h) do { _Pragma("unroll") for (int n = 0; n < 2; ++n) _Pragma("unroll") for (int k = 0; k < 2; ++k) dst[n][k] = *(const LAS bf16x8*)(lds + PG8_SB(b, h) + boff + n * 2048 + k * 1024); } while (0)
#define PG8_MMA(ai, bj, At, Bt) do { __builtin_amdgcn_s_setprio(1); _Pragma("unroll") for (int m = 0; m < 4; ++m) _Pragma("unroll") for (int n = 0; n < 2; ++n) _Pragma("unroll") for (int k = 0; k < 2; ++k) \
        acc[ai][bj][m][n] = __builtin_amdgcn_mfma_f32_16x16x32_bf16(Bt[n][k], At[m][k], acc[ai][bj][m][n], 0, 0, 0); __builtin_amdgcn_s_setprio(0); } while (0)
#define PG8_WAIT_V(n) asm volatile("s_waitcnt vmcnt(" #n ")" ::: "memory")
#define PG8_WAIT_L(n) asm volatile("s_waitcnt lgkmcnt(" #n ")" ::: "memory")
#define PG8_BAR __builtin_amdgcn_s_barrier()
#define PG8_SCHED __builtin_amdgcn_sched_barrier(0)
    Unit cur, nxt; int ui = 0;
    if (!S.next(0, cur)) return;
    f32x4 acc[2][2][4][2];
#pragma unroll
    for (int a = 0; a < 2; ++a)
#pragma unroll
        for (int b = 0; b < 2; ++b)
#pragma unroll
            for (int m = 0; m < 4; ++m)
#pragma unroll
                for (int n = 0; n < 2; ++n) acc[a][b][m][n] = (f32x4){0.f, 0.f, 0.f, 0.f};
    bf16x8 At[4][2], B0[2][2], B1[2][2];
    const char* cA = (const char*)g.A + (size_t)cur.pm * tstep; const char* cB = (const char*)g.Bt + (size_t)cur.pn * tstep;
    PG8_STAGE(PG8_SB(0, 0), cB, voffB); PG8_STAGE(PG8_SA(0, 0), cA, voffA); PG8_STAGE(PG8_SB(0, 1), cB + hstep, voffB); PG8_STAGE(PG8_SA(0, 1), cA + hstep, voffA);
    if (wr == 1) PG8_BAR;
    PG8_WAIT_V(4); PG8_BAR;
    PG8_STAGE(PG8_SB(1, 0), cB + kstep, voffB); PG8_STAGE(PG8_SA(1, 0), cA + kstep, voffA); PG8_STAGE(PG8_SB(1, 1), cB + hstep + kstep, voffB);
    PG8_WAIT_V(6); PG8_BAR;
    for (;;) {
        const bool has_next = S.next(ui + 1, nxt);
        const char* nA = has_next ? (const char*)g.A + (size_t)nxt.pm * tstep : cA; const char* nB = has_next ? (const char*)g.Bt + (size_t)nxt.pn * tstep : cB;
        for (int t = 0; t < nt; t += 2) {
            const bool last = (t == nt - 2);
            const char* a1 = cA + (size_t)(t + 1) * kstep;
            const char* a2 = last ? nA : cA + (size_t)(t + 2) * kstep; const char* b2 = last ? nB : cB + (size_t)(t + 2) * kstep;
            const char* a3 = a2 + kstep; const char* b3 = b2 + kstep;
            PG8_LDB(B0, 0, 0); PG8_SCHED; PG8_LDA(At, 0, 0); PG8_STAGE(PG8_SA(1, 1), a1 + hstep, voffA);
            PG8_WAIT_L(8); PG8_BAR; PG8_WAIT_L(0); PG8_MMA(0, 0, At, B0); PG8_BAR; PG8_SCHED;
            PG8_LDB(B1, 0, 1); PG8_STAGE(PG8_SB(0, 0), b2, voffB);
            PG8_BAR; PG8_WAIT_L(0); PG8_MMA(0, 1, At, B1); PG8_BAR;
            PG8_LDA(At, 0, 1); PG8_STAGE(PG8_SA(0, 0), a2, voffA);
            PG8_BAR; PG8_WAIT_L(0); PG8_MMA(1, 0, At, B0); PG8_BAR; PG8_SCHED;
            PG8_STAGE(PG8_SB(0, 1), b2 + hstep, voffB);
            PG8_WAIT_V(6); PG8_BAR; PG8_MMA(1, 1, At, B1); PG8_BAR;
            PG8_LDB(B0, 1, 0); PG8_SCHED; PG8_LDA(At, 1, 0); PG8_STAGE(PG8_SA(0, 1), a2 + hstep, voffA);
            PG8_WAIT_L(8); PG8_BAR; PG8_WAIT_L(0); PG8_MMA(0, 0, At, B0); PG8_BAR; PG8_SCHED;
            PG8_LDB(B1, 1, 1); PG8_STAGE(PG8_SB(1, 0), b3, voffB);
            PG8_BAR; PG8_WAIT_L(0); PG8_MMA(0, 1, At, B1); PG8_BAR;
            PG8_LDA(At, 1, 1); PG8_STAGE(PG8_SA(1, 0), a3, voffA);
            PG8_BAR; PG8_WAIT_L(0); PG8_MMA(1, 0, At, B0); PG8_BAR; PG8_SCHED;
            PG8_STAGE(PG8_SB(1, 1), b3 + hstep, voffB);
            PG8_WAIT_V(6); PG8_BAR; PG8_MMA(1, 1, At, B1); PG8_BAR;
        }
        E(acc, cur, wr, wc, fr, fq);
        if (!has_next) break;
#pragma unroll
        for (int a = 0; a < 2; ++a)
#pragma unroll
            for (int b = 0; b < 2; ++b)
#pragma unroll
                for (int m = 0; m < 4; ++m)
#pragma unroll
                    for (int n = 0; n < 2; ++n) acc[a][b][m][n] = (f32x4){0.f, 0.f, 0.f, 0.f};
        cur = nxt; cA = nA; cB = nB; ++ui;
    }
    PG8_WAIT_V(0);
    if (wr == 0) PG8_BAR;
    PG8_BAR;
#undef PG8_SA
#undef PG8_SB
#undef PG8_STAGE
#undef PG8_LDA
#undef PG8_LDB
#undef PG8_MMA
#undef PG8_WAIT_V
#undef PG8_WAIT_L
#undef PG8_BAR
#undef PG8_SCHED
}
}
using pg8::Unit;

__device__ __forceinline__ void load_rstd8(const float* SS, int row0, int fr, int fq, float (&rstd)[8]) {
    const int ln = fq * 16 + fr;
    f32x4 q[8];
    const float* p0 = SS + (size_t)row0 * 16 + fq * 4;
#pragma unroll
    for (int i = 0; i < 8; ++i) q[i] = *(const f32x4*)(p0 + ((i >> 2) * 128 + (i & 3) * 16) * 16);
#pragma unroll
    for (int i = 0; i < 8; ++i) { float s = (q[i][0] + q[i][1]) + (q[i][2] + q[i][3]); s += shx(s, ln, 16); s += shx(s, ln, 32); rstd[i] = __builtin_amdgcn_rsqf(s * (1.0f / 1024.0f) + 1e-6f); }
}

struct EpiZ {
    static constexpr bool PERM = true;
    bf16_t* Z; const float* SS; const float* COS; const float* SIN;
    __device__ __forceinline__ void operator()(const f32x4 (&acc)[2][2][4][2], const Unit& u, int wr, int wc, int fr, int fq) const {
        { const int l_ = lane_now(); fr = l_ & 15; fq = l_ >> 4; }
        const int row0 = u.pm * 256 + wr * 64 + fr, pn = u.pn, colw = wc * 32 + 8 * fq;
        float rs[8]; load_rstd8(SS, row0, fr, fq, rs);
#pragma unroll
        for (int ai = 0; ai < 2; ++ai)
#pragma unroll
            for (int m = 0; m < 4; ++m) {
                const int row = row0 + ai * 128 + m * 16;
                const float rstd = rs[ai * 4 + m];
                bf16_t* rowp = Z + (size_t)row * INW + pn * 256 + colw;
                if (pn >= 2 && pn < 6) {
                    const int i1 = 16 * wc + 4 * fq;
                    const f32x4 cs = *(const f32x4*)(COS + (size_t)row * 64 + i1), sn = *(const f32x4*)(SIN + (size_t)row * 64 + i1);
                    const float sc = rstd * (pn >= 4 ? 0.08838834764831845f : 1.0f);
#pragma unroll
                    for (int bj = 0; bj < 2; ++bj) {
                        const f32x4 x1 = acc[ai][bj][m][0] * sc, x2 = acc[ai][bj][m][1] * sc;
                        const f32x4 o1 = x1 * cs - x2 * sn, o2 = x1 * sn + x2 * cs;
                        *(u32x4*)(rowp + bj * 128) = pack8(o1, o2);
                    }
                } else {
#pragma unroll
                    for (int bj = 0; bj < 2; ++bj) {
                        f32x4 v0 = acc[ai][bj][m][0], v1 = acc[ai][bj][m][1];
                        const float nrl = rstd * -1.4426950408889634f;
                        if (pn >= 14) {
#pragma unroll
                            for (int j = 0; j < 4; ++j) { v0[j] = sigmoid_sc(v0[j], nrl); v1[j] = sigmoid_sc(v1[j], nrl); }
                        } else if (pn >= 10) {
#pragma unroll
                            for (int j = 0; j < 4; ++j) { v0[j] = v0[j] * rstd * sigmoid_sc(v0[j], nrl); v1[j] = v1[j] * rstd * sigmoid_sc(v1[j], nrl); }
                        } else { v0 = v0 * rstd; v1 = v1 * rstd; }
                        *(u32x4*)(rowp + bj * 128) = pack8(v0, v1);
                    }
                }
            }
    }
};
struct EpiSwiGLU {
    static constexpr bool PERM = true;
    bf16_t* ACT; const float* SS;
    __device__ __forceinline__ void operator()(const f32x4 (&acc)[2][2][4][2], const Unit& u, int wr, int wc, int fr, int fq) const {
        { const int l_ = lane_now(); fr = l_ & 15; fq = l_ >> 4; }
        const int row0 = u.pm * 256 + wr * 64 + fr, col = u.pn * 128 + wc * 32 + 8 * fq;
        float rs[8]; load_rstd8(SS, row0, fr, fq, rs);
#pragma unroll
        for (int ai = 0; ai < 2; ++ai)
#pragma unroll
            for (int m = 0; m < 4; ++m) {
                const int row = row0 + ai * 128 + m * 16;
                const float rstd = rs[ai * 4 + m];
                f32x4 o[2];
                const float r2 = rstd * rstd, nrl = rstd * -1.4426950408889634f;
#pragma unroll
                for (int n = 0; n < 2; ++n) { const f32x4 gt = acc[ai][0][m][n], up = acc[ai][1][m][n];
#pragma unroll
                    for (int j = 0; j < 4; ++j) o[n][j] = (gt[j] * up[j]) * (r2 * sigmoid_sc(gt[j], nrl)); }
                *(u32x4*)(ACT + (size_t)row * DFF + col) = pack8(o[0], o[1]);
            }
    }
};
template <int MODE> struct EpiGen {
    static constexpr bool PERM = true;
    bf16_t* O; const bf16_t* T; const bf16_t* G; const float* SS;
    __device__ __forceinline__ void operator()(const f32x4 (&acc)[2][2][4][2], const Unit& u, int wr, int wc, int fr, int fq) const {
        { const int l_ = lane_now(); fr = l_ & 15; fq = l_ >> 4; }
        const int row0 = u.pm * 256 + wr * 64 + fr, col0 = u.pn * 256 + wc * 32 + 8 * fq;
        if (MODE == 2) {
            float rs[8]; load_rstd8(SS, row0, fr, fq, rs);
#pragma unroll
            for (int rg = 0; rg < 8; ++rg) {
                const int ai = rg >> 2, m = rg & 3, row = row0 + ai * 128 + m * 16; const float rstd = rs[rg];
#pragma unroll
                for (int bj = 0; bj < 2; ++bj) {
                    f32x4 v0 = acc[ai][bj][m][0], v1 = acc[ai][bj][m][1];
#pragma unroll
                    for (int j = 0; j < 4; ++j) { v0[j] = sigmoid_sc(v0[j], rstd * -1.4426950408889634f); v1[j] = sigmoid_sc(v1[j], rstd * -1.4426950408889634f); }
                    *(u32x4*)(O + (size_t)row * DM + col0 + bj * 128) = pack8(v0, v1);
                }
            }
        } else {
            constexpr int NB = (MODE == 1) ? 2 : 1, RGP = 8 / NB;
#pragma unroll
            for (int b = 0; b < NB; ++b) {
                u32x4 gw[RGP][2], tw[RGP][2];
#pragma unroll
                for (int q = 0; q < RGP; ++q)
#pragma unroll
                    for (int bj = 0; bj < 2; ++bj) {
                        const int rg = b * RGP + q, row = row0 + (rg >> 2) * 128 + (rg & 3) * 16, col = col0 + bj * 128;
                        gw[q][bj] = *(const u32x4*)(G + (size_t)row * INW + col);
                        if (MODE == 1) tw[q][bj] = *(const u32x4*)(T + (size_t)row * DM + col);
                    }
#pragma unroll
                for (int q = 0; q < RGP; ++q)
#pragma unroll
                    for (int bj = 0; bj < 2; ++bj) {
                        const int rg = b * RGP + q, ai = rg >> 2, m = rg & 3, row = row0 + ai * 128 + m * 16, col = col0 + bj * 128;
                        f32x4 v0 = acc[ai][bj][m][0] * unpack_lo4(gw[q][bj]), v1 = acc[ai][bj][m][1] * unpack_hi4(gw[q][bj]);
                        if (MODE == 1) { v0 = v0 + unpack_lo4(tw[q][bj]); v1 = v1 + unpack_hi4(tw[q][bj]); }
                        *(u32x4*)(O + (size_t)row * DM + col) = pack8(v0, v1);
                    }
                asm volatile("" ::: "memory");
            }
        }
    }
};
template <bool MUL, bool SRC32> struct EpiResid {
    static constexpr bool PERM = true;
    const float* x32; const bf16_t* xb; bf16_t* XBo; float* SSo; const bf16_t* T;
    __device__ __forceinline__ void operator()(const f32x4 (&acc)[2][2][4][2], const Unit& u, int wr, int wc, int fr, int fq) const {
        { const int l_ = lane_now(); fr = l_ & 15; fq = l_ >> 4; }
        const int row0 = u.pm * 256 + wr * 64 + fr, col0 = u.pn * 256 + wc * 32 + 8 * fq;
        constexpr int NB = SRC32 ? 4 : (MUL ? 2 : 1), RG_PER = 8 / NB;
#pragma unroll
        for (int b = 0; b < NB; ++b) {
            f32x4 xr[RG_PER][2][2]; u32x4 xw[RG_PER][2], tw[RG_PER][2];
#pragma unroll
            for (int q = 0; q < RG_PER; ++q)
#pragma unroll
                for (int bj = 0; bj < 2; ++bj) {
                    const int rg = b * RG_PER + q;
                    const size_t off = (size_t)(row0 + (rg >> 2) * 128 + (rg & 3) * 16) * DM + col0 + bj * 128;
                    if (SRC32) { xr[q][bj][0] = *(const f32x4*)(x32 + off); xr[q][bj][1] = *(const f32x4*)(x32 + off + 4); } else xw[q][bj] = *(const u32x4*)(xb + off);
                    if (MUL) tw[q][bj] = *(const u32x4*)(T + off);
                }
#pragma unroll
            for (int q = 0; q < RG_PER; ++q) {
                const int rg = b * RG_PER + q, ai = rg >> 2, m = rg & 3, row = row0 + ai * 128 + m * 16;
                float ss = 0.f;
#pragma unroll
                for (int bj = 0; bj < 2; ++bj) {
                    const size_t off = (size_t)row * DM + col0 + bj * 128;
                    f32x4 v0 = acc[ai][bj][m][0], v1 = acc[ai][bj][m][1];
                    if (MUL) { v0 = v0 * unpack_lo4(tw[q][bj]); v1 = v1 * unpack_hi4(tw[q][bj]); }
                    if (SRC32) { v0 = v0 + xr[q][bj][0]; v1 = v1 + xr[q][bj][1]; } else { v0 = v0 + unpack_lo4(xw[q][bj]); v1 = v1 + unpack_hi4(xw[q][bj]); }
                    *(u32x4*)(XBo + off) = pack8(v0, v1);
                    ss += (v0[0] * v0[0] + v0[1] * v0[1]) + (v0[2] * v0[2] + v0[3] * v0[3]) + (v1[0] * v1[0] + v1[1] * v1[1]) + (v1[2] * v1[2] + v1[3] * v1[3]);
                }
                { const int ln = fq * 16 + fr; ss += shx(ss, ln, 16); ss += shx(ss, ln, 32); }
                if (fq == 0) SSo[(size_t)row * 16 + u.pn * 4 + wc] = ss;
            }
            asm volatile("" ::: "memory");
        }
    }
};

struct EpiStore {
    static constexpr bool PERM = true;
    bf16_t* O;
    __device__ __forceinline__ void operator()(const f32x4 (&acc)[2][2][4][2], const Unit& u, int wr, int wc, int fr, int fq) const {
        { const int l_ = lane_now(); fr = l_ & 15; fq = l_ >> 4; }
        const int row0 = u.pm * 256 + wr * 64 + fr, col0 = u.pn * 256 + wc * 32 + 8 * fq;
#pragma unroll
        for (int ai = 0; ai < 2; ++ai)
#pragma unroll
            for (int m = 0; m < 4; ++m)
#pragma unroll
                for (int bj = 0; bj < 2; ++bj)
                    *(u32x4*)(O + (size_t)(row0 + ai * 128 + m * 16) * DM + col0 + bj * 128) = pack8(acc[ai][bj][m][0], acc[ai][bj][m][1]);
    }
};
struct EpiPle {
    static constexpr bool PERM = true;
    const bf16_t* xb; bf16_t* XBo; float* SSo; const bf16_t* PJ; const float* SS;
    __device__ __forceinline__ void operator()(const f32x4 (&acc)[2][2][4][2], const Unit& u, int wr, int wc, int fr, int fq) const {
        { const int l_ = lane_now(); fr = l_ & 15; fq = l_ >> 4; }
        const int row0 = u.pm * 256 + wr * 64 + fr, col0 = u.pn * 256 + wc * 32 + 8 * fq;
        float rs[8]; load_rstd8(SS, row0, fr, fq, rs);
#pragma unroll
        for (int b = 0; b < 2; ++b) {
            u32x4 xw[4][2], pw[4][2];
#pragma unroll
            for (int q = 0; q < 4; ++q)
#pragma unroll
                for (int bj = 0; bj < 2; ++bj) { const size_t off = (size_t)(row0 + b * 128 + q * 16) * DM + col0 + bj * 128; xw[q][bj] = *(const u32x4*)(xb + off); pw[q][bj] = *(const u32x4*)(PJ + off); }
#pragma unroll
            for (int q = 0; q < 4; ++q) {
                const int row = row0 + b * 128 + q * 16; const float nrl = rs[b * 4 + q] * -1.4426950408889634f;
                float ss = 0.f;
#pragma unroll
                for (int bj = 0; bj < 2; ++bj) {
                    const size_t off = (size_t)row * DM + col0 + bj * 128;
                    f32x4 v0 = acc[b][bj][q][0], v1 = acc[b][bj][q][1];
#pragma unroll
                    for (int j = 0; j < 4; ++j) { v0[j] = sigmoid_sc(v0[j], nrl); v1[j] = sigmoid_sc(v1[j], nrl); }
                    v0 = v0 * unpack_lo4(pw[q][bj]) + unpack_lo4(xw[q][bj]); v1 = v1 * unpack_hi4(pw[q][bj]) + unpack_hi4(xw[q][bj]);
                    *(u32x4*)(XBo + off) = pack8(v0, v1);
                    ss += (v0[0] * v0[0] + v0[1] * v0[1]) + (v0[2] * v0[2] + v0[3] * v0[3]) + (v1[0] * v1[0] + v1[1] * v1[1]) + (v1[2] * v1[2] + v1[3] * v1[3]);
                }
                { const int ln = fq * 16 + fr; ss += shx(ss, ln, 16); ss += shx(ss, ln, 32); }
                if (fq == 0) SSo[(size_t)row * 16 + u.pn * 4 + wc] = ss;
            }
            asm volatile("" ::: "memory");
        }
    }
};

struct Params { const float* in[19]; float* out; unsigned char* ws; int ph_lo, ph_hi; };
typedef const __attribute__((address_space(4))) Params* KPtr;
struct Ctx {
    KPtr P; float* out; unsigned char* ws; int wv, bid, G;
    __device__ __forceinline__ int ftid() const { return wv * 64 + lane_now(); }
    __device__ __forceinline__ bf16_t* W(int layer, size_t off) const { return (bf16_t*)(ws + WS_W + (size_t)layer * W_LAYER + off); }
    __device__ __forceinline__ float* COS() const { return (float*)(ws + WS_COS); }
    __device__ __forceinline__ float* SIN() const { return (float*)(ws + WS_SIN); }
    __device__ __forceinline__ bf16_t* XB(int i) const { return (bf16_t*)(ws + WS_XB + (size_t)i * SEQ * DM * 2); }
    __device__ __forceinline__ float* SS(int i) const { return (float*)(ws + WS_SS + (size_t)i * SEQ * 16 * 4); }
    __device__ __forceinline__ bf16_t* Z() const { return (bf16_t*)(ws + WS_Z); }
    __device__ __forceinline__ bf16_t* KV() const { return (bf16_t*)(ws + WS_KV); }
    __device__ __forceinline__ bf16_t* TMP() const { return (bf16_t*)(ws + WS_KV); }
    __device__ __forceinline__ bf16_t* MG() const { return (bf16_t*)(ws + WS_KV + (size_t)SEQ * DM * 2); }
    __device__ __forceinline__ bf16_t* PA() const { return (bf16_t*)(ws + WS_PA); }
    __device__ __forceinline__ bf16_t* RG() const { return (bf16_t*)(ws + WS_RG); }
    __device__ __forceinline__ bf16_t* PROJ() const { return (bf16_t*)(ws + WS_PROJ); }
    __device__ __forceinline__ bf16_t* PB(int layer) const { return (bf16_t*)(ws + WS_PB + (size_t)layer * SEQ * PLE * 2); }
    __device__ __forceinline__ const float* xin(int s) const { return s == 0 ? P->in[0] : P->in[1] + (size_t)(s - 1) * SEQ * DM; }
    __device__ __forceinline__ const float* pin(int s, int layer) const { return s == 0 ? P->in[2] + (size_t)layer * SEQ * PLE : P->in[3] + (size_t)(layer * 2 + (s - 1)) * SEQ * PLE; }
    __device__ __forceinline__ float* xout(int s) const { return out + (size_t)s * SEQ * DM; }
};

__device__ __forceinline__ int dperm(int c) { return ((c >> 2) & 1) * 64 + 16 * (c >> 5) + 4 * ((c >> 3) & 3) + (c & 3); }
struct MatDesc { const float* W; int ldw, K, N; bf16_t* out; const float* gk; const float* gn; int cm; };
__device__ __forceinline__ MatDesc mat_desc(const Ctx& C, int l, int j) {
    switch (j) {
    case 0: return MatDesc{C.P->in[5] + (size_t)l * DM * INW, INW, DM, INW, C.W(l, W_IN), C.P->in[4] + l * DM, nullptr, 1};
    case 1: return MatDesc{C.P->in[9] + (size_t)l * 512 * DM, DM, 512, DM, C.W(l, W_PO), nullptr, nullptr, 0};
    case 2: return MatDesc{C.P->in[10] + (size_t)l * DM * DM, DM, DM, DM, C.W(l, W_RO), nullptr, nullptr, 0};
    case 3: return MatDesc{C.P->in[11] + (size_t)l * DM * DM, DM, DM, DM, C.W(l, W_O), nullptr, nullptr, 0};
    case 4: return MatDesc{C.P->in[13] + (size_t)l * DM * INW, INW, DM, INW, C.W(l, W_FFI), C.P->in[12] + l * DM, nullptr, 2};
    case 5: return MatDesc{C.P->in[14] + (size_t)l * DFF * DM, DM, DFF, DM, C.W(l, W_FFO), nullptr, nullptr, 0};
    case 6: return MatDesc{C.P->in[16] + (size_t)l * DM * DM, DM, DM, DM, C.W(l, W_PG), C.P->in[15] + l * DM, nullptr, 0};
    case 7: return MatDesc{C.P->in[17] + (size_t)l * PLE * DM, DM, PLE, DM, C.W(l, W_PP), nullptr, nullptr, 0};
    default: { const int g = j - 8; return MatDesc{C.P->in[6] + (size_t)(l * 4 + g) * 128 * 128, 128, 128, 128, C.W(l, W_PW) + g * 128 * 128, nullptr, C.P->in[7] + l * 512 + g * 128, 0}; }
    }
}
__device__ __forceinline__ int mat_items(int j) { return (j == 0 || j == 4) ? (DM / 32) * INW : (j == 1) ? (512 / 32) * DM : (j == 5) ? (DFF / 32) * DM : (j == 7) ? (PLE / 32) * DM : (j >= 8) ? (128 / 32) * 128 : (DM / 32) * DM; }
__device__ void conv_range(const Ctx& C, int l, int jlo, int jhi, int w, int nw) {
    int total = 0;
    for (int j = jlo; j < jhi; ++j) total += mat_items(j);
    for (int it0 = w; it0 < total; it0 += nw) {
        int it = it0, j = jlo;
        for (; j < jhi - 1; ++j) { const int cnt = mat_items(j); if (it < cnt) break; it -= cnt; }
        const MatDesc md = mat_desc(C, l, j);
        const int N = md.N, K = md.K, kb = it / N, n = it - kb * N, k0 = kb * 32;
        int src = n;
        if (md.cm == 1) { if (n >= 512 && n < 1536) { const int sec = (n - 512) >> 7, c = (n - 512) & 127; src = 512 + sec * 128 + dperm(c); } }
        if (md.cm == 2) { const int pn = n >> 8, r = n & 255; src = (r < 128) ? (128 * pn + r) : (DFF + 128 * pn + (r - 128)); }
        const float sn = md.gn ? md.gn[n] : 1.0f;
        const float* wp = md.W + (size_t)k0 * md.ldw + src;
        float v[32];
#pragma unroll
        for (int i = 0; i < 32; ++i) v[i] = wp[(size_t)i * md.ldw];
        if (md.gk) {
#pragma unroll
            for (int i = 0; i < 32; i += 4) { const f32x4 g4 = *(const f32x4*)(md.gk + k0 + i); v[i] *= g4[0]; v[i + 1] *= g4[1]; v[i + 2] *= g4[2]; v[i + 3] *= g4[3]; }
        }
        u32x4* op = (u32x4*)(md.out + (size_t)n * K + k0);
#pragma unroll
        for (int i = 0; i < 4; ++i) { u32x4 wv; wv.x = cvt_pk_bf16(v[8 * i] * sn, v[8 * i + 1] * sn); wv.y = cvt_pk_bf16(v[8 * i + 2] * sn, v[8 * i + 3] * sn);
            wv.z = cvt_pk_bf16(v[8 * i + 4] * sn, v[8 * i + 5] * sn); wv.w = cvt_pk_bf16(v[8 * i + 6] * sn, v[8 * i + 7] * sn); op[i] = wv; }
    }
}
__device__ void phase_p0(const Ctx& C, LAS unsigned char* lds) {
    (void)lds;
    {
        const int w = C.bid * 512 + C.ftid(), nw = C.G * 512;
        conv_range(C, 0, 0, 4, w, nw); conv_range(C, 0, 8, 12, w, nw); conv_range(C, 1, 8, 12, w, nw);
        if (C.G != 256) { conv_range(C, 0, 4, 8, w, nw); conv_range(C, 1, 0, 8, w, nw); }
    }
    float* COS = C.COS(); float* SIN = C.SIN();
    for (int e = C.bid * 512 + C.ftid(); e < SEQ * 64; e += C.G * 512) {
        const int pos = e >> 6, i = e & 63;
        double inv = 1.0; for (int k = 0; k < i; ++k) inv *= 0.8659643233600653;
        const double x = (double)pos * inv;
        const double n = rint(x * 0.15915494309189535);
        const double r = fma(-n, 2.4492935982947064e-16, fma(-n, 6.283185307179586, x));
        const double r2 = r * r;
        double s = 1.0, c = 1.0;
#pragma unroll
        for (int k = 17; k >= 1; --k) { s = 1.0 - s * r2 * (1.0 / (double)((2 * k) * (2 * k + 1))); c = 1.0 - c * r2 * (1.0 / (double)((2 * k - 1) * (2 * k))); }
        COS[e] = (float)c; SIN[e] = (float)(s * r);
    }
}
__device__ void phase_rows(const Ctx& C, int s_fin, int s_pre) {
    const int tid0 = C.ftid(), wid = tid0 >> 6, lane = tid0 & 63;
    float* SS0 = C.SS(0); bf16_t* XB0 = C.XB(0);
    for (int row = C.bid * 8 + wid; row < SEQ; row += C.G * 8) {
        if (s_fin >= 0) {
            float* x = C.xout(s_fin) + (size_t)row * DM; const float* gf = C.P->in[18];
            const float rstd = rstd_from_ss(SS0 + (size_t)row * 16);
#pragma unroll
            for (int i = 0; i < 4; ++i) { const int col = lane * 4 + 256 * i; const f32x4 v = unpack4(*(const u32x2*)(XB0 + (size_t)row * DM + col)), g = *(const f32x4*)(gf + col); *(f32x4*)(x + col) = v * rstd * g; }
        }
        if (s_pre >= 0) {
            const float* x = C.xin(s_pre) + (size_t)row * DM; float ss = 0.f;
#pragma unroll
            for (int i = 0; i < 4; ++i) { const int col = lane * 4 + 256 * i; const f32x4 v = *(const f32x4*)(x + col);
                ss += (v[0] * v[0] + v[1] * v[1]) + (v[2] * v[2] + v[3] * v[3]); *(u32x2*)(XB0 + (size_t)row * DM + col) = pack4(v); }
#pragma unroll
            for (int o = 32; o >= 1; o >>= 1) ss += shx(ss, lane, o);
            if (lane < 16) SS0[(size_t)row * 16 + lane] = (lane == 0) ? ss : 0.f;
#pragma unroll
            for (int l = 0; l < 2; ++l) { const f32x4 v = *(const f32x4*)(C.pin(s_pre, l) + (size_t)row * PLE + lane * 4); *(u32x2*)(C.PB(l) + (size_t)row * PLE + lane * 4) = pack4(v); }
        }
    }
}

__device__ __forceinline__ bf16x8 tr_frag(const LAS bf16_t* T, int pitch, int r0, int c0, int fr, int fq) {
#if SLOW_TR
    bf16x8 f;
#pragma unroll
    for (int j = 0; j < 8; ++j) f[j] = (short)T[(r0 + 8 * fq + j) * pitch + c0 + fr];
    return f;
#endif
    const int q = fr >> 2, p = fr & 3;
    const LAS bf16_t* a = T + (r0 + 8 * fq + q) * pitch + c0 + 4 * p;
    const s16x4 lo = __builtin_amdgcn_ds_read_tr16_b64_v4i16((LAS s16x4*)a);
    const s16x4 hi = __builtin_amdgcn_ds_read_tr16_b64_v4i16((LAS s16x4*)(a + 4 * pitch));
    return __builtin_shufflevector(lo, hi, 0, 1, 2, 3, 4, 5, 6, 7);
}
#define MFMA16(a, b, c) __builtin_amdgcn_mfma_f32_16x16x32_bf16((a), (b), (c), 0, 0, 0)

template <int W2> __device__ __forceinline__ void pool_window(const bf16_t* col, int tpos, f32x4& s0, f32x4& s1) {
    u32x4 d[2 * W2];
#pragma unroll
    for (int k = 0; k < 2 * W2; ++k) { const int sp = tpos - W2 + k; const int sc = ((unsigned)sp < (unsigned)SEQ) ? sp : tpos; d[k] = *(const u32x4*)(col + (size_t)sc * INW); }
#pragma unroll
    for (int k = 0; k < 2 * W2; ++k) { const int sp = tpos - W2 + k; const float m = ((unsigned)sp < (unsigned)SEQ) ? 1.0f : 0.0f; s0 = s0 + unpack_lo4(d[k]) * m; s1 = s1 + unpack_hi4(d[k]) * m; }
}
__device__ void phase_a(const Ctx& C, LAS unsigned char* lds, int layer) {
    const int tid = C.ftid(), wid = __builtin_amdgcn_readfirstlane(tid >> 6), lane = tid & 63, fr = lane & 15, fq = lane >> 4;
    LAS bf16_t* Vs = (LAS bf16_t*)lds;
    LAS bf16_t* Kf = Vs + 128 * 264;
    LAS bf16_t* Kb = Kf + 128 * 136;
    const bf16_t* Z = C.Z();
    for (int t = C.bid; t < 1024; t += C.G) {
        __syncthreads();
        if (t < 512) {
            const int c = t >> 2, h = t & 3;
            const float lgf = log2g(C.P->in[8] + layer * 8 + h), lgb = log2g(C.P->in[8] + layer * 8 + 4 + h);
            const bf16_t* zrow = Z + (size_t)(c * 128) * INW;
#pragma unroll
            for (int i = 0; i < 8; ++i) { const int idx = tid + i * 512, r = idx >> 5, v = idx & 31;
                *(LAS u32x4*)(Vs + r * 264 + v * 8) = *(const u32x4*)(zrow + (size_t)r * INW + 1536 + h * 256 + v * 8); }
#pragma unroll
            for (int i = 0; i < 4; ++i) { const int idx = tid + i * 512, r = idx >> 4, v = idx & 15;
                const u32x4 d = *(const u32x4*)(zrow + (size_t)r * INW + 1024 + h * 128 + v * 8);
                const float wf = exp2f(lgf * (float)(127 - r)), wb = exp2f(lgb * (float)r);
                const f32x4 a = unpack_lo4(d), b = unpack_hi4(d);
                *(LAS u32x4*)(Kf + r * 136 + v * 8) = pack8(a * wf, b * wf);
                *(LAS u32x4*)(Kb + r * 136 + v * 8) = pack8(a * wb, b * wb); }
            __syncthreads();
            f32x4 acc[2][8][2];
#pragma unroll
            for (int a = 0; a < 2; ++a)
#pragma unroll
                for (int b = 0; b < 8; ++b) { acc[a][b][0] = (f32x4){0.f, 0.f, 0.f, 0.f}; acc[a][b][1] = (f32x4){0.f, 0.f, 0.f, 0.f}; }
#pragma unroll 1
            for (int kk = 0; kk < 4; ++kk) {
                int fr = lane & 15, fq = lane >> 4; asm volatile("" : "+v"(fr), "+v"(fq));
                bf16x8 vf[2];
#pragma unroll
                for (int et = 0; et < 2; ++et) vf[et] = tr_frag(Vs, 264, 32 * kk, 32 * wid + 16 * et, fr, fq);
#pragma unroll
                for (int dir = 0; dir < 2; ++dir)
#pragma unroll
                    for (int dt = 0; dt < 8; ++dt) {
                        const bf16x8 kf = tr_frag(dir ? Kb : Kf, 136, 32 * kk, 16 * dt, fr, fq);
                        acc[dir][dt][0] = MFMA16(kf, vf[0], acc[dir][dt][0]);
                        acc[dir][dt][1] = MFMA16(kf, vf[1], acc[dir][dt][1]);
                    }
            }
            bf16_t* KV = C.KV();
#pragma unroll
            for (int dir = 0; dir < 2; ++dir)
#pragma unroll
                for (int dt = 0; dt < 8; ++dt)
#pragma unroll
                    for (int et = 0; et < 2; ++et) {
                        const int e = 32 * wid + 16 * et + fr, d = 16 * dt + 4 * fq;
                        *(u32x2*)(KV + ((size_t)(((c * 4 + h) * 2 + dir) * 256 + e)) * 128 + d) = pack4(acc[dir][dt][et]);
                    }
        } else {
            const int pt = t - 512, tb = pt >> 2, g = (pt >= 256) ? 3 - (pt & 3) : (pt & 3), w2 = 1 << g;
            LAS bf16_t* Ds = (LAS bf16_t*)lds;
#pragma unroll 1
            for (int i = 0; i < 4; ++i) {
                const int idx = tid + i * 512, r = idx >> 4, v = idx & 15, tpos = tb * 128 + r;
                const int lo = max(tpos - w2, 0), hi = min(tpos + w2, SEQ);
                const bf16_t* col = Z + g * 128 + v * 8;
                f32x4 s0 = (f32x4){0.f, 0.f, 0.f, 0.f}, s1 = s0;
                if (g == 3) pool_window<8>(col, tpos, s0, s1); else if (g == 2) pool_window<4>(col, tpos, s0, s1); else if (g == 1) pool_window<2>(col, tpos, s0, s1); else pool_window<1>(col, tpos, s0, s1);
                const float inv = 1.0f / (float)(hi - lo);
                const u32x4 d = *(const u32x4*)(col + (size_t)tpos * INW);
                *(LAS u32x4*)(Ds + r * 136 + v * 8) = pack8(s0 * inv - unpack_lo4(d), s1 * inv - unpack_hi4(d));
            }
            __syncthreads();
            const bf16_t* PW = C.W(layer, W_PW) + g * 128 * 128;
            f32x4 acc[8];
#pragma unroll
            for (int dt = 0; dt < 8; ++dt) acc[dt] = (f32x4){0.f, 0.f, 0.f, 0.f};
#pragma unroll 1
            for (int kk = 0; kk < 4; ++kk) {
                const bf16x8 df = *(const LAS bf16x8*)(Ds + (16 * wid + fr) * 136 + 32 * kk + 8 * fq);
#pragma unroll
                for (int dt = 0; dt < 8; ++dt) { const bf16x8 wf = *(const bf16x8*)(PW + (16 * dt + fr) * 128 + 32 * kk + 8 * fq); acc[dt] = MFMA16(wf, df, acc[dt]); }
            }
            bf16_t* PA = C.PA();
            const int row = tb * 128 + 16 * wid + fr;
#pragma unroll
            for (int dt = 0; dt < 8; ++dt) *(u32x2*)(PA + (size_t)row * 512 + g * 128 + 16 * dt + 4 * fq) = pack4(acc[dt]);
        }
    }
}
__device__ void phase_b(const Ctx& C, int layer) {
    u32x4* KV = (u32x4*)C.KV();
    const int tid = C.ftid();
    if (tid >= 128) return;
    for (int it = C.bid * 128 + tid; it < 32768; it += C.G * 128) {
        const int idx = it * 8, h = idx >> 16, dir = (idx >> 15) & 1;
        const float cd = exp2f(log2g(C.P->in[8] + layer * 8 + dir * 4 + h) * 128.0f);
        u32x4* base = KV + it;
        f32x4 ra = (f32x4){0.f, 0.f, 0.f, 0.f}, rb = ra;
        const int c0 = dir ? 127 : 0, st = dir ? -1 : 1;
        for (int cc = 0; cc < 128; cc += 8) { u32x4 v[8];
#pragma unroll
            for (int i = 0; i < 8; ++i) v[i] = base[(size_t)(c0 + st * (cc + i)) * 32768];
#pragma unroll
            for (int i = 0; i < 8; ++i) { base[(size_t)(c0 + st * (cc + i)) * 32768] = pack8(ra, rb); ra = ra * cd + unpack_lo4(v[i]); rb = rb * cd + unpack_hi4(v[i]); } }
    }
}
__device__ void phase_c(const Ctx& C, LAS unsigned char* lds, int layer) {
    const int tid0 = C.ftid(), wid = __builtin_amdgcn_readfirstlane(tid0 >> 6), lane = tid0 & 63;
    LAS bf16_t* Qs = (LAS bf16_t*)lds;
    LAS bf16_t* Ps = Qs + 128 * 136;
    LAS bf16_t* Vs = Ps + 128 * 136;
    LAS float* St = (LAS float*)(Vs + 128 * 264);
    const bf16_t* Z = C.Z(); const bf16_t* KV = C.KV(); bf16_t* RG = C.RG();
    for (int t = C.bid; t < 512; t += C.G) {
        const int c = t >> 2, h = t & 3;
        const float lgf = log2g(C.P->in[8] + layer * 8 + h), lgb = log2g(C.P->in[8] + layer * 8 + 4 + h);
        const bf16_t* zrow = Z + (size_t)(c * 128) * INW;
        const int e0 = 32 * wid;
        int fr = lane & 15, fq = lane >> 4;
        asm volatile("" : "+v"(fr), "+v"(fq));
        bf16x8 sf[2][2][4];
#pragma unroll
        for (int dir = 0; dir < 2; ++dir) {
            const bf16_t* sb = KV + (size_t)(((c * 4 + h) * 2 + dir) * 256) * 128;
#pragma unroll
            for (int et = 0; et < 2; ++et)
#pragma unroll
                for (int kk = 0; kk < 4; ++kk) sf[dir][et][kk] = *(const bf16x8*)(sb + (size_t)(e0 + 16 * et + fr) * 128 + 32 * kk + 8 * fq);
        }
        __syncthreads();
        { const int tid = C.ftid();
#pragma unroll
        for (int i = 0; i < 8; ++i) { const int idx = tid + i * 512, r = idx >> 5, v = idx & 31;
            *(LAS u32x4*)(Vs + r * 264 + v * 8) = *(const u32x4*)(zrow + (size_t)r * INW + 1536 + h * 256 + v * 8); }
#pragma unroll
        for (int i = 0; i < 4; ++i) { const int idx = tid + i * 512, r = idx >> 4, v = idx & 15;
            *(LAS u32x4*)(Qs + r * 136 + v * 8) = *(const u32x4*)(zrow + (size_t)r * INW + 512 + h * 128 + v * 8);
            *(LAS u32x4*)(Ps + r * 136 + v * 8) = *(const u32x4*)(zrow + (size_t)r * INW + 1024 + h * 128 + v * 8); }
        }
        __syncthreads();
        asm volatile("" : "+v"(fr), "+v"(fq));
        f32x4 sc[8];
        {
            const int i0 = 16 * wid;
            bf16x8 qf[4];
#pragma unroll
            for (int kk = 0; kk < 4; ++kk) qf[kk] = *(const LAS bf16x8*)(Qs + (i0 + fr) * 136 + 32 * kk + 8 * fq);
#pragma unroll
            for (int jt = 0; jt < 8; ++jt) {
                f32x4 a = (f32x4){0.f, 0.f, 0.f, 0.f};
#pragma unroll
                for (int kk = 0; kk < 4; ++kk) { const bf16x8 kf = *(const LAS bf16x8*)(Ps + (16 * jt + fr) * 136 + 32 * kk + 8 * fq); a = MFMA16(kf, qf[kk], a); }
                const int i = i0 + fr;
#pragma unroll
                for (int r = 0; r < 4; ++r) { const int j = 16 * jt + 4 * fq + r, dl = i - j; a[r] *= (dl >= 0) ? exp2f(lgf * (float)dl) : exp2f(lgb * (float)(-dl)); }
                sc[jt] = a;
            }
        }
        __syncthreads();
        {
            const int i = 16 * wid + fr;
#pragma unroll
            for (int jt = 0; jt < 8; ++jt) *(LAS u32x2*)(Ps + i * 136 + 16 * jt + 4 * fq) = pack4(sc[jt]);
        }
        __syncthreads();
        asm volatile("" : "+v"(fr), "+v"(fq));
        f32x4 y[8][2];
#pragma unroll
        for (int m = 0; m < 8; ++m) { y[m][0] = (f32x4){0.f, 0.f, 0.f, 0.f}; y[m][1] = (f32x4){0.f, 0.f, 0.f, 0.f}; }
#pragma unroll 1
        for (int kk = 0; kk < 4; ++kk) {
            bf16x8 vf[2];
#pragma unroll
            for (int et = 0; et < 2; ++et) vf[et] = tr_frag(Vs, 264, 32 * kk, e0 + 16 * et, fr, fq);
#pragma unroll
            for (int m = 0; m < 8; ++m) { const bf16x8 pf = *(const LAS bf16x8*)(Ps + (16 * m + fr) * 136 + 32 * kk + 8 * fq);
                y[m][0] = MFMA16(vf[0], pf, y[m][0]); y[m][1] = MFMA16(vf[1], pf, y[m][1]); }
        }
#pragma unroll
        for (int dir = 0; dir < 2; ++dir) {
            asm volatile("" : "+v"(fr), "+v"(fq));
#pragma unroll
            for (int m = 0; m < 8; ++m) {
                f32x4 t0 = (f32x4){0.f, 0.f, 0.f, 0.f}, t1 = t0;
#pragma unroll
                for (int kk = 0; kk < 4; ++kk) { const bf16x8 qq = *(const LAS bf16x8*)(Qs + (16 * m + fr) * 136 + 32 * kk + 8 * fq); t0 = MFMA16(sf[dir][0][kk], qq, t0); t1 = MFMA16(sf[dir][1][kk], qq, t1); }
                const int i = 16 * m + fr;
                const float scl = (dir == 0) ? exp2f(lgf * (float)(i + 1)) : exp2f(lgb * (float)(128 - i));
                y[m][0] = y[m][0] + t0 * scl; y[m][1] = y[m][1] + t1 * scl;
                if (m & 1) asm volatile("" ::: "memory");
            }
        }
        asm volatile("" : "+v"(fr), "+v"(fq));
        u32x2 gsw[8][2];
#pragma unroll
        for (int m = 0; m < 8; ++m)
#pragma unroll
            for (int et = 0; et < 2; ++et) gsw[m][et] = *(const u32x2*)(zrow + (size_t)(16 * m + fr) * INW + 2560 + h * 256 + e0 + 16 * et + 4 * fq);
#pragma unroll
        for (int m = 0; m < 8; ++m) {
            const f32x4 a = y[m][0], b = y[m][1];
            float s = (a[0] + a[1]) + (a[2] + a[3]) + (b[0] + b[1]) + (b[2] + b[3]);
            float q = (a[0] * a[0] + a[1] * a[1]) + (a[2] * a[2] + a[3] * a[3]) + (b[0] * b[0] + b[1] * b[1]) + (b[2] * b[2] + b[3] * b[3]);
            { const int ln = fq * 16 + fr; s += shx(s, ln, 16); s += shx(s, ln, 32); q += shx(q, ln, 16); q += shx(q, ln, 32); }
            if (fq == 0) { St[(16 * m + fr) * 16 + wid * 2] = s; St[(16 * m + fr) * 16 + wid * 2 + 1] = q; }
        }
        __syncthreads();
#pragma unroll
        for (int m = 0; m < 8; ++m) {
            const int i = 16 * m + fr;
            const LAS f32x4* sp = (const LAS f32x4*)(St + i * 16);
            const f32x4 p0 = sp[0], p1 = sp[1], p2 = sp[2], p3 = sp[3];
            const float s = (p0[0] + p0[2]) + (p1[0] + p1[2]) + (p2[0] + p2[2]) + (p3[0] + p3[2]);
            const float q = (p0[1] + p0[3]) + (p1[1] + p1[3]) + (p2[1] + p2[3]) + (p3[1] + p3[3]);
            const float mean = s * (1.0f / 256.0f), var = fmaxf(q * (1.0f / 256.0f) - mean * mean, 0.f);
            const float rstd = __builtin_amdgcn_rsqf(var + 1e-5f);
            const size_t row = (size_t)(c * 128 + i);
#pragma unroll
            for (int et = 0; et < 2; ++et) {
                const int e = e0 + 16 * et + 4 * fq;
                *(u32x2*)(RG + row * DM + h * 256 + e) = pack4((y[m][et] - mean) * rstd * unpack4(gsw[m][et]));
            }
        }
    }
}

__device__ __forceinline__ void run_phase(const Ctx& C, LAS unsigned char* lds, int ph) {
    if (ph == 0) { phase_p0(C, lds); phase_rows(C, -1, 0); return; }
    const int q = ph - 1, s = q / 19, r = q % 19;
    if (r == 18) { phase_rows(C, s, s < 2 ? s + 1 : -1); return; }
    const int layer = r / 9, st = r % 9, cur = layer, G = C.G, bid = C.bid;
    pg8::StaticOrder S;
    switch (st) {
    case 0: { pg8::Gemm g{C.XB(cur), C.W(layer, W_IN), SEQ, INW, DM}; S.init(SEQ, INW, G, bid, 2);
              EpiZ E{C.Z(), C.SS(cur), C.COS(), C.SIN()}; pg8::gemm_phase(C.ftid(), lds, g, S, E);
              if (s == 0 && G == 256 && bid >= 128) conv_range(C, layer, 4, 8, (bid - 128) * 512 + C.ftid(), 128 * 512);
              if (s > 0 && G == 256 && bid >= 128) {
                  pg8::StaticOrder S2; S2.init(SEQ, DM, 128, bid - 128, 0, 0, 1);
                  pg8::Gemm g2{C.PB(layer), C.W(layer, W_PP), SEQ, DM, PLE}; EpiStore E2{C.PROJ()}; pg8::gemm_phase(C.ftid(), lds, g2, S2, E2); } } break;
    case 1: phase_a(C, lds, layer); break;
    case 2: phase_b(C, layer); break;
    case 3: phase_c(C, lds, layer); break;
    case 4: { S.init(SEQ, DM, G, bid);
              { pg8::Gemm g{C.PA(), C.W(layer, W_PO), SEQ, DM, 512}; EpiGen<0> E{C.TMP(), nullptr, C.Z() + 3584, nullptr}; pg8::gemm_phase(C.ftid(), lds, g, S, E); }
              { pg8::Gemm g{C.RG(), C.W(layer, W_RO), SEQ, DM, DM}; EpiGen<1> E{C.MG(), C.TMP(), C.Z() + 3584 + 1024, nullptr}; pg8::gemm_phase(C.ftid(), lds, g, S, E); } } break;
    case 5: { pg8::Gemm g{C.MG(), C.W(layer, W_O), SEQ, DM, DM}; S.init(SEQ, DM, G, bid);
              if (layer == 0) { EpiResid<false, true> E{C.xin(s), nullptr, C.XB(cur ^ 1), C.SS(cur ^ 1), nullptr}; pg8::gemm_phase(C.ftid(), lds, g, S, E); }
              else { EpiResid<false, false> E{nullptr, C.XB(cur), C.XB(cur ^ 1), C.SS(cur ^ 1), nullptr}; pg8::gemm_phase(C.ftid(), lds, g, S, E); } } break;
    case 6: { pg8::Gemm g{C.XB(cur ^ 1), C.W(layer, W_FFI), SEQ, INW, DM}; S.init(SEQ, INW, G, bid);
              EpiSwiGLU E{C.Z(), C.SS(cur ^ 1)}; pg8::gemm_phase(C.ftid(), lds, g, S, E);
              if (s == 0 && layer == 0 && G == 256 && bid >= 128) conv_range(C, 1, 0, 4, (bid - 128) * 512 + C.ftid(), 128 * 512);
              if (G != 256 || bid >= 128) {
                  pg8::StaticOrder S2; if (G == 256) S2.init(SEQ, DM, 128, bid - 128, 0, s > 0 ? 1 : 0); else S2.init(SEQ, DM, G, bid);
                  pg8::Gemm g2{C.PB(layer), C.W(layer, W_PP), SEQ, DM, PLE}; EpiStore E2{C.PROJ()}; pg8::gemm_phase(C.ftid(), lds, g2, S2, E2); } } break;
    case 7: { pg8::Gemm g{C.Z(), C.W(layer, W_FFO), SEQ, DM, DFF}; S.init(SEQ, DM, G, bid);
              EpiResid<false, false> E{nullptr, C.XB(cur ^ 1), C.XB(cur), C.SS(cur), nullptr}; pg8::gemm_phase(C.ftid(), lds, g, S, E); } break;
    default: { S.init(SEQ, DM, G, bid);
              pg8::Gemm g{C.XB(cur), C.W(layer, W_PG), SEQ, DM, DM}; EpiPle E{C.XB(cur), C.XB(cur ^ 1), C.SS(cur ^ 1), C.PROJ(), C.SS(cur)}; pg8::gemm_phase(C.ftid(), lds, g, S, E); } break;
    }
}


#define XB_TMO      128
#define XB_XCNT(j)  (256  + 64 * (j))
#define XB_XSUB(j)  (1280 + 64 * (j))
#define XB_XGEN(j)  (2304 + 64 * (j))
#define XB_TOP      3328
#define XB_TOPGEN   3392
#define XCD_BAR_WORDS 3456
#define XB_SPIN_CAP (1u << 18)
__device__ __forceinline__ unsigned xb_ld(unsigned* p)              { return __hip_atomic_load(p, __ATOMIC_RELAXED, __HIP_MEMORY_SCOPE_AGENT); }
__device__ __forceinline__ unsigned xb_add(unsigned* p, unsigned v) { return __hip_atomic_fetch_add(p, v, __ATOMIC_RELAXED, __HIP_MEMORY_SCOPE_AGENT); }
__device__ __forceinline__ unsigned xb_xcc_id() { return (unsigned)__builtin_amdgcn_s_getreg((3 << 11) | 20) & 0xFu; }
#define XB_SPIN(cond, bar) do { unsigned _sp = 0; while (cond) { __builtin_amdgcn_s_sleep(1); \
    if ((++_sp & 255u) == 0u) { if (xb_ld(&(bar)[XB_TMO])) break; if (_sp > XB_SPIN_CAP) { atomicAdd(&(bar)[XB_TMO], 1u); break; } } } } while (0)
struct XcdBarrier { unsigned* bar; unsigned x; volatile LAS unsigned* st; };
__device__ __forceinline__ XcdBarrier xcd_barrier_post(unsigned* bar, volatile LAS unsigned* st, bool leader) {
    XcdBarrier b; b.bar = bar; b.x = xb_xcc_id(); b.st = st;
    if (leader) (void)xb_add(&bar[XB_XCNT(b.x)], 1u);
    return b;
}
__device__ __forceinline__ void xcd_barrier_complete(unsigned* bar, unsigned x, unsigned& nloc, unsigned& nx) {
    const unsigned G = gridDim.x * gridDim.y * gridDim.z;
    unsigned sum, cnt, mine, sp = 0u;
    for (;;) {
        sum = 0u; cnt = 0u; mine = 0u;
#pragma unroll
        for (unsigned j = 0; j < 16; ++j) { const unsigned c = xb_ld(&bar[XB_XCNT(j)]); sum += c; cnt += (c > 0u) ? 1u : 0u; mine = (j == x) ? c : mine; }
        if (sum == G) break;
        __builtin_amdgcn_s_sleep(1);
        if ((++sp & 255u) == 0u) { if (xb_ld(&bar[XB_TMO])) break; if (sp > XB_SPIN_CAP) { atomicAdd(&bar[XB_TMO], 1u); break; } }
    }
    nloc = mine > 0u ? mine : 1u; nx = cnt > 0u ? cnt : 1u;
}
__device__ __forceinline__ void xcd_barrier(const XcdBarrier& b, int wv) {
    asm volatile("s_waitcnt vmcnt(0)" ::: "memory");
    __syncthreads();
    if (wv == 0 && lane_now() == 0) {
        unsigned* bar = b.bar;
        __builtin_amdgcn_s_waitcnt(0);
        unsigned nloc = b.st[0], nx = b.st[1];
        if (nloc == 0u) { xcd_barrier_complete(bar, b.x, nloc, nx); b.st[0] = nloc; b.st[1] = nx; }
        const unsigned old = xb_add(&bar[XB_XSUB(b.x)], 1u);
        const unsigned gen = old / nloc;
        if (old + 1u == (gen + 1u) * nloc) {
            __builtin_amdgcn_fence(__ATOMIC_RELEASE, "agent");
            asm volatile("s_waitcnt vmcnt(0)" ::: "memory");
            const unsigned og = xb_add(&bar[XB_TOP], 1u);
            const unsigned tg = og / nx;
            if (og + 1u == (tg + 1u) * nx) xb_add(&bar[XB_TOPGEN], 1u);
            else XB_SPIN(xb_ld(&bar[XB_TOPGEN]) == tg, bar);
            __builtin_amdgcn_fence(__ATOMIC_ACQUIRE, "agent");
            xb_add(&bar[XB_XGEN(b.x)], 1u);
            asm volatile("s_waitcnt vmcnt(0)" ::: "memory");
        } else {
            XB_SPIN(xb_ld(&bar[XB_XGEN(b.x)]) == gen, bar);
            __builtin_amdgcn_fence(__ATOMIC_ACQUIRE, "agent");
            asm volatile("s_waitcnt vmcnt(0)" ::: "memory");
        }
    }
    __syncthreads();
}

__global__ void __launch_bounds__(512, 2) mk_fwd(Params P) {
    extern __shared__ __attribute__((aligned(16))) unsigned char lds_raw[];
    LAS unsigned char* lds = (LAS unsigned char*)lds_raw;
    const int wv0 = __builtin_amdgcn_readfirstlane((int)threadIdx.x >> 6);
    const bool leader0 = (threadIdx.x == 0);
    volatile LAS unsigned* bst = (volatile LAS unsigned*)(lds + LDS_BYTES - 16);
    XcdBarrier bar; bar.bar = (unsigned*)(P.ws + WS_END); bar.x = 0; bar.st = bst;
    if (P.ph_hi - P.ph_lo > 1) {
        if (leader0) { bst[0] = 0u; bst[1] = 0u; }
        __syncthreads();
        bar = xcd_barrier_post((unsigned*)(P.ws + WS_END), bst, leader0);
    }
    for (int ph = P.ph_lo; ph < P.ph_hi; ++ph) {
        int wv = wv0, bid = blockIdx.x, G = gridDim.x;
        asm volatile("" : "+s"(wv), "+s"(bid), "+s"(G));
        KPtr pp = (KPtr)__builtin_amdgcn_kernarg_segment_ptr();
        asm volatile("" : "+s"(pp));
        Ctx C{pp, pp->out, pp->ws, wv, bid, G};
        run_phase(C, lds, ph);
#if REP_MASK
        { int cls; if (ph == 0) cls = 10; else { const int r = (ph - 1) % 19; cls = (r == 18) ? 9 : (r % 9); }
          if ((REP_MASK >> cls) & 1) { __syncthreads(); run_phase(C, lds, ph); } }
#endif
        if (ph + 1 < P.ph_hi) { if (ph == P.ph_lo) cg::this_grid().sync(); else xcd_barrier(bar, wv0); }
    }
}

extern "C" void kernel_launch(void* const* d_in, const int* in_sizes, int n_in, void* d_out, int out_size, void* d_ws, size_t ws_size, hipStream_t stream) {
    static int grid = 0;
    if (grid == 0) {
        if (n_in != 19 || ws_size < WS_END2) { fprintf(stderr, "kernel_launch: unexpected n_in %d / ws %zu (need %zu)\n", n_in, ws_size, (size_t)WS_END); grid = -1; return; }
        int dev = 0, cus = 0, per_cu = 0;
        hipGetDevice(&dev); hipDeviceGetAttribute(&cus, hipDeviceAttributeMultiprocessorCount, dev);
        hipFuncSetAttribute((const void*)mk_fwd, hipFuncAttributeMaxDynamicSharedMemorySize, LDS_BYTES);
        hipOccupancyMaxActiveBlocksPerMultiprocessor(&per_cu, (const void*)mk_fwd, 512, LDS_BYTES);
        if (per_cu < 1) per_cu = 1;
        (void)hipGetLastError();
        grid = cus * per_cu;
    }
    if (grid < 0) return;
    if (hipMemsetAsync((char*)d_ws + WS_END, 0, XCD_BAR_WORDS * 4, stream) != hipSuccess) { fprintf(stderr, "kernel_launch: memset of barrier words failed\n"); return; }
    Params p{};
    for (int i = 0; i < 19; ++i) p.in[i] = (const float*)d_in[i];
    p.out = (float*)d_out; p.ws = (unsigned char*)d_ws;
#if MULTI_LAUNCH
    for (int ph = 0; ph < NPH; ++ph) { p.ph_lo = ph; p.ph_hi = ph + 1; hipLaunchKernelGGL(mk_fwd, dim3(grid), dim3(512), LDS_BYTES, stream, p); }
#else
    p.ph_lo = 0; p.ph_hi = NPH;
    void* args[] = {&p};
    hipError_t e = hipLaunchCooperativeKernel((const void*)mk_fwd, dim3(grid), dim3(512), args, LDS_BYTES, stream);
    if (e != hipSuccess) fprintf(stderr, "cooperative launch failed: %s (grid %d)\n", hipGetErrorString(e), grid);
#endif
}
```

```cpp
#include <hip/hip_runtime.h>
#include <hip/hip_cooperative_groups.h>
#include <cstdio>
namespace cg = cooperative_groups;

#ifndef SLOW_TR
#define SLOW_TR 0
#endif
#ifndef REP_MASK
#define REP_MASK 0
#endif
#ifndef MULTI_LAUNCH
#define MULTI_LAUNCH 0
#endif

#define LAS __attribute__((address_space(3)))
typedef unsigned short bf16_t;
typedef short bf16x8 __attribute__((ext_vector_type(8)));
typedef short s16x4 __attribute__((ext_vector_type(4)));
typedef float f32x4 __attribute__((ext_vector_type(4)));
typedef unsigned u32x4 __attribute__((ext_vector_type(4)));
typedef unsigned u32x2 __attribute__((ext_vector_type(2)));

constexpr int SEQ = 16384, DM = 1024, INW = 5632, DFF = 2816, PLE = 256;
constexpr int NPH = 58;
constexpr size_t W_IN = 0, W_PO = W_IN + (size_t)INW * DM * 2, W_RO = W_PO + (size_t)DM * 512 * 2, W_O = W_RO + (size_t)DM * DM * 2,
                 W_FFI = W_O + (size_t)DM * DM * 2, W_FFO = W_FFI + (size_t)INW * DM * 2, W_PG = W_FFO + (size_t)DM * DFF * 2,
                 W_PP = W_PG + (size_t)DM * DM * 2, W_PW = W_PP + (size_t)DM * PLE * 2, W_LAYER = W_PW + (size_t)4 * 128 * 128 * 2;
constexpr size_t WS_W = 0, WS_COS = WS_W + 2 * W_LAYER, WS_SIN = WS_COS + (size_t)SEQ * 64 * 4, WS_XB = WS_SIN + (size_t)SEQ * 64 * 4,
                 WS_SS = WS_XB + 2 * (size_t)SEQ * DM * 2, WS_Z = WS_SS + 2 * (size_t)SEQ * 16 * 4, WS_KV = WS_Z + (size_t)SEQ * INW * 2,
                 WS_PA = WS_KV + (size_t)128 * 4 * 2 * 256 * 128 * 2, WS_RG = WS_PA + (size_t)SEQ * 512 * 2, WS_PB = WS_RG + (size_t)SEQ * DM * 2,
                 WS_END = WS_PB + 2 * (size_t)SEQ * PLE * 2;
constexpr int LDS_BYTES = 147456;

typedef float f32x2_t __attribute__((ext_vector_type(2)));
typedef __bf16 bf16x2_t __attribute__((ext_vector_type(2)));
__device__ __forceinline__ unsigned cvt_pk_bf16(float lo, float hi) { const f32x2_t v = {lo, hi}; return __builtin_bit_cast(unsigned, __builtin_convertvector(v, bf16x2_t)); }
__device__ __forceinline__ float bf_lo(unsigned u) { return __uint_as_float(u << 16); }
__device__ __forceinline__ float bf_hi(unsigned u) { return __uint_as_float(u & 0xffff0000u); }
__device__ __forceinline__ float sigmoid_f(float x) { return __builtin_amdgcn_rcpf(1.0f + __expf(-x)); }
__device__ __forceinline__ float sigmoid_sc(float v, float nrl) { return __builtin_amdgcn_rcpf(1.0f + __builtin_amdgcn_exp2f(v * nrl)); }
__device__ __forceinline__ float silu_f(float x) { return x * sigmoid_f(x); }
__device__ __forceinline__ u32x2 pack4(f32x4 v) { u32x2 w; w.x = cvt_pk_bf16(v[0], v[1]); w.y = cvt_pk_bf16(v[2], v[3]); return w; }
__device__ __forceinline__ u32x4 pack8(f32x4 a, f32x4 b) { u32x4 w; w.x = cvt_pk_bf16(a[0], a[1]); w.y = cvt_pk_bf16(a[2], a[3]); w.z = cvt_pk_bf16(b[0], b[1]); w.w = cvt_pk_bf16(b[2], b[3]); return w; }
__device__ __forceinline__ f32x4 unpack_lo4(u32x4 w) { return (f32x4){bf_lo(w.x), bf_hi(w.x), bf_lo(w.y), bf_hi(w.y)}; }
__device__ __forceinline__ f32x4 unpack_hi4(u32x4 w) { return (f32x4){bf_lo(w.z), bf_hi(w.z), bf_lo(w.w), bf_hi(w.w)}; }
__device__ __forceinline__ f32x4 unpack4(u32x2 w) { return (f32x4){bf_lo(w.x), bf_hi(w.x), bf_lo(w.y), bf_hi(w.y)}; }
__device__ __forceinline__ float log2g(const float* logit) {
    const float x = *logit, u = __expf(-x);
    float l = u * (1.f - u * (0.5f - u * (0.33333334f - u * (0.25f - u * (0.2f - u * 0.16666667f)))));
    if (u > 0.0625f) l = __logf(1.0f + u);
    return -l * 1.4426950408889634f;
}
__device__ __forceinline__ float rstd_from_ss(const float* ss) {
    const f32x4* sp = (const f32x4*)ss; const f32x4 a = sp[0], b = sp[1], c = sp[2], d = sp[3];
    const f32x4 t = (a + b) + (c + d); const float s = (t[0] + t[1]) + (t[2] + t[3]);
    return __builtin_amdgcn_rsqf(s * (1.0f / 1024.0f) + 1e-6f);
}

__device__ __forceinline__ float shx(float v, int lane, int m) { return __int_as_float(__builtin_amdgcn_ds_bpermute((lane ^ m) << 2, __float_as_int(v))); }
__device__ __forceinline__ int lane_now() { int l; asm volatile("v_mbcnt_lo_u32_b32 %0, -1, 0\n\tv_mbcnt_hi_u32_b32 %0, -1, %0" : "=v"(l)); return l; }
namespace pg8 {
constexpr int BM = 256, BK = 64, HALF = 128, HTB = HALF * BK * 2, STAGE_BYTES = 8 * HTB, NXCD = 8, WGM = 8;
__host__ __device__ __forceinline__ int lds_byte(int r, int c) { const int st = (r >> 4) * 2 + (c >> 5), rr = r & 15, cc = c & 31, ob = rr * 64 + cc * 2; return st * 1024 + (ob ^ (((ob >> 9) & 1) << 5)); }
__host__ __device__ __forceinline__ void stage_rc(int b, int& R, int& C) { const int st = b / 1024, sb = b % 1024, swz = sb ^ (((sb >> 9) & 1) << 5); R = (st >> 1) * 16 + swz / 64; C = (st & 1) * 32 + (swz % 64) / 2; }
__host__ __device__ __forceinline__ int perm32(int rho) { const int n = rho >> 4, i = rho & 15; return 8 * (i >> 2) + 4 * n + (i & 3); }
struct Unit { int pm, pn; };
struct Gemm { const bf16_t* A; const bf16_t* Bt; int M, N, K; };
struct StaticOrder {
    int nM, nN, nwg, G, c, rot;
    __device__ void init(int M, int N, int G_, int c_, int rot_ = 0) { nM = M / BM; nN = N / BM; nwg = nM * nN; G = G_; c = c_; rot = rot_; }
    __device__ bool next(int i, Unit& u) const {
        const long L = (long)i * G + c; if (L >= nwg) return false;
        int wgid = (int)L; { const int q = nwg / NXCD, r = nwg % NXCD, xcd = wgid % NXCD, off = wgid / NXCD; wgid = (xcd < r ? xcd * (q + 1) : r * (q + 1) + (xcd - r) * q) + off; }
        const int nig = WGM * nN, gid = wgid / nig, fm = gid * WGM, gsz = (nM - fm) < WGM ? (nM - fm) : WGM;
        u.pm = fm + ((wgid % nig) % gsz); { const int p = (wgid % nig) / gsz + rot; u.pn = p >= nN ? p - nN : p; } return true;
    }
};
template <class Epi>
__device__ __forceinline__ void gemm_phase(const int tid, LAS unsigned char* lds, const Gemm g, const StaticOrder& S, const Epi& E) {
    const int wid = __builtin_amdgcn_readfirstlane(tid >> 6), lane = tid & 63, wr = wid >> 2, wc = wid & 3, fr = lane & 15, fq = lane >> 4;
    const int K = g.K, nt = K / BK;
    unsigned voffA[2], voffB[2];
#pragma unroll
    for (int i = 0; i < 2; ++i) { int R, C; stage_rc(tid * 16 + i * 8192, R, C); const int Rb = Epi::PERM ? ((R & ~31) + perm32(R & 31)) : R;
        voffA[i] = (unsigned)(R * K + C) * 2u; voffB[i] = (unsigned)(Rb * K + C) * 2u; }
    const size_t kstep = (size_t)(BK * 2);
    const size_t hstep = (size_t)HALF * K * 2;
    const size_t tstep = 2 * hstep;
    const unsigned ldsw = (unsigned)wid * 1024u;
    const int aoff = lds_byte(wr * 64 + fr, fq * 8), boff = lds_byte(wc * 32 + fr, fq * 8);
#define PG8_SA(b, h) (((b) * 2 + (h)) * HTB)
#define PG8_SB(b, h) ((4 + (b) * 2 + (h)) * HTB)
#define PG8_STAGE(bufoff, gbase, voff) do { _Pragma("unroll") for (int _i = 0; _i < 2; ++_i) { unsigned _vo = (voff)[_i]; asm volatile("" : "+v"(_vo)); \
        __builtin_amdgcn_global_load_lds((const unsigned*)((const char*)(gbase) + _vo), (LAS unsigned*)(lds + (bufoff) + ldsw + _i * 8192), 16, 0, 0); } } while (0)
#define PG8_LDA(dst, b, h) do { _Pragma("unroll") for (int m = 0; m < 4; ++m) _Pragma("unroll") for (int k = 0; k < 2; ++k) dst[m][k] = *(const LAS bf16x8*)(lds + PG8_SA(b, h) + aoff + m * 2048 + k * 1024); } while (0)
#define PG8_LDB(dst, b, h) do { _Pragma("unroll") for (int n = 0; n < 2; ++n) _Pragma("unroll") for (int k = 0; k < 2; ++k) dst[n][k] = *(const LAS bf16x8*)(lds + PG8_SB(b, h) + boff + n * 2048 + k * 1024); } while (0)
#define PG8_MMA(ai, bj, At, Bt) do { __builtin_amdgcn_s_setprio(1); _Pragma("unroll") for (int m = 0; m < 4; ++m) _Pragma("unroll") for (int n = 0; n < 2; ++n) _Pragma("unroll") for (int k = 0; k < 2; ++k) \
        acc[ai][bj][m][n] = __builtin_amdgcn_mfma_f32_16x16x32_bf16(Bt[n][k], At[m][k], acc[ai][bj][m][n], 0, 0, 0); __builtin_amdgcn_s_setprio(0); } while (0)
#define PG8_WAIT_V(n) asm volatile("s_waitcnt vmcnt(" #n ")" ::: "memory")
#define PG8_WAIT_L(n) asm volatile("s_waitcnt lgkmcnt(" #n ")" ::: "memory")
#define PG8_BAR __builtin_amdgcn_s_barrier()
#define PG8_SCHED __builtin_amdgcn_sched_barrier(0)
    Unit cur, nxt; int ui = 0;
    if (!S.next(0, cur)) return;
    f32x4 acc[2][2][4][2];
#pragma unroll
    for (int a = 0; a < 2; ++a)
#pragma unroll
        for (int b = 0; b < 2; ++b)
#pragma unroll
            for (int m = 0; m < 4; ++m)
#pragma unroll
                for (int n = 0; n < 2; ++n) acc[a][b][m][n] = (f32x4){0.f, 0.f, 0.f, 0.f};
    bf16x8 At[4][2], B0[2][2], B1[2][2];
    const char* cA = (const char*)g.A + (size_t)cur.pm * tstep; const char* cB = (const char*)g.Bt + (size_t)cur.pn * tstep;
    PG8_STAGE(PG8_SB(0, 0), cB, voffB); PG8_STAGE(PG8_SA(0, 0), cA, voffA); PG8_STAGE(PG8_SB(0, 1), cB + hstep, voffB); PG8_STAGE(PG8_SA(0, 1), cA + hstep, voffA);
    if (wr == 1) PG8_BAR;
    PG8_WAIT_V(4); PG8_BAR;
    PG8_STAGE(PG8_SB(1, 0), cB + kstep, voffB); PG8_STAGE(PG8_SA(1, 0), cA + kstep, voffA); PG8_STAGE(PG8_SB(1, 1), cB + hstep + kstep, voffB);
    PG8_WAIT_V(6); PG8_BAR;
    for (;;) {
        const bool has_next = S.next(ui + 1, nxt);
        const char* nA = has_next ? (const char*)g.A + (size_t)nxt.pm * tstep : cA; const char* nB = has_next ? (const char*)g.Bt + (size_t)nxt.pn * tstep : cB;
        for (int t = 0; t < nt; t += 2) {
            const bool last = (t == nt - 2);
            const char* a1 = cA + (size_t)(t + 1) * kstep;
            const char* a2 = last ? nA : cA + (size_t)(t + 2) * kstep; const char* b2 = last ? nB : cB + (size_t)(t + 2) * kstep;
            const char* a3 = a2 + kstep; const char* b3 = b2 + kstep;
            PG8_LDB(B0, 0, 0); PG8_SCHED; PG8_LDA(At, 0, 0); PG8_STAGE(PG8_SA(1, 1), a1 + hstep, voffA);
            PG8_WAIT_L(8); PG8_BAR; PG8_WAIT_L(0); PG8_MMA(0, 0, At, B0); PG8_BAR; PG8_SCHED;
            PG8_LDB(B1, 0, 1); PG8_STAGE(PG8_SB(0, 0), b2, voffB);
            PG8_BAR; PG8_WAIT_L(0); PG8_MMA(0, 1, At, B1); PG8_BAR;
            PG8_LDA(At, 0, 1); PG8_STAGE(PG8_SA(0, 0), a2, voffA);
            PG8_BAR; PG8_WAIT_L(0); PG8_MMA(1, 0, At, B0); PG8_BAR; PG8_SCHED;
            PG8_STAGE(PG8_SB(0, 1), b2 + hstep, voffB);
            PG8_WAIT_V(6); PG8_BAR; PG8_MMA(1, 1, At, B1); PG8_BAR;
            PG8_LDB(B0, 1, 0); PG8_SCHED; PG8_LDA(At, 1, 0); PG8_STAGE(PG8_SA(0, 1), a2 + hstep, voffA);
            PG8_WAIT_L(8); PG8_BAR; PG8_WAIT_L(0); PG8_MMA(0, 0, At, B0); PG8_BAR; PG8_SCHED;
            PG8_LDB(B1, 1, 1); PG8_STAGE(PG8_SB(1, 0), b3, voffB);
            PG8_BAR; PG8_WAIT_L(0); PG8_MMA(0, 1, At, B1); PG8_BAR;
            PG8_LDA(At, 1, 1); PG8_STAGE(PG8_SA(1, 0), a3, voffA);
            PG8_BAR; PG8_WAIT_L(0); PG8_MMA(1, 0, At, B0); PG8_BAR; PG8_SCHED;
            PG8_STAGE(PG8_SB(1, 1), b3 + hstep, voffB);
            PG8_WAIT_V(6); PG8_BAR; PG8_MMA(1, 1, At, B1); PG8_BAR;
        }
        E(acc, cur, wr, wc, fr, fq);
        if (!has_next) break;
#pragma unroll
        for (int a = 0; a < 2; ++a)
#pragma unroll
            for (int b = 0; b < 2; ++b)
#pragma unroll
                for (int m = 0; m < 4; ++m)
#pragma unroll
                    for (int n = 0; n < 2; ++n) acc[a][b][m][n] = (f32x4){0.f, 0.f, 0.f, 0.f};
        cur = nxt; cA = nA; cB = nB; ++ui;
    }
    PG8_WAIT_V(0);
    if (wr == 0) PG8_BAR;
    PG8_BAR;
#undef PG8_SA
#undef PG8_SB
#undef PG8_STAGE
#undef PG8_LDA
#undef PG8_LDB
#undef PG8_MMA
#undef PG8_WAIT_V
#undef PG8_WAIT_L
#undef PG8_BAR
#undef PG8_SCHED
}
}
using pg8::Unit;

__device__ __forceinline__ void load_rstd8(const float* SS, int row0, int fr, int fq, float (&rstd)[8]) {
    const int ln = fq * 16 + fr;
    f32x4 q[8];
#pragma unroll
    for (int i = 0; i < 8; ++i) q[i] = *(const f32x4*)(SS + (size_t)(row0 + (i >> 2) * 128 + (i & 3) * 16) * 16 + fq * 4);
#pragma unroll
    for (int i = 0; i < 8; ++i) { float s = (q[i][0] + q[i][1]) + (q[i][2] + q[i][3]); s += shx(s, ln, 16); s += shx(s, ln, 32); rstd[i] = __builtin_amdgcn_rsqf(s * (1.0f / 1024.0f) + 1e-6f); }
}

struct EpiZ {
    static constexpr bool PERM = true;
    bf16_t* Z; const float* SS; const float* COS; const float* SIN;
    __device__ __forceinline__ void operator()(const f32x4 (&acc)[2][2][4][2], const Unit& u, int wr, int wc, int fr, int fq) const {
        { const int l_ = lane_now(); fr = l_ & 15; fq = l_ >> 4; }
        const int row0 = u.pm * 256 + wr * 64 + fr, pn = u.pn, colw = wc * 32 + 8 * fq;
        float rs[8]; load_rstd8(SS, row0, fr, fq, rs);
#pragma unroll
        for (int ai = 0; ai < 2; ++ai)
#pragma unroll
            for (int m = 0; m < 4; ++m) {
                const int row = row0 + ai * 128 + m * 16;
                const float rstd = rs[ai * 4 + m];
                bf16_t* rowp = Z + (size_t)row * INW + pn * 256 + colw;
                if (pn >= 2 && pn < 6) {
                    const int i1 = 16 * wc + 4 * fq;
                    const f32x4 cs = *(const f32x4*)(COS + (size_t)row * 64 + i1), sn = *(const f32x4*)(SIN + (size_t)row * 64 + i1);
                    const float sc = rstd * (pn >= 4 ? 0.08838834764831845f : 1.0f);
#pragma unroll
                    for (int bj = 0; bj < 2; ++bj) {
                        const f32x4 x1 = acc[ai][bj][m][0] * sc, x2 = acc[ai][bj][m][1] * sc;
                        const f32x4 o1 = x1 * cs - x2 * sn, o2 = x1 * sn + x2 * cs;
                        *(u32x4*)(rowp + bj * 128) = pack8(o1, o2);
                    }
                } else {
#pragma unroll
                    for (int bj = 0; bj < 2; ++bj) {
                        f32x4 v0 = acc[ai][bj][m][0], v1 = acc[ai][bj][m][1];
                        const float nrl = rstd * -1.4426950408889634f;
                        if (pn >= 14) {
#pragma unroll
                            for (int j = 0; j < 4; ++j) { v0[j] = sigmoid_sc(v0[j], nrl); v1[j] = sigmoid_sc(v1[j], nrl); }
                        } else if (pn >= 10) {
#pragma unroll
                            for (int j = 0; j < 4; ++j) { v0[j] = v0[j] * rstd * sigmoid_sc(v0[j], nrl); v1[j] = v1[j] * rstd * sigmoid_sc(v1[j], nrl); }
                        } else { v0 = v0 * rstd; v1 = v1 * rstd; }
                        *(u32x4*)(rowp + bj * 128) = pack8(v0, v1);
                    }
                }
            }
    }
};
struct EpiSwiGLU {
    static constexpr bool PERM = true;
    bf16_t* ACT; const float* SS;
    __device__ __forceinline__ void operator()(const f32x4 (&acc)[2][2][4][2], const Unit& u, int wr, int wc, int fr, int fq) const {
        { const int l_ = lane_now(); fr = l_ & 15; fq = l_ >> 4; }
        const int row0 = u.pm * 256 + wr * 64 + fr, col = u.pn * 128 + wc * 32 + 8 * fq;
        float rs[8]; load_rstd8(SS, row0, fr, fq, rs);
#pragma unroll
        for (int ai = 0; ai < 2; ++ai)
#pragma unroll
            for (int m = 0; m < 4; ++m) {
                const int row = row0 + ai * 128 + m * 16;
                const float rstd = rs[ai * 4 + m];
                f32x4 o[2];
                const float r2 = rstd * rstd, nrl = rstd * -1.4426950408889634f;
#pragma unroll
                for (int n = 0; n < 2; ++n) { const f32x4 gt = acc[ai][0][m][n], up = acc[ai][1][m][n];
#pragma unroll
                    for (int j = 0; j < 4; ++j) o[n][j] = (gt[j] * up[j]) * (r2 * sigmoid_sc(gt[j], nrl)); }
                *(u32x4*)(ACT + (size_t)row * DFF + col) = pack8(o[0], o[1]);
            }
    }
};
template <int MODE> struct EpiGen {
    static constexpr bool PERM = true;
    bf16_t* O; const bf16_t* T; const bf16_t* G; const float* SS;
    __device__ __forceinline__ void operator()(const f32x4 (&acc)[2][2][4][2], const Unit& u, int wr, int wc, int fr, int fq) const {
        { const int l_ = lane_now(); fr = l_ & 15; fq = l_ >> 4; }
        const int row0 = u.pm * 256 + wr * 64 + fr, col0 = u.pn * 256 + wc * 32 + 8 * fq;
        if (MODE == 2) {
            float rs[8]; load_rstd8(SS, row0, fr, fq, rs);
#pragma unroll
            for (int rg = 0; rg < 8; ++rg) {
                const int ai = rg >> 2, m = rg & 3, row = row0 + ai * 128 + m * 16; const float rstd = rs[rg];
#pragma unroll
                for (int bj = 0; bj < 2; ++bj) {
                    f32x4 v0 = acc[ai][bj][m][0], v1 = acc[ai][bj][m][1];
#pragma unroll
                    for (int j = 0; j < 4; ++j) { v0[j] = sigmoid_sc(v0[j], rstd * -1.4426950408889634f); v1[j] = sigmoid_sc(v1[j], rstd * -1.4426950408889634f); }
                    *(u32x4*)(O + (size_t)row * DM + col0 + bj * 128) = pack8(v0, v1);
                }
            }
        } else {
            constexpr int NB = (MODE == 1) ? 2 : 1, RGP = 8 / NB;
#pragma unroll
            for (int b = 0; b < NB; ++b) {
                u32x4 gw[RGP][2], tw[RGP][2];
#pragma unroll
                for (int q = 0; q < RGP; ++q)
#pragma unroll
                    for (int bj = 0; bj < 2; ++bj) {
                        const int rg = b * RGP + q, row = row0 + (rg >> 2) * 128 + (rg & 3) * 16, col = col0 + bj * 128;
                        gw[q][bj] = *(const u32x4*)(G + (size_t)row * INW + col);
                        if (MODE == 1) tw[q][bj] = *(const u32x4*)(T + (size_t)row * DM + col);
                    }
#pragma unroll
                for (int q = 0; q < RGP; ++q)
#pragma unroll
                    for (int bj = 0; bj < 2; ++bj) {
                        const int rg = b * RGP + q, ai = rg >> 2, m = rg & 3, row = row0 + ai * 128 + m * 16, col = col0 + bj * 128;
                        f32x4 v0 = acc[ai][bj][m][0] * unpack_lo4(gw[q][bj]), v1 = acc[ai][bj][m][1] * unpack_hi4(gw[q][bj]);
                        if (MODE == 1) { v0 = v0 + unpack_lo4(tw[q][bj]); v1 = v1 + unpack_hi4(tw[q][bj]); }
                        *(u32x4*)(O + (size_t)row * DM + col) = pack8(v0, v1);
                    }
                asm volatile("" ::: "memory");
            }
        }
    }
};
template <bool MUL, bool SRC32> struct EpiResid {
    static constexpr bool PERM = true;
    const float* x32; const bf16_t* xb; bf16_t* XBo; float* SSo; const bf16_t* T;
    __device__ __forceinline__ void operator()(const f32x4 (&acc)[2][2][4][2], const Unit& u, int wr, int wc, int fr, int fq) const {
        { const int l_ = lane_now(); fr = l_ & 15; fq = l_ >> 4; }
        const int row0 = u.pm * 256 + wr * 64 + fr, col0 = u.pn * 256 + wc * 32 + 8 * fq;
        constexpr int NB = SRC32 ? 4 : (MUL ? 2 : 1), RG_PER = 8 / NB;
#pragma unroll
        for (int b = 0; b < NB; ++b) {
            f32x4 xr[RG_PER][2][2]; u32x4 xw[RG_PER][2], tw[RG_PER][2];
#pragma unroll
            for (int q = 0; q < RG_PER; ++q)
#pragma unroll
                for (int bj = 0; bj < 2; ++bj) {
                    const int rg = b * RG_PER + q;
                    const size_t off = (size_t)(row0 + (rg >> 2) * 128 + (rg & 3) * 16) * DM + col0 + bj * 128;
                    if (SRC32) { xr[q][bj][0] = *(const f32x4*)(x32 + off); xr[q][bj][1] = *(const f32x4*)(x32 + off + 4); } else xw[q][bj] = *(const u32x4*)(xb + off);
                    if (MUL) tw[q][bj] = *(const u32x4*)(T + off);
                }
#pragma unroll
            for (int q = 0; q < RG_PER; ++q) {
                const int rg = b * RG_PER + q, ai = rg >> 2, m = rg & 3, row = row0 + ai * 128 + m * 16;
                float ss = 0.f;
#pragma unroll
                for (int bj = 0; bj < 2; ++bj) {
                    const size_t off = (size_t)row * DM + col0 + bj * 128;
                    f32x4 v0 = acc[ai][bj][m][0], v1 = acc[ai][bj][m][1];
                    if (MUL) { v0 = v0 * unpack_lo4(tw[q][bj]); v1 = v1 * unpack_hi4(tw[q][bj]); }
                    if (SRC32) { v0 = v0 + xr[q][bj][0]; v1 = v1 + xr[q][bj][1]; } else { v0 = v0 + unpack_lo4(xw[q][bj]); v1 = v1 + unpack_hi4(xw[q][bj]); }
                    *(u32x4*)(XBo + off) = pack8(v0, v1);
                    ss += (v0[0] * v0[0] + v0[1] * v0[1]) + (v0[2] * v0[2] + v0[3] * v0[3]) + (v1[0] * v1[0] + v1[1] * v1[1]) + (v1[2] * v1[2] + v1[3] * v1[3]);
                }
                { const int ln = fq * 16 + fr; ss += shx(ss, ln, 16); ss += shx(ss, ln, 32); }
                if (fq == 0) SSo[(size_t)row * 16 + u.pn * 4 + wc] = ss;
            }
            asm volatile("" ::: "memory");
        }
    }
};

struct Params { const float* in[19]; float* out; unsigned char* ws; int ph_lo, ph_hi; };
typedef const __attribute__((address_space(4))) Params* KPtr;
struct Ctx {
    KPtr P; float* out; unsigned char* ws; int wv, bid, G;
    __device__ __forceinline__ int ftid() const { return wv * 64 + lane_now(); }
    __device__ __forceinline__ bf16_t* W(int layer, size_t off) const { return (bf16_t*)(ws + WS_W + (size_t)layer * W_LAYER + off); }
    __device__ __forceinline__ float* COS() const { return (float*)(ws + WS_COS); }
    __device__ __forceinline__ float* SIN() const { return (float*)(ws + WS_SIN); }
    __device__ __forceinline__ bf16_t* XB(int i) const { return (bf16_t*)(ws + WS_XB + (size_t)i * SEQ * DM * 2); }
    __device__ __forceinline__ float* SS(int i) const { return (float*)(ws + WS_SS + (size_t)i * SEQ * 16 * 4); }
    __device__ __forceinline__ bf16_t* Z() const { return (bf16_t*)(ws + WS_Z); }
    __device__ __forceinline__ bf16_t* KV() const { return (bf16_t*)(ws + WS_KV); }
    __device__ __forceinline__ bf16_t* TMP() const { return (bf16_t*)(ws + WS_KV); }
    __device__ __forceinline__ bf16_t* MG() const { return (bf16_t*)(ws + WS_KV + (size_t)SEQ * DM * 2); }
    __device__ __forceinline__ bf16_t* PA() const { return (bf16_t*)(ws + WS_PA); }
    __device__ __forceinline__ bf16_t* RG() const { return (bf16_t*)(ws + WS_RG); }
    __device__ __forceinline__ bf16_t* PB(int layer) const { return (bf16_t*)(ws + WS_PB + (size_t)layer * SEQ * PLE * 2); }
    __device__ __forceinline__ const float* xin(int s) const { return s == 0 ? P->in[0] : P->in[1] + (size_t)(s - 1) * SEQ * DM; }
    __device__ __forceinline__ const float* pin(int s, int layer) const { return s == 0 ? P->in[2] + (size_t)layer * SEQ * PLE : P->in[3] + (size_t)(layer * 2 + (s - 1)) * SEQ * PLE; }
    __device__ __forceinline__ float* xout(int s) const { return out + (size_t)s * SEQ * DM; }
};

__device__ __forceinline__ int dperm(int c) { return ((c >> 2) & 1) * 64 + 16 * (c >> 5) + 4 * ((c >> 3) & 3) + (c & 3); }
struct MatDesc { const float* W; int ldw, K, N; bf16_t* out; const float* gk; const float* gn; int cm; };
__device__ __forceinline__ MatDesc mat_desc(const Ctx& C, int l, int j) {
    switch (j) {
    case 0: return MatDesc{C.P->in[5] + (size_t)l * DM * INW, INW, DM, INW, C.W(l, W_IN), C.P->in[4] + l * DM, nullptr, 1};
    case 1: return MatDesc{C.P->in[9] + (size_t)l * 512 * DM, DM, 512, DM, C.W(l, W_PO), nullptr, nullptr, 0};
    case 2: return MatDesc{C.P->in[10] + (size_t)l * DM * DM, DM, DM, DM, C.W(l, W_RO), nullptr, nullptr, 0};
    case 3: return MatDesc{C.P->in[11] + (size_t)l * DM * DM, DM, DM, DM, C.W(l, W_O), nullptr, nullptr, 0};
    case 4: return MatDesc{C.P->in[13] + (size_t)l * DM * INW, INW, DM, INW, C.W(l, W_FFI), C.P->in[12] + l * DM, nullptr, 2};
    case 5: return MatDesc{C.P->in[14] + (size_t)l * DFF * DM, DM, DFF, DM, C.W(l, W_FFO), nullptr, nullptr, 0};
    case 6: return MatDesc{C.P->in[16] + (size_t)l * DM * DM, DM, DM, DM, C.W(l, W_PG), C.P->in[15] + l * DM, nullptr, 0};
    case 7: return MatDesc{C.P->in[17] + (size_t)l * PLE * DM, DM, PLE, DM, C.W(l, W_PP), nullptr, nullptr, 0};
    default: { const int g = j - 8; return MatDesc{C.P->in[6] + (size_t)(l * 4 + g) * 128 * 128, 128, 128, 128, C.W(l, W_PW) + g * 128 * 128, nullptr, C.P->in[7] + l * 512 + g * 128, 0}; }
    }
}
__device__ __forceinline__ int mat_items(int j) { return (j == 0 || j == 4) ? (DM / 32) * INW : (j == 1) ? (512 / 32) * DM : (j == 5) ? (DFF / 32) * DM : (j == 7) ? (PLE / 32) * DM : (j >= 8) ? (128 / 32) * 128 : (DM / 32) * DM; }
__device__ void conv_range(const Ctx& C, int l, int jlo, int jhi, int w, int nw) {
    int total = 0;
    for (int j = jlo; j < jhi; ++j) total += mat_items(j);
    for (int it0 = w; it0 < total; it0 += nw) {
        int it = it0, j = jlo;
        for (; j < jhi - 1; ++j) { const int cnt = mat_items(j); if (it < cnt) break; it -= cnt; }
        const MatDesc md = mat_desc(C, l, j);
        const int N = md.N, K = md.K, kb = it / N, n = it - kb * N, k0 = kb * 32;
        int src = n;
        if (md.cm == 1) { if (n >= 512 && n < 1536) { const int sec = (n - 512) >> 7, c = (n - 512) & 127; src = 512 + sec * 128 + dperm(c); } }
        if (md.cm == 2) { const int pn = n >> 8, r = n & 255; src = (r < 128) ? (128 * pn + r) : (DFF + 128 * pn + (r - 128)); }
        const float sn = md.gn ? md.gn[n] : 1.0f;
        const float* wp = md.W + (size_t)k0 * md.ldw + src;
        float v[32];
#pragma unroll
        for (int i = 0; i < 32; ++i) v[i] = wp[(size_t)i * md.ldw];
        if (md.gk) {
#pragma unroll
            for (int i = 0; i < 32; i += 4) { const f32x4 g4 = *(const f32x4*)(md.gk + k0 + i); v[i] *= g4[0]; v[i + 1] *= g4[1]; v[i + 2] *= g4[2]; v[i + 3] *= g4[3]; }
        }
        u32x4* op = (u32x4*)(md.out + (size_t)n * K + k0);
#pragma unroll
        for (int i = 0; i < 4; ++i) { u32x4 wv; wv.x = cvt_pk_bf16(v[8 * i] * sn, v[8 * i + 1] * sn); wv.y = cvt_pk_bf16(v[8 * i + 2] * sn, v[8 * i + 3] * sn);
            wv.z = cvt_pk_bf16(v[8 * i + 4] * sn, v[8 * i + 5] * sn); wv.w = cvt_pk_bf16(v[8 * i + 6] * sn, v[8 * i + 7] * sn); op[i] = wv; }
    }
}
__device__ void phase_p0(const Ctx& C, LAS unsigned char* lds) {
    (void)lds;
    {
        const int w = C.bid * 512 + C.ftid(), nw = C.G * 512;
        conv_range(C, 0, 0, 4, w, nw); conv_range(C, 0, 8, 12, w, nw); conv_range(C, 1, 8, 12, w, nw);
        if (C.G != 256) { conv_range(C, 0, 4, 8, w, nw); conv_range(C, 1, 0, 8, w, nw); }
    }
    float* COS = C.COS(); float* SIN = C.SIN();
    for (int e = C.bid * 512 + C.ftid(); e < SEQ * 64; e += C.G * 512) {
        const int pos = e >> 6, i = e & 63;
        double inv = 1.0; for (int k = 0; k < i; ++k) inv *= 0.8659643233600653;
        const double x = (double)pos * inv;
        const double n = rint(x * 0.15915494309189535);
        const double r = fma(-n, 2.4492935982947064e-16, fma(-n, 6.283185307179586, x));
        const double r2 = r * r;
        double s = 1.0, c = 1.0;
#pragma unroll
        for (int k = 17; k >= 1; --k) { s = 1.0 - s * r2 * (1.0 / (double)((2 * k) * (2 * k + 1))); c = 1.0 - c * r2 * (1.0 / (double)((2 * k - 1) * (2 * k))); }
        COS[e] = (float)c; SIN[e] = (float)(s * r);
    }
}
__device__ void phase_rows(const Ctx& C, int s_fin, int s_pre) {
    const int tid0 = C.ftid(), wid = tid0 >> 6, lane = tid0 & 63;
    float* SS0 = C.SS(0); bf16_t* XB0 = C.XB(0);
    for (int row = C.bid * 8 + wid; row < SEQ; row += C.G * 8) {
        if (s_fin >= 0) {
            float* x = C.xout(s_fin) + (size_t)row * DM; const float* gf = C.P->in[18];
            const float rstd = rstd_from_ss(SS0 + (size_t)row * 16);
#pragma unroll
            for (int i = 0; i < 4; ++i) { const int col = lane * 4 + 256 * i; const f32x4 v = unpack4(*(const u32x2*)(XB0 + (size_t)row * DM + col)), g = *(const f32x4*)(gf + col); *(f32x4*)(x + col) = v * rstd * g; }
        }
        if (s_pre >= 0) {
            const float* x = C.xin(s_pre) + (size_t)row * DM; float ss = 0.f;
#pragma unroll
            for (int i = 0; i < 4; ++i) { const int col = lane * 4 + 256 * i; const f32x4 v = *(const f32x4*)(x + col);
                ss += (v[0] * v[0] + v[1] * v[1]) + (v[2] * v[2] + v[3] * v[3]); *(u32x2*)(XB0 + (size_t)row * DM + col) = pack4(v); }
#pragma unroll
            for (int o = 32; o >= 1; o >>= 1) ss += shx(ss, lane, o);
            if (lane < 16) SS0[(size_t)row * 16 + lane] = (lane == 0) ? ss : 0.f;
#pragma unroll
            for (int l = 0; l < 2; ++l) { const f32x4 v = *(const f32x4*)(C.pin(s_pre, l) + (size_t)row * PLE + lane * 4); *(u32x2*)(C.PB(l) + (size_t)row * PLE + lane * 4) = pack4(v); }
        }
    }
}

__device__ __forceinline__ bf16x8 tr_frag(const LAS bf16_t* T, int pitch, int r0, int c0, int fr, int fq) {
#if SLOW_TR
    bf16x8 f;
#pragma unroll
    for (int j = 0; j < 8; ++j) f[j] = (short)T[(r0 + 8 * fq + j) * pitch + c0 + fr];
    return f;
#endif
    const int q = fr >> 2, p = fr & 3;
    const LAS bf16_t* a = T + (r0 + 8 * fq + q) * pitch + c0 + 4 * p;
    const s16x4 lo = __builtin_amdgcn_ds_read_tr16_b64_v4i16((LAS s16x4*)a);
    const s16x4 hi = __builtin_amdgcn_ds_read_tr16_b64_v4i16((LAS s16x4*)(a + 4 * pitch));
    return __builtin_shufflevector(lo, hi, 0, 1, 2, 3, 4, 5, 6, 7);
}
__device__ __forceinline__ bf16x8 tr_frag_cs(const LAS bf16_t* T, int pitch, int r0, int c0, int fr, int fq) {
    const int q = fr >> 2, p = fr & 3;
    const LAS bf16_t* a = T + (r0 + 8 * fq + q) * pitch + c0 + 8 * p;
    const s16x4 lo = __builtin_amdgcn_ds_read_tr16_b64_v4i16((LAS s16x4*)a);
    const s16x4 hi = __builtin_amdgcn_ds_read_tr16_b64_v4i16((LAS s16x4*)(a + 4 * pitch));
    return __builtin_shufflevector(lo, hi, 0, 1, 2, 3, 4, 5, 6, 7);
}
#define MFMA16(a, b, c) __builtin_amdgcn_mfma_f32_16x16x32_bf16((a), (b), (c), 0, 0, 0)

template <int W2> __device__ __forceinline__ void pool_window(const bf16_t* col, int tpos, f32x4& s0, f32x4& s1) {
    u32x4 d[2 * W2];
#pragma unroll
    for (int k = 0; k < 2 * W2; ++k) { const int sp = tpos - W2 + k; const int sc = ((unsigned)sp < (unsigned)SEQ) ? sp : tpos; d[k] = *(const u32x4*)(col + (size_t)sc * INW); }
#pragma unroll
    for (int k = 0; k < 2 * W2; ++k) { const int sp = tpos - W2 + k; const float m = ((unsigned)sp < (unsigned)SEQ) ? 1.0f : 0.0f; s0 = s0 + unpack_lo4(d[k]) * m; s1 = s1 + unpack_hi4(d[k]) * m; }
}
__device__ void phase_a(const Ctx& C, LAS unsigned char* lds, int layer) {
    const int tid = C.ftid(), wid = __builtin_amdgcn_readfirstlane(tid >> 6), lane = tid & 63, fr = lane & 15, fq = lane >> 4;
    LAS bf16_t* Vs = (LAS bf16_t*)lds;
    LAS bf16_t* Kf = Vs + 128 * 264;
    LAS bf16_t* Kb = Kf + 128 * 136;
    const bf16_t* Z = C.Z();
    for (int t = C.bid; t < 1024; t += C.G) {
        __syncthreads();
        if (t < 512) {
            const int c = t >> 2, h = t & 3;
            const float lgf = log2g(C.P->in[8] + layer * 8 + h), lgb = log2g(C.P->in[8] + layer * 8 + 4 + h);
            const bf16_t* zrow = Z + (size_t)(c * 128) * INW;
#pragma unroll
            for (int i = 0; i < 8; ++i) { const int idx = tid + i * 512, r = idx >> 5, v = idx & 31;
                *(LAS u32x4*)(Vs + r * 264 + v * 8) = *(const u32x4*)(zrow + (size_t)r * INW + 1536 + h * 256 + v * 8); }
#pragma unroll
            for (int i = 0; i < 4; ++i) { const int idx = tid + i * 512, r = idx >> 4, v = idx & 15;
                const u32x4 d = *(const u32x4*)(zrow + (size_t)r * INW + 1024 + h * 128 + v * 8);
                const float wf = exp2f(lgf * (float)(127 - r)), wb = exp2f(lgb * (float)r);
                const f32x4 a = unpack_lo4(d), b = unpack_hi4(d);
                *(LAS u32x4*)(Kf + r * 136 + v * 8) = pack8(a * wf, b * wf);
                *(LAS u32x4*)(Kb + r * 136 + v * 8) = pack8(a * wb, b * wb); }
            __syncthreads();
            const int eq = wid & 3, dh = wid >> 2;
            f32x4 acc[2][4][4];
#pragma unroll
            for (int a = 0; a < 2; ++a)
#pragma unroll
                for (int b = 0; b < 4; ++b)
#pragma unroll
                    for (int e4 = 0; e4 < 4; ++e4) acc[a][b][e4] = (f32x4){0.f, 0.f, 0.f, 0.f};
#pragma unroll 1
            for (int kk = 0; kk < 4; ++kk) {
                int fr = lane & 15, fq = lane >> 4; asm volatile("" : "+v"(fr), "+v"(fq));
                bf16x8 vf[4];
#pragma unroll
                for (int et = 0; et < 4; ++et) vf[et] = tr_frag(Vs, 264, 32 * kk, 64 * eq + 16 * et, fr, fq);
#pragma unroll
                for (int dir = 0; dir < 2; ++dir)
#pragma unroll
                    for (int dt = 0; dt < 4; ++dt) {
                        const bf16x8 kf = tr_frag_cs(dir ? Kb : Kf, 136, 32 * kk, 64 * dh + 32 * (dt >> 1) + 4 * (dt & 1), fr, fq);
#pragma unroll
                        for (int et = 0; et < 4; ++et) acc[dir][dt][et] = MFMA16(kf, vf[et], acc[dir][dt][et]);
                    }
            }
            bf16_t* KV = C.KV();
#pragma unroll
            for (int dir = 0; dir < 2; ++dir)
#pragma unroll
                for (int j = 0; j < 2; ++j)
#pragma unroll
                    for (int et = 0; et < 4; ++et) {
                        const int e = 64 * eq + 16 * et + fr, d = 64 * dh + 32 * j + 8 * fq;
                        *(u32x4*)(KV + ((size_t)(((c * 4 + h) * 2 + dir) * 256 + e)) * 128 + d) = pack8(acc[dir][2 * j][et], acc[dir][2 * j + 1][et]);
                    }
        } else {
            const int pt = t - 512, tb = pt >> 2, g = (pt >= 256) ? 3 - (pt & 3) : (pt & 3), w2 = 1 << g;
            LAS bf16_t* Ds = (LAS bf16_t*)lds;
#pragma unroll 1
            for (int i = 0; i < 4; ++i) {
                const int idx = tid + i * 512, r = idx >> 4, v = idx & 15, tpos = tb * 128 + r;
                const int lo = max(tpos - w2, 0), hi = min(tpos + w2, SEQ);
                const bf16_t* col = Z + g * 128 + v * 8;
                f32x4 s0 = (f32x4){0.f, 0.f, 0.f, 0.f}, s1 = s0;
                if (g == 3) pool_window<8>(col, tpos, s0, s1); else if (g == 2) pool_window<4>(col, tpos, s0, s1); else if (g == 1) pool_window<2>(col, tpos, s0, s1); else pool_window<1>(col, tpos, s0, s1);
                const float inv = 1.0f / (float)(hi - lo);
                const u32x4 d = *(const u32x4*)(col + (size_t)tpos * INW);
                *(LAS u32x4*)(Ds + r * 136 + v * 8) = pack8(s0 * inv - unpack_lo4(d), s1 * inv - unpack_hi4(d));
            }
            __syncthreads();
            const bf16_t* PW = C.W(layer, W_PW) + g * 128 * 128;
            f32x4 acc[8];
#pragma unroll
            for (int dt = 0; dt < 8; ++dt) acc[dt] = (f32x4){0.f, 0.f, 0.f, 0.f};
#pragma unroll 1
            for (int kk = 0; kk < 4; ++kk) {
                const bf16x8 df = *(const LAS bf16x8*)(Ds + (16 * wid + fr) * 136 + 32 * kk + 8 * fq);
#pragma unroll
                for (int dt = 0; dt < 8; ++dt) { const bf16x8 wf = *(const bf16x8*)(PW + (16 * dt + fr) * 128 + 32 * kk + 8 * fq); acc[dt] = MFMA16(wf, df, acc[dt]); }
            }
            bf16_t* PA = C.PA();
            const int row = tb * 128 + 16 * wid + fr;
#pragma unroll
            for (int dt = 0; dt < 8; ++dt) *(u32x2*)(PA + (size_t)row * 512 + g * 128 + 16 * dt + 4 * fq) = pack4(acc[dt]);
        }
    }
}
__device__ void phase_b(const Ctx& C, int layer) {
    u32x4* KV = (u32x4*)C.KV();
    const int tid = C.ftid();
    if (tid >= 128) return;
    for (int it = C.bid * 128 + tid; it < 32768; it += C.G * 128) {
        const int idx = it * 8, h = idx >> 16, dir = (idx >> 15) & 1;
        const float cd = exp2f(log2g(C.P->in[8] + layer * 8 + dir * 4 + h) * 128.0f);
        u32x4* base = KV + it;
        f32x4 ra = (f32x4){0.f, 0.f, 0.f, 0.f}, rb = ra;
        const int c0 = dir ? 127 : 0, st = dir ? -1 : 1;
        for (int cc = 0; cc < 128; cc += 8) { u32x4 v[8];
#pragma unroll
            for (int i = 0; i < 8; ++i) v[i] = base[(size_t)(c0 + st * (cc + i)) * 32768];
#pragma unroll
            for (int i = 0; i < 8; ++i) { base[(size_t)(c0 + st * (cc + i)) * 32768] = pack8(ra, rb); ra = ra * cd + unpack_lo4(v[i]); rb = rb * cd + unpack_hi4(v[i]); } }
    }
}
__device__ void phase_c(const Ctx& C, LAS unsigned char* lds, int layer) {
    const int tid0 = C.ftid(), wid = __builtin_amdgcn_readfirstlane(tid0 >> 6), lane = tid0 & 63;
    LAS bf16_t* Qs = (LAS bf16_t*)lds;
    LAS bf16_t* Ps = Qs + 128 * 136;
    LAS bf16_t* Vs = Ps + 128 * 136;
    LAS float* St = (LAS float*)(Vs + 128 * 264);
    const bf16_t* Z = C.Z(); const bf16_t* KV = C.KV(); bf16_t* RG = C.RG();
    for (int t = C.bid; t < 512; t += C.G) {
        const int c = t >> 2, h = t & 3;
        const float lgf = log2g(C.P->in[8] + layer * 8 + h), lgb = log2g(C.P->in[8] + layer * 8 + 4 + h);
        const bf16_t* zrow = Z + (size_t)(c * 128) * INW;
        const int e0 = 32 * wid;
        int fr = lane & 15, fq = lane >> 4;
        asm volatile("" : "+v"(fr), "+v"(fq));
        bf16x8 sf[2][2][4];
#pragma unroll
        for (int dir = 0; dir < 2; ++dir) {
            const bf16_t* sb = KV + (size_t)(((c * 4 + h) * 2 + dir) * 256) * 128;
#pragma unroll
            for (int et = 0; et < 2; ++et)
#pragma unroll
                for (int kk = 0; kk < 4; ++kk) sf[dir][et][kk] = *(const bf16x8*)(sb + (size_t)(e0 + 16 * et + fr) * 128 + 32 * kk + 8 * fq);
        }
        __syncthreads();
        { const int tid = C.ftid();
#pragma unroll
        for (int i = 0; i < 8; ++i) { const int idx = tid + i * 512, r = idx >> 5, v = idx & 31;
            *(LAS u32x4*)(Vs + r * 264 + v * 8) = *(const u32x4*)(zrow + (size_t)r * INW + 1536 + h * 256 + v * 8); }
#pragma unroll
        for (int i = 0; i < 4; ++i) { const int idx = tid + i * 512, r = idx >> 4, v = idx & 15;
            *(LAS u32x4*)(Qs + r * 136 + v * 8) = *(const u32x4*)(zrow + (size_t)r * INW + 512 + h * 128 + v * 8);
            *(LAS u32x4*)(Ps + r * 136 + v * 8) = *(const u32x4*)(zrow + (size_t)r * INW + 1024 + h * 128 + v * 8); }
        }
        __syncthreads();
        asm volatile("" : "+v"(fr), "+v"(fq));
        f32x4 sc[8];
        {
            const int i0 = 16 * wid;
            bf16x8 qf[4];
#pragma unroll
            for (int kk = 0; kk < 4; ++kk) qf[kk] = *(const LAS bf16x8*)(Qs + (i0 + fr) * 136 + 32 * kk + 8 * fq);
#pragma unroll
            for (int jt = 0; jt < 8; ++jt) {
                f32x4 a = (f32x4){0.f, 0.f, 0.f, 0.f};
#pragma unroll
                for (int kk = 0; kk < 4; ++kk) { const bf16x8 kf = *(const LAS bf16x8*)(Ps + (16 * jt + fr) * 136 + 32 * kk + 8 * fq); a = MFMA16(kf, qf[kk], a); }
                const int i = i0 + fr;
#pragma unroll
                for (int r = 0; r < 4; ++r) { const int j = 16 * jt + 4 * fq + r, dl = i - j; a[r] *= (dl >= 0) ? exp2f(lgf * (float)dl) : exp2f(lgb * (float)(-dl)); }
                sc[jt] = a;
            }
        }
        __syncthreads();
        {
            const int i = 16 * wid + fr;
#pragma unroll
            for (int jt = 0; jt < 8; ++jt) *(LAS u32x2*)(Ps + i * 136 + 16 * jt + 4 * fq) = pack4(sc[jt]);
        }
        __syncthreads();
        asm volatile("" : "+v"(fr), "+v"(fq));
        f32x4 y[8][2];
#pragma unroll
        for (int m = 0; m < 8; ++m) { y[m][0] = (f32x4){0.f, 0.f, 0.f, 0.f}; y[m][1] = (f32x4){0.f, 0.f, 0.f, 0.f}; }
#pragma unroll 1
        for (int kk = 0; kk < 4; ++kk) {
            bf16x8 vf[2];
#pragma unroll
            for (int et = 0; et < 2; ++et) vf[et] = tr_frag(Vs, 264, 32 * kk, e0 + 16 * et, fr, fq);
#pragma unroll
            for (int m = 0; m < 8; ++m) { const bf16x8 pf = *(const LAS bf16x8*)(Ps + (16 * m + fr) * 136 + 32 * kk + 8 * fq);
                y[m][0] = MFMA16(vf[0], pf, y[m][0]); y[m][1] = MFMA16(vf[1], pf, y[m][1]); }
        }
#pragma unroll
        for (int dir = 0; dir < 2; ++dir) {
            asm volatile("" : "+v"(fr), "+v"(fq));
#pragma unroll
            for (int m = 0; m < 8; ++m) {
                f32x4 t0 = (f32x4){0.f, 0.f, 0.f, 0.f}, t1 = t0;
#pragma unroll
                for (int kk = 0; kk < 4; ++kk) { const bf16x8 qq = *(const LAS bf16x8*)(Qs + (16 * m + fr) * 136 + 32 * kk + 8 * fq); t0 = MFMA16(sf[dir][0][kk], qq, t0); t1 = MFMA16(sf[dir][1][kk], qq, t1); }
                const int i = 16 * m + fr;
                const float scl = (dir == 0) ? exp2f(lgf * (float)(i + 1)) : exp2f(lgb * (float)(128 - i));
                y[m][0] = y[m][0] + t0 * scl; y[m][1] = y[m][1] + t1 * scl;
                if (m & 1) asm volatile("" ::: "memory");
            }
        }
        asm volatile("" : "+v"(fr), "+v"(fq));
        u32x2 gsw[8][2];
#pragma unroll
        for (int m = 0; m < 8; ++m)
#pragma unroll
            for (int et = 0; et < 2; ++et) gsw[m][et] = *(const u32x2*)(zrow + (size_t)(16 * m + fr) * INW + 2560 + h * 256 + e0 + 16 * et + 4 * fq);
#pragma unroll
        for (int m = 0; m < 8; ++m) {
            const f32x4 a = y[m][0], b = y[m][1];
            float s = (a[0] + a[1]) + (a[2] + a[3]) + (b[0] + b[1]) + (b[2] + b[3]);
            float q = (a[0] * a[0] + a[1] * a[1]) + (a[2] * a[2] + a[3] * a[3]) + (b[0] * b[0] + b[1] * b[1]) + (b[2] * b[2] + b[3] * b[3]);
            { const int ln = fq * 16 + fr; s += shx(s, ln, 16); s += shx(s, ln, 32); q += shx(q, ln, 16); q += shx(q, ln, 32); }
            if (fq == 0) { St[(16 * m + fr) * 16 + wid * 2] = s; St[(16 * m + fr) * 16 + wid * 2 + 1] = q; }
        }
        __syncthreads();
#pragma unroll
        for (int m = 0; m < 8; ++m) {
            const int i = 16 * m + fr;
            const LAS f32x4* sp = (const LAS f32x4*)(St + i * 16);
            const f32x4 p0 = sp[0], p1 = sp[1], p2 = sp[2], p3 = sp[3];
            const float s = (p0[0] + p0[2]) + (p1[0] + p1[2]) + (p2[0] + p2[2]) + (p3[0] + p3[2]);
            const float q = (p0[1] + p0[3]) + (p1[1] + p1[3]) + (p2[1] + p2[3]) + (p3[1] + p3[3]);
            const float mean = s * (1.0f / 256.0f), var = fmaxf(q * (1.0f / 256.0f) - mean * mean, 0.f);
            const float rstd = __builtin_amdgcn_rsqf(var + 1e-5f);
            const size_t row = (size_t)(c * 128 + i);
#pragma unroll
            for (int et = 0; et < 2; ++et) {
                const int e = e0 + 16 * et + 4 * fq;
                *(u32x2*)(RG + row * DM + h * 256 + e) = pack4((y[m][et] - mean) * rstd * unpack4(gsw[m][et]));
            }
        }
    }
}

__device__ __forceinline__ void run_phase(const Ctx& C, LAS unsigned char* lds, int ph) {
    if (ph == 0) { phase_p0(C, lds); phase_rows(C, -1, 0); return; }
    const int q = ph - 1, s = q / 19, r = q % 19;
    if (r == 18) { phase_rows(C, s, s < 2 ? s + 1 : -1); return; }
    const int layer = r / 9, st = r % 9, cur = layer, G = C.G, bid = C.bid;
    pg8::StaticOrder S;
    switch (st) {
    case 0: { pg8::Gemm g{C.XB(cur), C.W(layer, W_IN), SEQ, INW, DM}; S.init(SEQ, INW, G, bid, 2);
              EpiZ E{C.Z(), C.SS(cur), C.COS(), C.SIN()}; pg8::gemm_phase(C.ftid(), lds, g, S, E);
              if (s == 0 && G == 256 && bid >= 128) conv_range(C, layer, 4, 8, (bid - 128) * 512 + C.ftid(), 128 * 512); } break;
    case 1: phase_a(C, lds, layer); break;
    case 2: phase_b(C, layer); break;
    case 3: phase_c(C, lds, layer); break;
    case 4: { S.init(SEQ, DM, G, bid);
              { pg8::Gemm g{C.PA(), C.W(layer, W_PO), SEQ, DM, 512}; EpiGen<0> E{C.TMP(), nullptr, C.Z() + 3584, nullptr}; pg8::gemm_phase(C.ftid(), lds, g, S, E); }
              { pg8::Gemm g{C.RG(), C.W(layer, W_RO), SEQ, DM, DM}; EpiGen<1> E{C.MG(), C.TMP(), C.Z() + 3584 + 1024, nullptr}; pg8::gemm_phase(C.ftid(), lds, g, S, E); } } break;
    case 5: { pg8::Gemm g{C.MG(), C.W(layer, W_O), SEQ, DM, DM}; S.init(SEQ, DM, G, bid);
              if (layer == 0) { EpiResid<false, true> E{C.xin(s), nullptr, C.XB(cur ^ 1), C.SS(cur ^ 1), nullptr}; pg8::gemm_phase(C.ftid(), lds, g, S, E); }
              else { EpiResid<false, false> E{nullptr, C.XB(cur), C.XB(cur ^ 1), C.SS(cur ^ 1), nullptr}; pg8::gemm_phase(C.ftid(), lds, g, S, E); } } break;
    case 6: { pg8::Gemm g{C.XB(cur ^ 1), C.W(layer, W_FFI), SEQ, INW, DM}; S.init(SEQ, INW, G, bid);
              EpiSwiGLU E{C.Z(), C.SS(cur ^ 1)}; pg8::gemm_phase(C.ftid(), lds, g, S, E);
              if (s == 0 && layer == 0 && G == 256 && bid >= 128) conv_range(C, 1, 0, 4, (bid - 128) * 512 + C.ftid(), 128 * 512); } break;
    case 7: { pg8::Gemm g{C.Z(), C.W(layer, W_FFO), SEQ, DM, DFF}; S.init(SEQ, DM, G, bid);
              EpiResid<false, false> E{nullptr, C.XB(cur ^ 1), C.XB(cur), C.SS(cur), nullptr}; pg8::gemm_phase(C.ftid(), lds, g, S, E); } break;
    default: { S.init(SEQ, DM, G, bid);
              { pg8::Gemm g{C.XB(cur), C.W(layer, W_PG), SEQ, DM, DM}; EpiGen<2> E{C.TMP(), nullptr, nullptr, C.SS(cur)}; pg8::gemm_phase(C.ftid(), lds, g, S, E); }
              { pg8::Gemm g{C.PB(layer), C.W(layer, W_PP), SEQ, DM, PLE}; EpiResid<true, false> E{nullptr, C.XB(cur), C.XB(cur ^ 1), C.SS(cur ^ 1), C.TMP()}; pg8::gemm_phase(C.ftid(), lds, g, S, E); } } break;
    }
}


#define XB_TMO      128
#define XB_XCNT(j)  (256  + 64 * (j))
#define XB_XSUB(j)  (1280 + 64 * (j))
#define XB_XGEN(j)  (2304 + 64 * (j))
#define XB_TOP      3328
#define XB_TOPGEN   3392
#define XCD_BAR_WORDS 3456
#define XB_SPIN_CAP (1u << 18)
__device__ __forceinline__ unsigned xb_ld(unsigned* p)              { return __hip_atomic_load(p, __ATOMIC_RELAXED, __HIP_MEMORY_SCOPE_AGENT); }
__device__ __forceinline__ unsigned xb_add(unsigned* p, unsigned v) { return __hip_atomic_fetch_add(p, v, __ATOMIC_RELAXED, __HIP_MEMORY_SCOPE_AGENT); }
__device__ __forceinline__ unsigned xb_xcc_id() { return (unsigned)__builtin_amdgcn_s_getreg((3 << 11) | 20) & 0xFu; }
#define XB_SPIN(cond, bar) do { unsigned _sp = 0; while (cond) { __builtin_amdgcn_s_sleep(1); \
    if ((++_sp & 255u) == 0u) { if (xb_ld(&(bar)[XB_TMO])) break; if (_sp > XB_SPIN_CAP) { atomicAdd(&(bar)[XB_TMO], 1u); break; } } } } while (0)
struct XcdBarrier { unsigned* bar; unsigned x; volatile LAS unsigned* st; };
__device__ __forceinline__ XcdBarrier xcd_barrier_post(unsigned* bar, volatile LAS unsigned* st, bool leader) {
    XcdBarrier b; b.bar = bar; b.x = xb_xcc_id(); b.st = st;
    if (leader) (void)xb_add(&bar[XB_XCNT(b.x)], 1u);
    return b;
}
__device__ __forceinline__ void xcd_barrier_complete(unsigned* bar, unsigned x, unsigned& nloc, unsigned& nx) {
    const unsigned G = gridDim.x * gridDim.y * gridDim.z;
    unsigned sum, cnt, mine, sp = 0u;
    for (;;) {
        sum = 0u; cnt = 0u; mine = 0u;
#pragma unroll
        for (unsigned j = 0; j < 16; ++j) { const unsigned c = xb_ld(&bar[XB_XCNT(j)]); sum += c; cnt += (c > 0u) ? 1u : 0u; mine = (j == x) ? c : mine; }
        if (sum == G) break;
        __builtin_amdgcn_s_sleep(1);
        if ((++sp & 255u) == 0u) { if (xb_ld(&bar[XB_TMO])) break; if (sp > XB_SPIN_CAP) { atomicAdd(&bar[XB_TMO], 1u); break; } }
    }
    nloc = mine > 0u ? mine : 1u; nx = cnt > 0u ? cnt : 1u;
}
__device__ __forceinline__ void xcd_barrier(const XcdBarrier& b, int wv) {
    asm volatile("s_waitcnt vmcnt(0)" ::: "memory");
    __syncthreads();
    if (wv == 0 && lane_now() == 0) {
        unsigned* bar = b.bar;
        __builtin_amdgcn_s_waitcnt(0);
        unsigned nloc = b.st[0], nx = b.st[1];
        if (nloc == 0u) { xcd_barrier_complete(bar, b.x, nloc, nx); b.st[0] = nloc; b.st[1] = nx; }
        const unsigned old = xb_add(&bar[XB_XSUB(b.x)], 1u);
        const unsigned gen = old / nloc;
        if (old + 1u == (gen + 1u) * nloc) {
            __builtin_amdgcn_fence(__ATOMIC_RELEASE, "agent");
            asm volatile("s_waitcnt vmcnt(0)" ::: "memory");
            const unsigned og = xb_add(&bar[XB_TOP], 1u);
            const unsigned tg = og / nx;
            if (og + 1u == (tg + 1u) * nx) xb_add(&bar[XB_TOPGEN], 1u);
            else XB_SPIN(xb_ld(&bar[XB_TOPGEN]) == tg, bar);
            __builtin_amdgcn_fence(__ATOMIC_ACQUIRE, "agent");
            xb_add(&bar[XB_XGEN(b.x)], 1u);
            asm volatile("s_waitcnt vmcnt(0)" ::: "memory");
        } else {
            XB_SPIN(xb_ld(&bar[XB_XGEN(b.x)]) == gen, bar);
            __builtin_amdgcn_fence(__ATOMIC_ACQUIRE, "agent");
            asm volatile("s_waitcnt vmcnt(0)" ::: "memory");
        }
    }
    __syncthreads();
}

__global__ void __launch_bounds__(512, 2) mk_fwd(Params P) {
    extern __shared__ __attribute__((aligned(16))) unsigned char lds_raw[];
    LAS unsigned char* lds = (LAS unsigned char*)lds_raw;
    const int wv0 = __builtin_amdgcn_readfirstlane((int)threadIdx.x >> 6);
    const bool leader0 = (threadIdx.x == 0);
    volatile LAS unsigned* bst = (volatile LAS unsigned*)(lds + LDS_BYTES - 16);
    XcdBarrier bar; bar.bar = (unsigned*)(P.ws + WS_END); bar.x = 0; bar.st = bst;
    if (P.ph_hi - P.ph_lo > 1) {
        if (leader0) { bst[0] = 0u; bst[1] = 0u; }
        __syncthreads();
        bar = xcd_barrier_post((unsigned*)(P.ws + WS_END), bst, leader0);
    }
    for (int ph = P.ph_lo; ph < P.ph_hi; ++ph) {
        int wv = wv0, bid = blockIdx.x, G = gridDim.x;
        asm volatile("" : "+s"(wv), "+s"(bid), "+s"(G));
        KPtr pp = (KPtr)__builtin_amdgcn_kernarg_segment_ptr();
        asm volatile("" : "+s"(pp));
        Ctx C{pp, pp->out, pp->ws, wv, bid, G};
        run_phase(C, lds, ph);
#if REP_MASK
        { int cls; if (ph == 0) cls = 10; else { const int r = (ph - 1) % 19; cls = (r == 18) ? 9 : (r % 9); }
          if ((REP_MASK >> cls) & 1) { __syncthreads(); run_phase(C, lds, ph); } }
#endif
        if (ph + 1 < P.ph_hi) { if (ph == P.ph_lo) cg::this_grid().sync(); else xcd_barrier(bar, wv0); }
    }
}

extern "C" void kernel_launch(void* const* d_in, const int* in_sizes, int n_in, void* d_out, int out_size, void* d_ws, size_t ws_size, hipStream_t stream) {
    static int grid = 0;
    if (grid == 0) {
        if (n_in != 19 || ws_size < WS_END + XCD_BAR_WORDS * 4) { fprintf(stderr, "kernel_launch: unexpected n_in %d / ws %zu (need %zu)\n", n_in, ws_size, (size_t)WS_END); grid = -1; return; }
        int dev = 0, cus = 0, per_cu = 0;
        hipGetDevice(&dev); hipDeviceGetAttribute(&cus, hipDeviceAttributeMultiprocessorCount, dev);
        hipFuncSetAttribute((const void*)mk_fwd, hipFuncAttributeMaxDynamicSharedMemorySize, LDS_BYTES);
        hipOccupancyMaxActiveBlocksPerMultiprocessor(&per_cu, (const void*)mk_fwd, 512, LDS_BYTES);
        if (per_cu < 1) per_cu = 1;
        (void)hipGetLastError();
        grid = cus * per_cu;
    }
    if (grid < 0) return;
    if (hipMemsetAsync((char*)d_ws + WS_END, 0, XCD_BAR_WORDS * 4, stream) != hipSuccess) { fprintf(stderr, "kernel_launch: memset of barrier words failed\n"); return; }
    Params p{};
    for (int i = 0; i < 19; ++i) p.in[i] = (const float*)d_in[i];
    p.out = (float*)d_out; p.ws = (unsigned char*)d_ws;
#if MULTI_LAUNCH
    for (int ph = 0; ph < NPH; ++ph) { p.ph_lo = ph; p.ph_hi = ph + 1; hipLaunchKernelGGL(mk_fwd, dim3(grid), dim3(512), LDS_BYTES, stream, p); }
#else
    p.ph_lo = 0; p.ph_hi = NPH;
    void* args[] = {&p};
    hipError_t e = hipLaunchCooperativeKernel((const void*)mk_fwd, dim3(grid), dim3(512), args, LDS_BYTES, stream);
    if (e != hipSuccess) fprintf(stderr, "cooperative launch failed: %s (grid %d)\n", hipGetErrorString(e), grid);
#endif
}
```

```cpp
#include <hip/hip_runtime.h>
#include <hip/hip_cooperative_groups.h>
#include <cstdio>
namespace cg = cooperative_groups;

#ifndef SLOW_TR
#define SLOW_TR 0
#endif
#ifndef REP_MASK
#define REP_MASK 0
#endif
#ifndef MULTI_LAUNCH
#define MULTI_LAUNCH 0
#endif

#define LAS __attribute__((address_space(3)))
typedef unsigned short bf16_t;
typedef short bf16x8 __attribute__((ext_vector_type(8)));
typedef short s16x4 __attribute__((ext_vector_type(4)));
typedef float f32x4 __attribute__((ext_vector_type(4)));
typedef unsigned u32x4 __attribute__((ext_vector_type(4)));
typedef unsigned u32x2 __attribute__((ext_vector_type(2)));

constexpr int SEQ = 16384, DM = 1024, INW = 5632, DFF = 2816, PLE = 256;
constexpr int NPH = 58;
constexpr size_t W_IN = 0, W_PO = W_IN + (size_t)INW * DM * 2, W_RO = W_PO + (size_t)DM * 512 * 2, W_O = W_RO + (size_t)DM * DM * 2,
                 W_FFI = W_O + (size_t)DM * DM * 2, W_FFO = W_FFI + (size_t)INW * DM * 2, W_PG = W_FFO + (size_t)DM * DFF * 2,
                 W_PP = W_PG + (size_t)DM * DM * 2, W_PW = W_PP + (size_t)DM * PLE * 2, W_LAYER = W_PW + (size_t)4 * 128 * 128 * 2;
constexpr size_t WS_W = 0, WS_COS = WS_W + 2 * W_LAYER, WS_SIN = WS_COS + (size_t)SEQ * 64 * 4, WS_XB = WS_SIN + (size_t)SEQ * 64 * 4,
                 WS_SS = WS_XB + 2 * (size_t)SEQ * DM * 2, WS_Z = WS_SS + 2 * (size_t)SEQ * 16 * 4, WS_KV = WS_Z + (size_t)SEQ * INW * 2,
                 WS_PA = WS_KV + (size_t)128 * 4 * 2 * 256 * 128 * 2, WS_RG = WS_PA + (size_t)SEQ * 512 * 2, WS_PB = WS_RG + (size_t)SEQ * DM * 2,
                 WS_END = WS_PB + 2 * (size_t)SEQ * PLE * 2;
constexpr int LDS_BYTES = 147456;

typedef float f32x2_t __attribute__((ext_vector_type(2)));
typedef __bf16 bf16x2_t __attribute__((ext_vector_type(2)));
__device__ __forceinline__ unsigned cvt_pk_bf16(float lo, float hi) { const f32x2_t v = {lo, hi}; return __builtin_bit_cast(unsigned, __builtin_convertvector(v, bf16x2_t)); }
__device__ __forceinline__ float bf_lo(unsigned u) { return __uint_as_float(u << 16); }
__device__ __forceinline__ float bf_hi(unsigned u) { return __uint_as_float(u & 0xffff0000u); }
__device__ __forceinline__ float sigmoid_f(float x) { return __builtin_amdgcn_rcpf(1.0f + __expf(-x)); }
__device__ __forceinline__ float sigmoid_sc(float v, float nrl) { return __builtin_amdgcn_rcpf(1.0f + __builtin_amdgcn_exp2f(v * nrl)); }
__device__ __forceinline__ float sigmoid_scm(float v, float nrl, float ic) { return __builtin_amdgcn_rcpf(__builtin_fmaf(__builtin_amdgcn_exp2f(v * nrl), ic, ic)); }
__device__ __forceinline__ float silu_f(float x) { return x * sigmoid_f(x); }
__device__ __forceinline__ u32x2 pack4(f32x4 v) { u32x2 w; w.x = cvt_pk_bf16(v[0], v[1]); w.y = cvt_pk_bf16(v[2], v[3]); return w; }
__device__ __forceinline__ u32x4 pack8(f32x4 a, f32x4 b) { u32x4 w; w.x = cvt_pk_bf16(a[0], a[1]); w.y = cvt_pk_bf16(a[2], a[3]); w.z = cvt_pk_bf16(b[0], b[1]); w.w = cvt_pk_bf16(b[2], b[3]); return w; }
__device__ __forceinline__ f32x4 unpack_lo4(u32x4 w) { return (f32x4){bf_lo(w.x), bf_hi(w.x), bf_lo(w.y), bf_hi(w.y)}; }
__device__ __forceinline__ f32x4 unpack_hi4(u32x4 w) { return (f32x4){bf_lo(w.z), bf_hi(w.z), bf_lo(w.w), bf_hi(w.w)}; }
__device__ __forceinline__ f32x4 unpack4(u32x2 w) { return (f32x4){bf_lo(w.x), bf_hi(w.x), bf_lo(w.y), bf_hi(w.y)}; }
__device__ __forceinline__ float log2g(const float* logit) {
    const float x = *logit, u = __expf(-x);
    float l = u * (1.f - u * (0.5f - u * (0.33333334f - u * (0.25f - u * (0.2f - u * 0.16666667f)))));
    if (u > 0.0625f) l = __logf(1.0f + u);
    return -l * 1.4426950408889634f;
}
__device__ __forceinline__ float rstd_from_ss(const float* ss) {
    const f32x4* sp = (const f32x4*)ss; const f32x4 a = sp[0], b = sp[1], c = sp[2], d = sp[3];
    const f32x4 t = (a + b) + (c + d); const float s = (t[0] + t[1]) + (t[2] + t[3]);
    return __builtin_amdgcn_rsqf(s * (1.0f / 1024.0f) + 1e-6f);
}

__device__ __forceinline__ float shx(float v, int lane, int m) { return __int_as_float(__builtin_amdgcn_ds_bpermute((lane ^ m) << 2, __float_as_int(v))); }
__device__ __forceinline__ int lane_now() { int l; asm volatile("v_mbcnt_lo_u32_b32 %0, -1, 0\n\tv_mbcnt_hi_u32_b32 %0, -1, %0" : "=v"(l)); return l; }
namespace pg8 {
constexpr int BM = 256, BK = 64, HALF = 128, HTB = HALF * BK * 2, STAGE_BYTES = 8 * HTB, NXCD = 8, WGM = 8;
__host__ __device__ __forceinline__ int lds_byte(int r, int c) { const int st = (r >> 4) * 2 + (c >> 5), rr = r & 15, cc = c & 31, ob = rr * 64 + cc * 2; return st * 1024 + (ob ^ (((ob >> 9) & 1) << 5)); }
__host__ __device__ __forceinline__ void stage_rc(int b, int& R, int& C) { const int st = b / 1024, sb = b % 1024, swz = sb ^ (((sb >> 9) & 1) << 5); R = (st >> 1) * 16 + swz / 64; C = (st & 1) * 32 + (swz % 64) / 2; }
__host__ __device__ __forceinline__ int perm32(int rho) { const int n = rho >> 4, i = rho & 15; return 8 * (i >> 2) + 4 * n + (i & 3); }
struct Unit { int pm, pn; };
struct Gemm { const bf16_t* A; const bf16_t* Bt; int M, N, K; };
struct StaticOrder {
    int nM, nN, nwg, G, c, rot;
    __device__ void init(int M, int N, int G_, int c_, int rot_ = 0) { nM = M / BM; nN = N / BM; nwg = nM * nN; G = G_; c = c_; rot = rot_; }
    __device__ bool next(int i, Unit& u) const {
        const long L = (long)i * G + c; if (L >= nwg) return false;
        int wgid = (int)L; { const int q = nwg / NXCD, r = nwg % NXCD, xcd = wgid % NXCD, off = wgid / NXCD; wgid = (xcd < r ? xcd * (q + 1) : r * (q + 1) + (xcd - r) * q) + off; }
        const int nig = WGM * nN, gid = wgid / nig, fm = gid * WGM, gsz = (nM - fm) < WGM ? (nM - fm) : WGM;
        u.pm = fm + ((wgid % nig) % gsz); { const int p = (wgid % nig) / gsz + rot; u.pn = p >= nN ? p - nN : p; } return true;
    }
};
template <class Epi>
__device__ __forceinline__ void gemm_phase(const int tid, LAS unsigned char* lds, const Gemm g, const StaticOrder& S, const Epi& E) {
    const int wid = __builtin_amdgcn_readfirstlane(tid >> 6), lane = tid & 63, wr = wid >> 2, wc = wid & 3, fr = lane & 15, fq = lane >> 4;
    const int K = g.K, nt = K / BK;
    unsigned voffA[2], voffB[2];
#pragma unroll
    for (int i = 0; i < 2; ++i) { int R, C; stage_rc(tid * 16 + i * 8192, R, C); const int Rb = Epi::PERM ? ((R & ~31) + perm32(R & 31)) : R;
        voffA[i] = (unsigned)(R * K + C) * 2u; voffB[i] = (unsigned)(Rb * K + C) * 2u; }
    const size_t kstep = (size_t)(BK * 2);
    const size_t hstep = (size_t)HALF * K * 2;
    const size_t tstep = 2 * hstep;
    const unsigned ldsw = (unsigned)wid * 1024u;
    const int aoff = lds_byte(wr * 64 + fr, fq * 8), boff = lds_byte(wc * 32 + fr, fq * 8);
#define PG8_SA(b, h) (((b) * 2 + (h)) * HTB)
#define PG8_SB(b, h) ((4 + (b) * 2 + (h)) * HTB)
#define PG8_STAGE(bufoff, gbase, voff) do { _Pragma("unroll") for (int _i = 0; _i < 2; ++_i) { unsigned _vo = (voff)[_i]; asm volatile("" : "+v"(_vo)); \
        __builtin_amdgcn_global_load_lds((const unsigned*)((const char*)(gbase) + _vo), (LAS unsigned*)(lds + (bufoff) + ldsw + _i * 8192), 16, 0, 0); } } while (0)
#define PG8_LDA(dst, b, h) do { _Pragma("unroll") for (int m = 0; m < 4; ++m) _Pragma("unroll") for (int k = 0; k < 2; ++k) dst[m][k] = *(const LAS bf16x8*)(lds + PG8_SA(b, h) + aoff + m * 2048 + k * 1024); } while (0)
#define PG8_LDB(dst, b, h) do { _Pragma("unroll") for (int n = 0; n < 2; ++n) _Pragma("unroll") for (int k = 0; k < 2; ++k) dst[n][k] = *(const LAS bf16x8*)(lds + PG8_SB(b, h) + boff + n * 2048 + k * 1024); } while (0)
#define PG8_MMA(ai, bj, At, Bt) do { __builtin_amdgcn_s_setprio(1); _Pragma("unroll") for (int m = 0; m < 4; ++m) _Pragma("unroll") for (int n = 0; n < 2; ++n) _Pragma("unroll") for (int k = 0; k < 2; ++k) \
        acc[ai][bj][m][n] = __builtin_amdgcn_mfma_f32_16x16x32_bf16(Bt[n][k], At[m][k], acc[ai][bj][m][n], 0, 0, 0); __builtin_amdgcn_s_setprio(0); } while (0)
#define PG8_WAIT_V(n) asm volatile("s_waitcnt vmcnt(" #n ")" ::: "memory")
#define PG8_WAIT_L(n) asm volatile("s_waitcnt lgkmcnt(" #n ")" ::: "memory")
#define PG8_BAR __builtin_amdgcn_s_barrier()
#define PG8_SCHED __builtin_amdgcn_sched_barrier(0)
    Unit cur, nxt; int ui = 0;
    if (!S.next(0, cur)) return;
    f32x4 acc[2][2][4][2];
#pragma unroll
    for (int a = 0; a < 2; ++a)
#pragma unroll
        for (int b = 0; b < 2; ++b)
#pragma unroll
            for (int m = 0; m < 4; ++m)
#pragma unroll
                for (int n = 0; n < 2; ++n) acc[a][b][m][n] = (f32x4){0.f, 0.f, 0.f, 0.f};
    bf16x8 At[4][2], B0[2][2], B1[2][2];
    const char* cA = (const char*)g.A + (size_t)cur.pm * tstep; const char* cB = (const char*)g.Bt + (size_t)cur.pn * tstep;
    PG8_STAGE(PG8_SB(0, 0), cB, voffB); PG8_STAGE(PG8_SA(0, 0), cA, voffA); PG8_STAGE(PG8_SB(0, 1), cB + hstep, voffB); PG8_STAGE(PG8_SA(0, 1), cA + hstep, voffA);
    if (wr == 1) PG8_BAR;
    PG8_WAIT_V(4); PG8_BAR;
    PG8_STAGE(PG8_SB(1, 0), cB + kstep, voffB); PG8_STAGE(PG8_SA(1, 0), cA + kstep, voffA); PG8_STAGE(PG8_SB(1, 1), cB + hstep + kstep, voffB);
    PG8_WAIT_V(6); PG8_BAR;
    for (;;) {
        const bool has_next = S.next(ui + 1, nxt);
        const char* nA = has_next ? (const char*)g.A + (size_t)nxt.pm * tstep : cA; const char* nB = has_next ? (const char*)g.Bt + (size_t)nxt.pn * tstep : cB;
        for (int t = 0; t < nt; t += 2) {
            const bool last = (t == nt - 2);
            const char* a1 = cA + (size_t)(t + 1) * kstep;
            const char* a2 = last ? nA : cA + (size_t)(t + 2) * kstep; const char* b2 = last ? nB : cB + (size_t)(t + 2) * kstep;
            const char* a3 = a2 + kstep; const char* b3 = b2 + kstep;
            PG8_LDB(B0, 0, 0); PG8_SCHED; PG8_LDA(At, 0, 0); PG8_STAGE(PG8_SA(1, 1), a1 + hstep, voffA);
            PG8_WAIT_L(8); PG8_BAR; PG8_WAIT_L(0); PG8_MMA(0, 0, At, B0); PG8_BAR; PG8_SCHED;
            PG8_LDB(B1, 0, 1); PG8_STAGE(PG8_SB(0, 0), b2, voffB);
            PG8_BAR; PG8_WAIT_L(0); PG8_MMA(0, 1, At, B1); PG8_BAR;
            PG8_LDA(At, 0, 1); PG8_STAGE(PG8_SA(0, 0), a2, voffA);
            PG8_BAR; PG8_WAIT_L(0); PG8_MMA(1, 0, At, B0); PG8_BAR; PG8_SCHED;
            PG8_STAGE(PG8_SB(0, 1), b2 + hstep, voffB);
            PG8_WAIT_V(6); PG8_BAR; PG8_MMA(1, 1, At, B1); PG8_BAR;
            PG8_LDB(B0, 1, 0); PG8_SCHED; PG8_LDA(At, 1, 0); PG8_STAGE(PG8_SA(0, 1), a2 + hstep, voffA);
            PG8_WAIT_L(8); PG8_BAR; PG8_WAIT_L(0); PG8_MMA(0, 0, At, B0); PG8_BAR; PG8_SCHED;
            PG8_LDB(B1, 1, 1); PG8_STAGE(PG8_SB(1, 0), b3, voffB);
            PG8_BAR; PG8_WAIT_L(0); PG8_MMA(0, 1, At, B1); PG8_BAR;
            PG8_LDA(At, 1, 1); PG8_STAGE(PG8_SA(1, 0), a3, voffA);
            PG8_BAR; PG8_WAIT_L(0); PG8_MMA(1, 0, At, B0); PG8_BAR; PG8_SCHED;
            PG8_STAGE(PG8_SB(1, 1), b3 + hstep, voffB);
            PG8_WAIT_V(6); PG8_BAR; PG8_MMA(1, 1, At, B1); PG8_BAR;
        }
        E(acc, cur, wr, wc, fr, fq);
        if (!has_next) break;
#pragma unroll
        for (int a = 0; a < 2; ++a)
#pragma unroll
            for (int b = 0; b < 2; ++b)
#pragma unroll
                for (int m = 0; m < 4; ++m)
#pragma unroll
                    for (int n = 0; n < 2; ++n) acc[a][b][m][n] = (f32x4){0.f, 0.f, 0.f, 0.f};
        cur = nxt; cA = nA; cB = nB; ++ui;
    }
    PG8_WAIT_V(0);
    if (wr == 0) PG8_BAR;
    PG8_BAR;
#undef PG8_SA
#undef PG8_SB
#undef PG8_STAGE
#undef PG8_LDA
#undef PG8_LDB
#undef PG8_MMA
#undef PG8_WAIT_V
#undef PG8_WAIT_L
#undef PG8_BAR
#undef PG8_SCHED
}
}
using pg8::Unit;

__device__ __forceinline__ void load_rstd8(const float* SS, int row0, int fr, int fq, float (&rstd)[8]) {
    const int ln = fq * 16 + fr;
    f32x4 q[8];
#pragma unroll
    for (int i = 0; i < 8; ++i) q[i] = *(const f32x4*)(SS + (size_t)(row0 + (i >> 2) * 128 + (i & 3) * 16) * 16 + fq * 4);
#pragma unroll
    for (int i = 0; i < 8; ++i) { float s = (q[i][0] + q[i][1]) + (q[i][2] + q[i][3]); s += shx(s, ln, 16); s += shx(s, ln, 32); rstd[i] = __builtin_amdgcn_rsqf(s * (1.0f / 1024.0f) + 1e-6f); }
}

struct EpiZ {
    static constexpr bool PERM = true;
    bf16_t* Z; const float* SS; const float* COS; const float* SIN;
    __device__ __forceinline__ void operator()(const f32x4 (&acc)[2][2][4][2], const Unit& u, int wr, int wc, int fr, int fq) const {
        { const int l_ = lane_now(); fr = l_ & 15; fq = l_ >> 4; }
        const int row0 = u.pm * 256 + wr * 64 + fr, pn = u.pn, colw = wc * 32 + 8 * fq;
        float rs[8]; load_rstd8(SS, row0, fr, fq, rs);
#pragma unroll
        for (int ai = 0; ai < 2; ++ai)
#pragma unroll
            for (int m = 0; m < 4; ++m) {
                const int row = row0 + ai * 128 + m * 16;
                const float rstd = rs[ai * 4 + m];
                bf16_t* rowp = Z + (size_t)row * INW + pn * 256 + colw;
                if (pn >= 2 && pn < 6) {
                    const int i1 = 16 * wc + 4 * fq;
                    const f32x4 cs = *(const f32x4*)(COS + (size_t)row * 64 + i1), sn = *(const f32x4*)(SIN + (size_t)row * 64 + i1);
                    const float sc = rstd * (pn >= 4 ? 0.08838834764831845f : 1.0f);
#pragma unroll
                    for (int bj = 0; bj < 2; ++bj) {
                        const f32x4 x1 = acc[ai][bj][m][0] * sc, x2 = acc[ai][bj][m][1] * sc;
                        const f32x4 o1 = x1 * cs - x2 * sn, o2 = x1 * sn + x2 * cs;
                        *(u32x4*)(rowp + bj * 128) = pack8(o1, o2);
                    }
                } else {
#pragma unroll
                    for (int bj = 0; bj < 2; ++bj) {
                        f32x4 v0 = acc[ai][bj][m][0], v1 = acc[ai][bj][m][1];
                        const float nrl = rstd * -1.4426950408889634f;
                        if (pn >= 14) {
#pragma unroll
                            for (int j = 0; j < 4; ++j) { v0[j] = sigmoid_sc(v0[j], nrl); v1[j] = sigmoid_sc(v1[j], nrl); }
                        } else if (pn >= 10) {
                            { const float ir = __builtin_amdgcn_rcpf(rstd);
#pragma unroll
                            for (int j = 0; j < 4; ++j) { v0[j] = v0[j] * sigmoid_scm(v0[j], nrl, ir); v1[j] = v1[j] * sigmoid_scm(v1[j], nrl, ir); } }
                        } else { v0 = v0 * rstd; v1 = v1 * rstd; }
                        *(u32x4*)(rowp + bj * 128) = pack8(v0, v1);
                    }
                }
            }
    }
};
struct EpiSwiGLU {
    static constexpr bool PERM = true;
    bf16_t* ACT; const float* SS;
    __device__ __forceinline__ void operator()(const f32x4 (&acc)[2][2][4][2], const Unit& u, int wr, int wc, int fr, int fq) const {
        { const int l_ = lane_now(); fr = l_ & 15; fq = l_ >> 4; }
        const int row0 = u.pm * 256 + wr * 64 + fr, col = u.pn * 128 + wc * 32 + 8 * fq;
        float rs[8]; load_rstd8(SS, row0, fr, fq, rs);
#pragma unroll
        for (int ai = 0; ai < 2; ++ai)
#pragma unroll
            for (int m = 0; m < 4; ++m) {
                const int row = row0 + ai * 128 + m * 16;
                const float rstd = rs[ai * 4 + m];
                f32x4 o[2];
                const float ir2 = __builtin_amdgcn_rcpf(rstd * rstd), nrl = rstd * -1.4426950408889634f;
#pragma unroll
                for (int n = 0; n < 2; ++n) { const f32x4 gt = acc[ai][0][m][n], up = acc[ai][1][m][n];
#pragma unroll
                    for (int j = 0; j < 4; ++j) o[n][j] = (gt[j] * up[j]) * sigmoid_scm(gt[j], nrl, ir2); }
                *(u32x4*)(ACT + (size_t)row * DFF + col) = pack8(o[0], o[1]);
            }
    }
};
template <int MODE> struct EpiGen {
    static constexpr bool PERM = true;
    bf16_t* O; const bf16_t* T; const bf16_t* G; const float* SS;
    __device__ __forceinline__ void operator()(const f32x4 (&acc)[2][2][4][2], const Unit& u, int wr, int wc, int fr, int fq) const {
        { const int l_ = lane_now(); fr = l_ & 15; fq = l_ >> 4; }
        const int row0 = u.pm * 256 + wr * 64 + fr, col0 = u.pn * 256 + wc * 32 + 8 * fq;
        if (MODE == 2) {
            float rs[8]; load_rstd8(SS, row0, fr, fq, rs);
#pragma unroll
            for (int rg = 0; rg < 8; ++rg) {
                const int ai = rg >> 2, m = rg & 3, row = row0 + ai * 128 + m * 16; const float rstd = rs[rg];
#pragma unroll
                for (int bj = 0; bj < 2; ++bj) {
                    f32x4 v0 = acc[ai][bj][m][0], v1 = acc[ai][bj][m][1];
#pragma unroll
                    for (int j = 0; j < 4; ++j) { v0[j] = sigmoid_sc(v0[j], rstd * -1.4426950408889634f); v1[j] = sigmoid_sc(v1[j], rstd * -1.4426950408889634f); }
                    *(u32x4*)(O + (size_t)row * DM + col0 + bj * 128) = pack8(v0, v1);
                }
            }
        } else {
            constexpr int NB = (MODE == 1) ? 2 : 1, RGP = 8 / NB;
#pragma unroll
            for (int b = 0; b < NB; ++b) {
                u32x4 gw[RGP][2], tw[RGP][2];
#pragma unroll
                for (int q = 0; q < RGP; ++q)
#pragma unroll
                    for (int bj = 0; bj < 2; ++bj) {
                        const int rg = b * RGP + q, row = row0 + (rg >> 2) * 128 + (rg & 3) * 16, col = col0 + bj * 128;
                        gw[q][bj] = *(const u32x4*)(G + (size_t)row * INW + col);
                        if (MODE == 1) tw[q][bj] = *(const u32x4*)(T + (size_t)row * DM + col);
                    }
#pragma unroll
                for (int q = 0; q < RGP; ++q)
#pragma unroll
                    for (int bj = 0; bj < 2; ++bj) {
                        const int rg = b * RGP + q, ai = rg >> 2, m = rg & 3, row = row0 + ai * 128 + m * 16, col = col0 + bj * 128;
                        f32x4 v0 = acc[ai][bj][m][0] * unpack_lo4(gw[q][bj]), v1 = acc[ai][bj][m][1] * unpack_hi4(gw[q][bj]);
                        if (MODE == 1) { v0 = v0 + unpack_lo4(tw[q][bj]); v1 = v1 + unpack_hi4(tw[q][bj]); }
                        *(u32x4*)(O + (size_t)row * DM + col) = pack8(v0, v1);
                    }
                asm volatile("" ::: "memory");
            }
        }
    }
};
template <bool MUL, bool SRC32> struct EpiResid {
    static constexpr bool PERM = true;
    const float* x32; const bf16_t* xb; bf16_t* XBo; float* SSo; const bf16_t* T;
    __device__ __forceinline__ void operator()(const f32x4 (&acc)[2][2][4][2], const Unit& u, int wr, int wc, int fr, int fq) const {
        { const int l_ = lane_now(); fr = l_ & 15; fq = l_ >> 4; }
        const int row0 = u.pm * 256 + wr * 64 + fr, col0 = u.pn * 256 + wc * 32 + 8 * fq;
        constexpr int NB = SRC32 ? 4 : (MUL ? 2 : 1), RG_PER = 8 / NB;
#pragma unroll
        for (int b = 0; b < NB; ++b) {
            f32x4 xr[RG_PER][2][2]; u32x4 xw[RG_PER][2], tw[RG_PER][2];
#pragma unroll
            for (int q = 0; q < RG_PER; ++q)
#pragma unroll
                for (int bj = 0; bj < 2; ++bj) {
                    const int rg = b * RG_PER + q;
                    const size_t off = (size_t)(row0 + (rg >> 2) * 128 + (rg & 3) * 16) * DM + col0 + bj * 128;
                    if (SRC32) { xr[q][bj][0] = *(const f32x4*)(x32 + off); xr[q][bj][1] = *(const f32x4*)(x32 + off + 4); } else xw[q][bj] = *(const u32x4*)(xb + off);
                    if (MUL) tw[q][bj] = *(const u32x4*)(T + off);
                }
#pragma unroll
            for (int q = 0; q < RG_PER; ++q) {
                const int rg = b * RG_PER + q, ai = rg >> 2, m = rg & 3, row = row0 + ai * 128 + m * 16;
                float ss = 0.f;
#pragma unroll
                for (int bj = 0; bj < 2; ++bj) {
                    const size_t off = (size_t)row * DM + col0 + bj * 128;
                    f32x4 v0 = acc[ai][bj][m][0], v1 = acc[ai][bj][m][1];
                    if (MUL) { v0 = v0 * unpack_lo4(tw[q][bj]); v1 = v1 * unpack_hi4(tw[q][bj]); }
                    if (SRC32) { v0 = v0 + xr[q][bj][0]; v1 = v1 + xr[q][bj][1]; } else { v0 = v0 + unpack_lo4(xw[q][bj]); v1 = v1 + unpack_hi4(xw[q][bj]); }
                    *(u32x4*)(XBo + off) = pack8(v0, v1);
                    ss += (v0[0] * v0[0] + v0[1] * v0[1]) + (v0[2] * v0[2] + v0[3] * v0[3]) + (v1[0] * v1[0] + v1[1] * v1[1]) + (v1[2] * v1[2] + v1[3] * v1[3]);
                }
                { const int ln = fq * 16 + fr; ss += shx(ss, ln, 16); ss += shx(ss, ln, 32); }
                if (fq == 0) SSo[(size_t)row * 16 + u.pn * 4 + wc] = ss;
            }
            asm volatile("" ::: "memory");
        }
    }
};

struct Params { const float* in[19]; float* out; unsigned char* ws; int ph_lo, ph_hi; };
typedef const __attribute__((address_space(4))) Params* KPtr;
struct Ctx {
    KPtr P; float* out; unsigned char* ws; int wv, bid, G;
    __device__ __forceinline__ int ftid() const { return wv * 64 + lane_now(); }
    __device__ __forceinline__ bf16_t* W(int layer, size_t off) const { return (bf16_t*)(ws + WS_W + (size_t)layer * W_LAYER + off); }
    __device__ __forceinline__ float* COS() const { return (float*)(ws + WS_COS); }
    __device__ __forceinline__ float* SIN() const { return (float*)(ws + WS_SIN); }
    __device__ __forceinline__ bf16_t* XB(int i) const { return (bf16_t*)(ws + WS_XB + (size_t)i * SEQ * DM * 2); }
    __device__ __forceinline__ float* SS(int i) const { return (float*)(ws + WS_SS + (size_t)i * SEQ * 16 * 4); }
    __device__ __forceinline__ bf16_t* Z() const { return (bf16_t*)(ws + WS_Z); }
    __device__ __forceinline__ bf16_t* KV() const { return (bf16_t*)(ws + WS_KV); }
    __device__ __forceinline__ bf16_t* TMP() const { return (bf16_t*)(ws + WS_KV); }
    __device__ __forceinline__ bf16_t* MG() const { return (bf16_t*)(ws + WS_KV + (size_t)SEQ * DM * 2); }
    __device__ __forceinline__ bf16_t* PA() const { return (bf16_t*)(ws + WS_PA); }
    __device__ __forceinline__ bf16_t* RG() const { return (bf16_t*)(ws + WS_RG); }
    __device__ __forceinline__ bf16_t* PB(int layer) const { return (bf16_t*)(ws + WS_PB + (size_t)layer * SEQ * PLE * 2); }
    __device__ __forceinline__ const float* xin(int s) const { return s == 0 ? P->in[0] : P->in[1] + (size_t)(s - 1) * SEQ * DM; }
    __device__ __forceinline__ const float* pin(int s, int layer) const { return s == 0 ? P->in[2] + (size_t)layer * SEQ * PLE : P->in[3] + (size_t)(layer * 2 + (s - 1)) * SEQ * PLE; }
    __device__ __forceinline__ float* xout(int s) const { return out + (size_t)s * SEQ * DM; }
};

__device__ __forceinline__ int dperm(int c) { return ((c >> 2) & 1) * 64 + 16 * (c >> 5) + 4 * ((c >> 3) & 3) + (c & 3); }
struct MatDesc { const float* W; int ldw, K, N; bf16_t* out; const float* gk; const float* gn; int cm; };
__device__ __forceinline__ MatDesc mat_desc(const Ctx& C, int l, int j) {
    switch (j) {
    case 0: return MatDesc{C.P->in[5] + (size_t)l * DM * INW, INW, DM, INW, C.W(l, W_IN), C.P->in[4] + l * DM, nullptr, 1};
    case 1: return MatDesc{C.P->in[9] + (size_t)l * 512 * DM, DM, 512, DM, C.W(l, W_PO), nullptr, nullptr, 0};
    case 2: return MatDesc{C.P->in[10] + (size_t)l * DM * DM, DM, DM, DM, C.W(l, W_RO), nullptr, nullptr, 0};
    case 3: return MatDesc{C.P->in[11] + (size_t)l * DM * DM, DM, DM, DM, C.W(l, W_O), nullptr, nullptr, 0};
    case 4: return MatDesc{C.P->in[13] + (size_t)l * DM * INW, INW, DM, INW, C.W(l, W_FFI), C.P->in[12] + l * DM, nullptr, 2};
    case 5: return MatDesc{C.P->in[14] + (size_t)l * DFF * DM, DM, DFF, DM, C.W(l, W_FFO), nullptr, nullptr, 0};
    case 6: return MatDesc{C.P->in[16] + (size_t)l * DM * DM, DM, DM, DM, C.W(l, W_PG), C.P->in[15] + l * DM, nullptr, 0};
    case 7: return MatDesc{C.P->in[17] + (size_t)l * PLE * DM, DM, PLE, DM, C.W(l, W_PP), nullptr, nullptr, 0};
    default: { const int g = j - 8; return MatDesc{C.P->in[6] + (size_t)(l * 4 + g) * 128 * 128, 128, 128, 128, C.W(l, W_PW) + g * 128 * 128, nullptr, C.P->in[7] + l * 512 + g * 128, 0}; }
    }
}
__device__ __forceinline__ int mat_items(int j) { return (j == 0 || j == 4) ? (DM / 32) * INW : (j == 1) ? (512 / 32) * DM : (j == 5) ? (DFF / 32) * DM : (j == 7) ? (PLE / 32) * DM : (j >= 8) ? (128 / 32) * 128 : (DM / 32) * DM; }
__device__ void conv_range(const Ctx& C, int l, int jlo, int jhi, int w, int nw) {
    int total = 0;
    for (int j = jlo; j < jhi; ++j) total += mat_items(j);
    for (int it0 = w; it0 < total; it0 += nw) {
        int it = it0, j = jlo;
        for (; j < jhi - 1; ++j) { const int cnt = mat_items(j); if (it < cnt) break; it -= cnt; }
        const MatDesc md = mat_desc(C, l, j);
        const int N = md.N, K = md.K, kb = it / N, n = it - kb * N, k0 = kb * 32;
        int src = n;
        if (md.cm == 1) { if (n >= 512 && n < 1536) { const int sec = (n - 512) >> 7, c = (n - 512) & 127; src = 512 + sec * 128 + dperm(c); } }
        if (md.cm == 2) { const int pn = n >> 8, r = n & 255; src = (r < 128) ? (128 * pn + r) : (DFF + 128 * pn + (r - 128)); }
        const float sn = md.gn ? md.gn[n] : 1.0f;
        const float* wp = md.W + (size_t)k0 * md.ldw + src;
        float v[32];
#pragma unroll
        for (int i = 0; i < 32; ++i) v[i] = wp[(size_t)i * md.ldw];
        if (md.gk) {
#pragma unroll
            for (int i = 0; i < 32; i += 4) { const f32x4 g4 = *(const f32x4*)(md.gk + k0 + i); v[i] *= g4[0]; v[i + 1] *= g4[1]; v[i + 2] *= g4[2]; v[i + 3] *= g4[3]; }
        }
        u32x4* op = (u32x4*)(md.out + (size_t)n * K + k0);
#pragma unroll
        for (int i = 0; i < 4; ++i) { u32x4 wv; wv.x = cvt_pk_bf16(v[8 * i] * sn, v[8 * i + 1] * sn); wv.y = cvt_pk_bf16(v[8 * i + 2] * sn, v[8 * i + 3] * sn);
            wv.z = cvt_pk_bf16(v[8 * i + 4] * sn, v[8 * i + 5] * sn); wv.w = cvt_pk_bf16(v[8 * i + 6] * sn, v[8 * i + 7] * sn); op[i] = wv; }
    }
}
__device__ void phase_p0(const Ctx& C, LAS unsigned char* lds) {
    (void)lds;
    {
        const int w = C.bid * 512 + C.ftid(), nw = C.G * 512;
        conv_range(C, 0, 0, 4, w, nw); conv_range(C, 0, 8, 12, w, nw); conv_range(C, 1, 8, 12, w, nw);
        if (C.G != 256) { conv_range(C, 0, 4, 8, w, nw); conv_range(C, 1, 0, 8, w, nw); }
    }
    float* COS = C.COS(); float* SIN = C.SIN();
    for (int e = C.bid * 512 + C.ftid(); e < SEQ * 64; e += C.G * 512) {
        const int pos = e >> 6, i = e & 63;
        double inv = 1.0; for (int k = 0; k < i; ++k) inv *= 0.8659643233600653;
        const double x = (double)pos * inv;
        const double n = rint(x * 0.15915494309189535);
        const double r = fma(-n, 2.4492935982947064e-16, fma(-n, 6.283185307179586, x));
        const double r2 = r * r;
        double s = 1.0, c = 1.0;
#pragma unroll
        for (int k = 17; k >= 1; --k) { s = 1.0 - s * r2 * (1.0 / (double)((2 * k) * (2 * k + 1))); c = 1.0 - c * r2 * (1.0 / (double)((2 * k - 1) * (2 * k))); }
        COS[e] = (float)c; SIN[e] = (float)(s * r);
    }
}
__device__ void phase_rows(const Ctx& C, int s_fin, int s_pre) {
    const int tid0 = C.ftid(), wid = tid0 >> 6, lane = tid0 & 63;
    float* SS0 = C.SS(0); bf16_t* XB0 = C.XB(0);
    for (int row = C.bid * 8 + wid; row < SEQ; row += C.G * 8) {
        if (s_fin >= 0) {
            float* x = C.xout(s_fin) + (size_t)row * DM; const float* gf = C.P->in[18];
            const float rstd = rstd_from_ss(SS0 + (size_t)row * 16);
#pragma unroll
            for (int i = 0; i < 4; ++i) { const int col = lane * 4 + 256 * i; const f32x4 v = unpack4(*(const u32x2*)(XB0 + (size_t)row * DM + col)), g = *(const f32x4*)(gf + col); *(f32x4*)(x + col) = v * rstd * g; }
        }
        if (s_pre >= 0) {
            const float* x = C.xin(s_pre) + (size_t)row * DM; float ss = 0.f;
#pragma unroll
            for (int i = 0; i < 4; ++i) { const int col = lane * 4 + 256 * i; const f32x4 v = *(const f32x4*)(x + col);
                ss += (v[0] * v[0] + v[1] * v[1]) + (v[2] * v[2] + v[3] * v[3]); *(u32x2*)(XB0 + (size_t)row * DM + col) = pack4(v); }
#pragma unroll
            for (int o = 32; o >= 1; o >>= 1) ss += shx(ss, lane, o);
            if (lane < 16) SS0[(size_t)row * 16 + lane] = (lane == 0) ? ss : 0.f;
#pragma unroll
            for (int l = 0; l < 2; ++l) { const f32x4 v = *(const f32x4*)(C.pin(s_pre, l) + (size_t)row * PLE + lane * 4); *(u32x2*)(C.PB(l) + (size_t)row * PLE + lane * 4) = pack4(v); }
        }
    }
}

__device__ __forceinline__ bf16x8 tr_frag(const LAS bf16_t* T, int pitch, int r0, int c0, int fr, int fq) {
#if SLOW_TR
    bf16x8 f;
#pragma unroll
    for (int j = 0; j < 8; ++j) f[j] = (short)T[(r0 + 8 * fq + j) * pitch + c0 + fr];
    return f;
#endif
    const int q = fr >> 2, p = fr & 3;
    const LAS bf16_t* a = T + (r0 + 8 * fq + q) * pitch + c0 + 4 * p;
    const s16x4 lo = __builtin_amdgcn_ds_read_tr16_b64_v4i16((LAS s16x4*)a);
    const s16x4 hi = __builtin_amdgcn_ds_read_tr16_b64_v4i16((LAS s16x4*)(a + 4 * pitch));
    return __builtin_shufflevector(lo, hi, 0, 1, 2, 3, 4, 5, 6, 7);
}
__device__ __forceinline__ bf16x8 tr_frag_cs(const LAS bf16_t* T, int pitch, int r0, int c0, int fr, int fq) {
    const int q = fr >> 2, p = fr & 3;
    const LAS bf16_t* a = T + (r0 + 8 * fq + q) * pitch + c0 + 8 * p;
    const s16x4 lo = __builtin_amdgcn_ds_read_tr16_b64_v4i16((LAS s16x4*)a);
    const s16x4 hi = __builtin_amdgcn_ds_read_tr16_b64_v4i16((LAS s16x4*)(a + 4 * pitch));
    return __builtin_shufflevector(lo, hi, 0, 1, 2, 3, 4, 5, 6, 7);
}
#define MFMA16(a, b, c) __builtin_amdgcn_mfma_f32_16x16x32_bf16((a), (b), (c), 0, 0, 0)

template <int W2> __device__ __forceinline__ void pool_window(const bf16_t* col, int tpos, f32x4& s0, f32x4& s1) {
    u32x4 d[2 * W2];
#pragma unroll
    for (int k = 0; k < 2 * W2; ++k) { const int sp = tpos - W2 + k; const int sc = ((unsigned)sp < (unsigned)SEQ) ? sp : tpos; d[k] = *(const u32x4*)(col + (size_t)sc * INW); }
#pragma unroll
    for (int k = 0; k < 2 * W2; ++k) { const int sp = tpos - W2 + k; const float m = ((unsigned)sp < (unsigned)SEQ) ? 1.0f : 0.0f; s0 = s0 + unpack_lo4(d[k]) * m; s1 = s1 + unpack_hi4(d[k]) * m; }
}
__device__ void phase_a(const Ctx& C, LAS unsigned char* lds, int layer) {
    const int tid = C.ftid(), wid = __builtin_amdgcn_readfirstlane(tid >> 6), lane = tid & 63, fr = lane & 15, fq = lane >> 4;
    LAS bf16_t* Vs = (LAS bf16_t*)lds;
    LAS bf16_t* Kf = Vs + 128 * 264;
    LAS bf16_t* Kb = Kf + 128 * 136;
    const bf16_t* Z = C.Z();
    for (int t = C.bid; t < 1024; t += C.G) {
        __syncthreads();
        if (t < 512) {
            const int c = t >> 2, h = t & 3;
            const float lgf = log2g(C.P->in[8] + layer * 8 + h), lgb = log2g(C.P->in[8] + layer * 8 + 4 + h);
            const bf16_t* zrow = Z + (size_t)(c * 128) * INW;
#pragma unroll
            for (int i = 0; i < 8; ++i) { const int idx = tid + i * 512, r = idx >> 5, v = idx & 31;
                *(LAS u32x4*)(Vs + r * 264 + v * 8) = *(const u32x4*)(zrow + (size_t)r * INW + 1536 + h * 256 + v * 8); }
#pragma unroll
            for (int i = 0; i < 4; ++i) { const int idx = tid + i * 512, r = idx >> 4, v = idx & 15;
                const u32x4 d = *(const u32x4*)(zrow + (size_t)r * INW + 1024 + h * 128 + v * 8);
                const float wf = exp2f(lgf * (float)(127 - r)), wb = exp2f(lgb * (float)r);
                const f32x4 a = unpack_lo4(d), b = unpack_hi4(d);
                *(LAS u32x4*)(Kf + r * 136 + v * 8) = pack8(a * wf, b * wf);
                *(LAS u32x4*)(Kb + r * 136 + v * 8) = pack8(a * wb, b * wb); }
            __syncthreads();
            const int eq = wid & 3, dh = wid >> 2;
            f32x4 acc[2][4][4];
#pragma unroll
            for (int a = 0; a < 2; ++a)
#pragma unroll
                for (int b = 0; b < 4; ++b)
#pragma unroll
                    for (int e4 = 0; e4 < 4; ++e4) acc[a][b][e4] = (f32x4){0.f, 0.f, 0.f, 0.f};
#pragma unroll 1
            for (int kk = 0; kk < 4; ++kk) {
                int fr = lane & 15, fq = lane >> 4; asm volatile("" : "+v"(fr), "+v"(fq));
                bf16x8 vf[4];
#pragma unroll
                for (int et = 0; et < 4; ++et) vf[et] = tr_frag(Vs, 264, 32 * kk, 64 * eq + 16 * et, fr, fq);
#pragma unroll
                for (int dir = 0; dir < 2; ++dir)
#pragma unroll
                    for (int dt = 0; dt < 4; ++dt) {
                        const bf16x8 kf = tr_frag_cs(dir ? Kb : Kf, 136, 32 * kk, 64 * dh + 32 * (dt >> 1) + 4 * (dt & 1), fr, fq);
#pragma unroll
                        for (int et = 0; et < 4; ++et) acc[dir][dt][et] = MFMA16(kf, vf[et], acc[dir][dt][et]);
                    }
            }
            bf16_t* KV = C.KV();
#pragma unroll
            for (int dir = 0; dir < 2; ++dir)
#pragma unroll
                for (int j = 0; j < 2; ++j)
#pragma unroll
                    for (int et = 0; et < 4; ++et) {
                        const int e = 64 * eq + 16 * et + fr, d = 64 * dh + 32 * j + 8 * fq;
                        *(u32x4*)(KV + ((size_t)(((c * 4 + h) * 2 + dir) * 256 + e)) * 128 + d) = pack8(acc[dir][2 * j][et], acc[dir][2 * j + 1][et]);
                    }
        } else {
            const int pt = t - 512, tb = pt >> 2, g = (pt >= 256) ? 3 - (pt & 3) : (pt & 3), w2 = 1 << g;
            LAS bf16_t* Ds = (LAS bf16_t*)lds;
#pragma unroll 1
            for (int i = 0; i < 4; ++i) {
                const int idx = tid + i * 512, r = idx >> 4, v = idx & 15, tpos = tb * 128 + r;
                const int lo = max(tpos - w2, 0), hi = min(tpos + w2, SEQ);
                const bf16_t* col = Z + g * 128 + v * 8;
                f32x4 s0 = (f32x4){0.f, 0.f, 0.f, 0.f}, s1 = s0;
                if (g == 3) pool_window<8>(col, tpos, s0, s1); else if (g == 2) pool_window<4>(col, tpos, s0, s1); else if (g == 1) pool_window<2>(col, tpos, s0, s1); else pool_window<1>(col, tpos, s0, s1);
                const float inv = 1.0f / (float)(hi - lo);
                const u32x4 d = *(const u32x4*)(col + (size_t)tpos * INW);
                *(LAS u32x4*)(Ds + r * 136 + v * 8) = pack8(s0 * inv - unpack_lo4(d), s1 * inv - unpack_hi4(d));
            }
            __syncthreads();
            const bf16_t* PW = C.W(layer, W_PW) + g * 128 * 128;
            f32x4 acc[8];
#pragma unroll
            for (int dt = 0; dt < 8; ++dt) acc[dt] = (f32x4){0.f, 0.f, 0.f, 0.f};
#pragma unroll 1
            for (int kk = 0; kk < 4; ++kk) {
                const bf16x8 df = *(const LAS bf16x8*)(Ds + (16 * wid + fr) * 136 + 32 * kk + 8 * fq);
#pragma unroll
                for (int dt = 0; dt < 8; ++dt) { const bf16x8 wf = *(const bf16x8*)(PW + (16 * dt + fr) * 128 + 32 * kk + 8 * fq); acc[dt] = MFMA16(wf, df, acc[dt]); }
            }
            bf16_t* PA = C.PA();
            const int row = tb * 128 + 16 * wid + fr;
#pragma unroll
            for (int dt = 0; dt < 8; ++dt) *(u32x2*)(PA + (size_t)row * 512 + g * 128 + 16 * dt + 4 * fq) = pack4(acc[dt]);
        }
    }
}
__device__ void phase_b(const Ctx& C, int layer) {
    u32x4* KV = (u32x4*)C.KV();
    const int tid = C.ftid();
    if (tid >= 128) return;
    for (int it = C.bid * 128 + tid; it < 32768; it += C.G * 128) {
        const int idx = it * 8, h = idx >> 16, dir = (idx >> 15) & 1;
        const float cd = exp2f(log2g(C.P->in[8] + layer * 8 + dir * 4 + h) * 128.0f);
        u32x4* base = KV + it;
        f32x4 ra = (f32x4){0.f, 0.f, 0.f, 0.f}, rb = ra;
        const int c0 = dir ? 127 : 0, st = dir ? -1 : 1;
        for (int cc = 0; cc < 128; cc += 8) { u32x4 v[8];
#pragma unroll
            for (int i = 0; i < 8; ++i) v[i] = base[(size_t)(c0 + st * (cc + i)) * 32768];
#pragma unroll
            for (int i = 0; i < 8; ++i) { base[(size_t)(c0 + st * (cc + i)) * 32768] = pack8(ra, rb); ra = ra * cd + unpack_lo4(v[i]); rb = rb * cd + unpack_hi4(v[i]); } }
    }
}
__device__ void phase_c(const Ctx& C, LAS unsigned char* lds, int layer) {
    const int tid0 = C.ftid(), wid = __builtin_amdgcn_readfirstlane(tid0 >> 6), lane = tid0 & 63;
    LAS bf16_t* Qs = (LAS bf16_t*)lds;
    LAS bf16_t* Ps = Qs + 128 * 136;
    LAS bf16_t* Vs = Ps + 128 * 136;
    LAS float* St = (LAS float*)(Vs + 128 * 264);
    const bf16_t* Z = C.Z(); const bf16_t* KV = C.KV(); bf16_t* RG = C.RG();
    for (int t = C.bid; t < 512; t += C.G) {
        const int c = t >> 2, h = t & 3;
        const float lgf = log2g(C.P->in[8] + layer * 8 + h), lgb = log2g(C.P->in[8] + layer * 8 + 4 + h);
        const bf16_t* zrow = Z + (size_t)(c * 128) * INW;
        const int e0 = 32 * wid;
        int fr = lane & 15, fq = lane >> 4;
        asm volatile("" : "+v"(fr), "+v"(fq));
        bf16x8 sf[2][2][4];
#pragma unroll
        for (int dir = 0; dir < 2; ++dir) {
            const bf16_t* sb = KV + (size_t)(((c * 4 + h) * 2 + dir) * 256) * 128;
#pragma unroll
            for (int et = 0; et < 2; ++et)
#pragma unroll
                for (int kk = 0; kk < 4; ++kk) sf[dir][et][kk] = *(const bf16x8*)(sb + (size_t)(e0 + 16 * et + fr) * 128 + 32 * kk + 8 * fq);
        }
        __syncthreads();
        { const int tid = C.ftid();
#pragma unroll
        for (int i = 0; i < 8; ++i) { const int idx = tid + i * 512, r = idx >> 5, v = idx & 31;
            *(LAS u32x4*)(Vs + r * 264 + v * 8) = *(const u32x4*)(zrow + (size_t)r * INW + 1536 + h * 256 + v * 8); }
#pragma unroll
        for (int i = 0; i < 4; ++i) { const int idx = tid + i * 512, r = idx >> 4, v = idx & 15;
            *(LAS u32x4*)(Qs + r * 136 + v * 8) = *(const u32x4*)(zrow + (size_t)r * INW + 512 + h * 128 + v * 8);
            *(LAS u32x4*)(Ps + r * 136 + v * 8) = *(const u32x4*)(zrow + (size_t)r * INW + 1024 + h * 128 + v * 8); }
        }
        __syncthreads();
        asm volatile("" : "+v"(fr), "+v"(fq));
        f32x4 sc[8];
        {
            const int i0 = 16 * wid;
            bf16x8 qf[4];
#pragma unroll
            for (int kk = 0; kk < 4; ++kk) qf[kk] = *(const LAS bf16x8*)(Qs + (i0 + fr) * 136 + 32 * kk + 8 * fq);
#pragma unroll
            for (int jt = 0; jt < 8; ++jt) {
                f32x4 a = (f32x4){0.f, 0.f, 0.f, 0.f};
#pragma unroll
                for (int kk = 0; kk < 4; ++kk) { const bf16x8 kf = *(const LAS bf16x8*)(Ps + (16 * jt + fr) * 136 + 32 * kk + 8 * fq); a = MFMA16(kf, qf[kk], a); }
                const int i = i0 + fr;
#pragma unroll
                for (int r = 0; r < 4; ++r) { const int j = 16 * jt + 4 * fq + r, dl = i - j; a[r] *= (dl >= 0) ? exp2f(lgf * (float)dl) : exp2f(lgb * (float)(-dl)); }
                sc[jt] = a;
            }
        }
        __syncthreads();
        {
            const int i = 16 * wid + fr;
#pragma unroll
            for (int jt = 0; jt < 8; ++jt) *(LAS u32x2*)(Ps + i * 136 + 16 * jt + 4 * fq) = pack4(sc[jt]);
        }
        __syncthreads();
        asm volatile("" : "+v"(fr), "+v"(fq));
        f32x4 y[8][2];
#pragma unroll
        for (int m = 0; m < 8; ++m) { y[m][0] = (f32x4){0.f, 0.f, 0.f, 0.f}; y[m][1] = (f32x4){0.f, 0.f, 0.f, 0.f}; }
#pragma unroll 1
        for (int kk = 0; kk < 4; ++kk) {
            bf16x8 vf[2];
#pragma unroll
            for (int et = 0; et < 2; ++et) vf[et] = tr_frag(Vs, 264, 32 * kk, e0 + 16 * et, fr, fq);
#pragma unroll
            for (int m = 0; m < 8; ++m) { const bf16x8 pf = *(const LAS bf16x8*)(Ps + (16 * m + fr) * 136 + 32 * kk + 8 * fq);
                y[m][0] = MFMA16(vf[0], pf, y[m][0]); y[m][1] = MFMA16(vf[1], pf, y[m][1]); }
        }
#pragma unroll
        for (int dir = 0; dir < 2; ++dir) {
            asm volatile("" : "+v"(fr), "+v"(fq));
#pragma unroll
            for (int m = 0; m < 8; ++m) {
                f32x4 t0 = (f32x4){0.f, 0.f, 0.f, 0.f}, t1 = t0;
#pragma unroll
                for (int kk = 0; kk < 4; ++kk) { const bf16x8 qq = *(const LAS bf16x8*)(Qs + (16 * m + fr) * 136 + 32 * kk + 8 * fq); t0 = MFMA16(sf[dir][0][kk], qq, t0); t1 = MFMA16(sf[dir][1][kk], qq, t1); }
                const int i = 16 * m + fr;
                const float scl = (dir == 0) ? exp2f(lgf * (float)(i + 1)) : exp2f(lgb * (float)(128 - i));
                y[m][0] = y[m][0] + t0 * scl; y[m][1] = y[m][1] + t1 * scl;
                if (m & 1) asm volatile("" ::: "memory");
            }
        }
        asm volatile("" : "+v"(fr), "+v"(fq));
        u32x2 gsw[8][2];
#pragma unroll
        for (int m = 0; m < 8; ++m)
#pragma unroll
            for (int et = 0; et < 2; ++et) gsw[m][et] = *(const u32x2*)(zrow + (size_t)(16 * m + fr) * INW + 2560 + h * 256 + e0 + 16 * et + 4 * fq);
#pragma unroll
        for (int m = 0; m < 8; ++m) {
            const f32x4 a = y[m][0], b = y[m][1];
            float s = (a[0] + a[1]) + (a[2] + a[3]) + (b[0] + b[1]) + (b[2] + b[3]);
            float q = (a[0] * a[0] + a[1] * a[1]) + (a[2] * a[2] + a[3] * a[3]) + (b[0] * b[0] + b[1] * b[1]) + (b[2] * b[2] + b[3] * b[3]);
            { const int ln = fq * 16 + fr; s += shx(s, ln, 16); s += shx(s, ln, 32); q += shx(q, ln, 16); q += shx(q, ln, 32); }
            if (fq == 0) { St[(16 * m + fr) * 16 + wid * 2] = s; St[(16 * m + fr) * 16 + wid * 2 + 1] = q; }
        }
        __syncthreads();
#pragma unroll
        for (int m = 0; m < 8; ++m) {
            const int i = 16 * m + fr;
            const LAS f32x4* sp = (const LAS f32x4*)(St + i * 16);
            const f32x4 p0 = sp[0], p1 = sp[1], p2 = sp[2], p3 = sp[3];
            const float s = (p0[0] + p0[2]) + (p1[0] + p1[2]) + (p2[0] + p2[2]) + (p3[0] + p3[2]);
            const float q = (p0[1] + p0[3]) + (p1[1] + p1[3]) + (p2[1] + p2[3]) + (p3[1] + p3[3]);
            const float mean = s * (1.0f / 256.0f), var = fmaxf(q * (1.0f / 256.0f) - mean * mean, 0.f);
            const float rstd = __builtin_amdgcn_rsqf(var + 1e-5f);
            const size_t row = (size_t)(c * 128 + i);
#pragma unroll
            for (int et = 0; et < 2; ++et) {
                const int e = e0 + 16 * et + 4 * fq;
                *(u32x2*)(RG + row * DM + h * 256 + e) = pack4((y[m][et] - mean) * rstd * unpack4(gsw[m][et]));
            }
        }
    }
}

__device__ __forceinline__ void run_phase(const Ctx& C, LAS unsigned char* lds, int ph) {
    if (ph == 0) { phase_p0(C, lds); phase_rows(C, -1, 0); return; }
    const int q = ph - 1, s = q / 19, r = q % 19;
    if (r == 18) { phase_rows(C, s, s < 2 ? s + 1 : -1); return; }
    const int layer = r / 9, st = r % 9, cur = layer, G = C.G, bid = C.bid;
    pg8::StaticOrder S;
    switch (st) {
    case 0: { pg8::Gemm g{C.XB(cur), C.W(layer, W_IN), SEQ, INW, DM}; S.init(SEQ, INW, G, bid, 2);
              EpiZ E{C.Z(), C.SS(cur), C.COS(), C.SIN()}; pg8::gemm_phase(C.ftid(), lds, g, S, E);
              if (s == 0 && G == 256 && bid >= 128) conv_range(C, layer, 4, 8, (bid - 128) * 512 + C.ftid(), 128 * 512); } break;
    case 1: phase_a(C, lds, layer); break;
    case 2: phase_b(C, layer); break;
    case 3: phase_c(C, lds, layer); break;
    case 4: { S.init(SEQ, DM, G, bid);
              { pg8::Gemm g{C.PA(), C.W(layer, W_PO), SEQ, DM, 512}; EpiGen<0> E{C.TMP(), nullptr, C.Z() + 3584, nullptr}; pg8::gemm_phase(C.ftid(), lds, g, S, E); }
              { pg8::Gemm g{C.RG(), C.W(layer, W_RO), SEQ, DM, DM}; EpiGen<1> E{C.MG(), C.TMP(), C.Z() + 3584 + 1024, nullptr}; pg8::gemm_phase(C.ftid(), lds, g, S, E); } } break;
    case 5: { pg8::Gemm g{C.MG(), C.W(layer, W_O), SEQ, DM, DM}; S.init(SEQ, DM, G, bid);
              if (layer == 0) { EpiResid<false, true> E{C.xin(s), nullptr, C.XB(cur ^ 1), C.SS(cur ^ 1), nullptr}; pg8::gemm_phase(C.ftid(), lds, g, S, E); }
              else { EpiResid<false, false> E{nullptr, C.XB(cur), C.XB(cur ^ 1), C.SS(cur ^ 1), nullptr}; pg8::gemm_phase(C.ftid(), lds, g, S, E); } } break;
    case 6: { pg8::Gemm g{C.XB(cur ^ 1), C.W(layer, W_FFI), SEQ, INW, DM}; S.init(SEQ, INW, G, bid);
              EpiSwiGLU E{C.Z(), C.SS(cur ^ 1)}; pg8::gemm_phase(C.ftid(), lds, g, S, E);
              if (s == 0 && layer == 0 && G == 256 && bid >= 128) conv_range(C, 1, 0, 4, (bid - 128) * 512 + C.ftid(), 128 * 512); } break;
    case 7: { pg8::Gemm g{C.Z(), C.W(layer, W_FFO), SEQ, DM, DFF}; S.init(SEQ, DM, G, bid);
              EpiResid<false, false> E{nullptr, C.XB(cur ^ 1), C.XB(cur), C.SS(cur), nullptr}; pg8::gemm_phase(C.ftid(), lds, g, S, E); } break;
    default: { S.init(SEQ, DM, G, bid);
              { pg8::Gemm g{C.XB(cur), C.W(layer, W_PG), SEQ, DM, DM}; EpiGen<2> E{C.TMP(), nullptr, nullptr, C.SS(cur)}; pg8::gemm_phase(C.ftid(), lds, g, S, E); }
              { pg8::Gemm g{C.PB(layer), C.W(layer, W_PP), SEQ, DM, PLE}; EpiResid<true, false> E{nullptr, C.XB(cur), C.XB(cur ^ 1), C.SS(cur ^ 1), C.TMP()}; pg8::gemm_phase(C.ftid(), lds, g, S, E); } } break;
    }
}


#define XB_TMO      128
#define XB_XCNT(j)  (256  + 64 * (j))
#define XB_XSUB(j)  (1280 + 64 * (j))
#define XB_XGEN(j)  (2304 + 64 * (j))
#define XB_TOP      3328
#define XB_TOPGEN   3392
#define XCD_BAR_WORDS 3456
#define XB_SPIN_CAP (1u << 18)
__device__ __forceinline__ unsigned xb_ld(unsigned* p)              { return __hip_atomic_load(p, __ATOMIC_RELAXED, __HIP_MEMORY_SCOPE_AGENT); }
__device__ __forceinline__ unsigned xb_add(unsigned* p, unsigned v) { return __hip_atomic_fetch_add(p, v, __ATOMIC_RELAXED, __HIP_MEMORY_SCOPE_AGENT); }
__device__ __forceinline__ unsigned xb_xcc_id() { return (unsigned)__builtin_amdgcn_s_getreg((3 << 11) | 20) & 0xFu; }
#define XB_SPIN(cond, bar) do { unsigned _sp = 0; while (cond) { __builtin_amdgcn_s_sleep(1); \
    if ((++_sp & 255u) == 0u) { if (xb_ld(&(bar)[XB_TMO])) break; if (_sp > XB_SPIN_CAP) { atomicAdd(&(bar)[XB_TMO], 1u); break; } } } } while (0)
struct XcdBarrier { unsigned* bar; unsigned x; volatile LAS unsigned* st; };
__device__ __forceinline__ XcdBarrier xcd_barrier_post(unsigned* bar, volatile LAS unsigned* st, bool leader) {
    XcdBarrier b; b.bar = bar; b.x = xb_xcc_id(); b.st = st;
    if (leader) (void)xb_add(&bar[XB_XCNT(b.x)], 1u);
    return b;
}
__device__ __forceinline__ void xcd_barrier_complete(unsigned* bar, unsigned x, unsigned& nloc, unsigned& nx) {
    const unsigned G = gridDim.x * gridDim.y * gridDim.z;
    unsigned sum, cnt, mine, sp = 0u;
    for (;;) {
        sum = 0u; cnt = 0u; mine = 0u;
#pragma unroll
        for (unsigned j = 0; j < 16; ++j) { const unsigned c = xb_ld(&bar[XB_XCNT(j)]); sum += c; cnt += (c > 0u) ? 1u : 0u; mine = (j == x) ? c : mine; }
        if (sum == G) break;
        __builtin_amdgcn_s_sleep(1);
        if ((++sp & 255u) == 0u) { if (xb_ld(&bar[XB_TMO])) break; if (sp > XB_SPIN_CAP) { atomicAdd(&bar[XB_TMO], 1u); break; } }
    }
    nloc = mine > 0u ? mine : 1u; nx = cnt > 0u ? cnt : 1u;
}
__device__ __forceinline__ void xcd_barrier(const XcdBarrier& b, int wv) {
    asm volatile("s_waitcnt vmcnt(0)" ::: "memory");
    __syncthreads();
    if (wv == 0 && lane_now() == 0) {
        unsigned* bar = b.bar;
        __builtin_amdgcn_s_waitcnt(0);
        unsigned nloc = b.st[0], nx = b.st[1];
        if (nloc == 0u) { xcd_barrier_complete(bar, b.x, nloc, nx); b.st[0] = nloc; b.st[1] = nx; }
        const unsigned old = xb_add(&bar[XB_XSUB(b.x)], 1u);
        const unsigned gen = old / nloc;
        if (old + 1u == (gen + 1u) * nloc) {
            __builtin_amdgcn_fence(__ATOMIC_RELEASE, "agent");
            asm volatile("s_waitcnt vmcnt(0)" ::: "memory");
            const unsigned og = xb_add(&bar[XB_TOP], 1u);
            const unsigned tg = og / nx;
            if (og + 1u == (tg + 1u) * nx) xb_add(&bar[XB_TOPGEN], 1u);
            else XB_SPIN(xb_ld(&bar[XB_TOPGEN]) == tg, bar);
            __builtin_amdgcn_fence(__ATOMIC_ACQUIRE, "agent");
            xb_add(&bar[XB_XGEN(b.x)], 1u);
            asm volatile("s_waitcnt vmcnt(0)" ::: "memory");
        } else {
            XB_SPIN(xb_ld(&bar[XB_XGEN(b.x)]) == gen, bar);
            __builtin_amdgcn_fence(__ATOMIC_ACQUIRE, "agent");
            asm volatile("s_waitcnt vmcnt(0)" ::: "memory");
        }
    }
    __syncthreads();
}

__global__ void __launch_bounds__(512, 2) mk_fwd(Params P) {
    extern __shared__ __attribute__((aligned(16))) unsigned char lds_raw[];
    LAS unsigned char* lds = (LAS unsigned char*)lds_raw;
    const int wv0 = __builtin_amdgcn_readfirstlane((int)threadIdx.x >> 6);
    const bool leader0 = (threadIdx.x == 0);
    volatile LAS unsigned* bst = (volatile LAS unsigned*)(lds + LDS_BYTES - 16);
    XcdBarrier bar; bar.bar = (unsigned*)(P.ws + WS_END); bar.x = 0; bar.st = bst;
    if (P.ph_hi - P.ph_lo > 1) {
        if (leader0) { bst[0] = 0u; bst[1] = 0u; }
        __syncthreads();
        bar = xcd_barrier_post((unsigned*)(P.ws + WS_END), bst, leader0);
    }
    for (int ph = P.ph_lo; ph < P.ph_hi; ++ph) {
        int wv = wv0, bid = blockIdx.x, G = gridDim.x;
        asm volatile("" : "+s"(wv), "+s"(bid), "+s"(G));
        KPtr pp = (KPtr)__builtin_amdgcn_kernarg_segment_ptr();
        asm volatile("" : "+s"(pp));
        Ctx C{pp, pp->out, pp->ws, wv, bid, G};
        run_phase(C, lds, ph);
#if REP_MASK
        { int cls; if (ph == 0) cls = 10; else { const int r = (ph - 1) % 19; cls = (r == 18) ? 9 : (r % 9); }
          if ((REP_MASK >> cls) & 1) { __syncthreads(); run_phase(C, lds, ph); } }
#endif
        if (ph + 1 < P.ph_hi) { if (ph == P.ph_lo) cg::this_grid().sync(); else xcd_barrier(bar, wv0); }
    }
}

extern "C" void kernel_launch(void* const* d_in, const int* in_sizes, int n_in, void* d_out, int out_size, void* d_ws, size_t ws_size, hipStream_t stream) {
    static int grid = 0;
    if (grid == 0) {
        if (n_in != 19 || ws_size < WS_END + XCD_BAR_WORDS * 4) { fprintf(stderr, "kernel_launch: unexpected n_in %d / ws %zu (need %zu)\n", n_in, ws_size, (size_t)WS_END); grid = -1; return; }
        int dev = 0, cus = 0, per_cu = 0;
        hipGetDevice(&dev); hipDeviceGetAttribute(&cus, hipDeviceAttributeMultiprocessorCount, dev);
        hipFuncSetAttribute((const void*)mk_fwd, hipFuncAttributeMaxDynamicSharedMemorySize, LDS_BYTES);
        hipOccupancyMaxActiveBlocksPerMultiprocessor(&per_cu, (const void*)mk_fwd, 512, LDS_BYTES);
        if (per_cu < 1) per_cu = 1;
        (void)hipGetLastError();
        grid = cus * per_cu;
    }
    if (grid < 0) return;
    if (hipMemsetAsync((char*)d_ws + WS_END, 0, XCD_BAR_WORDS * 4, stream) != hipSuccess) { fprintf(stderr, "kernel_launch: memset of barrier words failed\n"); return; }
    Params p{};
    for (int i = 0; i < 19; ++i) p.in[i] = (const float*)d_in[i];
    p.out = (float*)d_out; p.ws = (unsigned char*)d_ws;
#if MULTI_LAUNCH
    for (int ph = 0; ph < NPH; ++ph) { p.ph_lo = ph; p.ph_hi = ph + 1; hipLaunchKernelGGL(mk_fwd, dim3(grid), dim3(512), LDS_BYTES, stream, p); }
#else
    p.ph_lo = 0; p.ph_hi = NPH;
    void* args[] = {&p};
    hipError_t e = hipLaunchCooperativeKernel((const void*)mk_fwd, dim3(grid), dim3(512), args, LDS_BYTES, stream);
    if (e != hipSuccess) fprintf(stderr, "cooperative launch failed: %s (grid %d)\n", hipGetErrorString(e), grid);
#endif
}
```

```cpp
#include <hip/hip_runtime.h>
#include <hip/hip_cooperative_groups.h>
#include <cstdio>
namespace cg = cooperative_groups;

#ifndef SLOW_TR
#define SLOW_TR 0
#endif
#ifndef REP_MASK
#define REP_MASK 0
#endif
#ifndef MULTI_LAUNCH
#define MULTI_LAUNCH 0
#endif

#define LAS __attribute__((address_space(3)))
typedef unsigned short bf16_t;
typedef short bf16x8 __attribute__((ext_vector_type(8)));
typedef short s16x4 __attribute__((ext_vector_type(4)));
typedef float f32x4 __attribute__((ext_vector_type(4)));
typedef unsigned u32x4 __attribute__((ext_vector_type(4)));
typedef unsigned u32x2 __attribute__((ext_vector_type(2)));

constexpr int SEQ = 16384, DM = 1024, INW = 5632, DFF = 2816, PLE = 256;
constexpr int NPH = 58;
constexpr size_t W_IN = 0, W_PO = W_IN + (size_t)INW * DM * 2, W_RO = W_PO + (size_t)DM * 512 * 2, W_O = W_RO + (size_t)DM * DM * 2,
                 W_FFI = W_O + (size_t)DM * DM * 2, W_FFO = W_FFI + (size_t)INW * DM * 2, W_PG = W_FFO + (size_t)DM * DFF * 2,
                 W_PP = W_PG + (size_t)DM * DM * 2, W_PW = W_PP + (size_t)DM * PLE * 2, W_LAYER = W_PW + (size_t)4 * 128 * 128 * 2;
constexpr size_t WS_W = 0, WS_COS = WS_W + 2 * W_LAYER, WS_SIN = WS_COS + (size_t)SEQ * 64 * 4, WS_XB = WS_SIN + (size_t)SEQ * 64 * 4,
                 WS_SS = WS_XB + 2 * (size_t)SEQ * DM * 2, WS_Z = WS_SS + 2 * (size_t)SEQ * 16 * 4, WS_KV = WS_Z + (size_t)SEQ * INW * 2,
                 WS_PA = WS_KV + (size_t)128 * 4 * 2 * 256 * 128 * 2, WS_RG = WS_PA + (size_t)SEQ * 512 * 2, WS_PB = WS_RG + (size_t)SEQ * DM * 2,
                 WS_END = WS_PB + 2 * (size_t)SEQ * PLE * 2;
constexpr int LDS_BYTES = 147456 + 64;
constexpr int LDS_RS = 131072, LDS_RSTAG = 131072 + 16384;

typedef float f32x2_t __attribute__((ext_vector_type(2)));
typedef __bf16 bf16x2_t __attribute__((ext_vector_type(2)));
__device__ __forceinline__ unsigned cvt_pk_bf16(float lo, float hi) { const f32x2_t v = {lo, hi}; return __builtin_bit_cast(unsigned, __builtin_convertvector(v, bf16x2_t)); }
__device__ __forceinline__ float bf_lo(unsigned u) { return __uint_as_float(u << 16); }
__device__ __forceinline__ float bf_hi(unsigned u) { return __uint_as_float(u & 0xffff0000u); }
__device__ __forceinline__ float sigmoid_f(float x) { return __builtin_amdgcn_rcpf(1.0f + __expf(-x)); }
__device__ __forceinline__ float sigmoid_sc(float v, float nrl) { return __builtin_amdgcn_rcpf(1.0f + __builtin_amdgcn_exp2f(v * nrl)); }
__device__ __forceinline__ float sigmoid_scm(float v, float nrl, float ic) { return __builtin_amdgcn_rcpf(__builtin_fmaf(__builtin_amdgcn_exp2f(v * nrl), ic, ic)); }
__device__ __forceinline__ float silu_f(float x) { return x * sigmoid_f(x); }
__device__ __forceinline__ u32x2 pack4(f32x4 v) { u32x2 w; w.x = cvt_pk_bf16(v[0], v[1]); w.y = cvt_pk_bf16(v[2], v[3]); return w; }
__device__ __forceinline__ u32x4 pack8(f32x4 a, f32x4 b) { u32x4 w; w.x = cvt_pk_bf16(a[0], a[1]); w.y = cvt_pk_bf16(a[2], a[3]); w.z = cvt_pk_bf16(b[0], b[1]); w.w = cvt_pk_bf16(b[2], b[3]); return w; }
__device__ __forceinline__ f32x4 unpack_lo4(u32x4 w) { return (f32x4){bf_lo(w.x), bf_hi(w.x), bf_lo(w.y), bf_hi(w.y)}; }
__device__ __forceinline__ f32x4 unpack_hi4(u32x4 w) { return (f32x4){bf_lo(w.z), bf_hi(w.z), bf_lo(w.w), bf_hi(w.w)}; }
__device__ __forceinline__ f32x4 unpack4(u32x2 w) { return (f32x4){bf_lo(w.x), bf_hi(w.x), bf_lo(w.y), bf_hi(w.y)}; }
__device__ __forceinline__ float log2g(const float* logit) {
    const float x = *logit, u = __expf(-x);
    float l = u * (1.f - u * (0.5f - u * (0.33333334f - u * (0.25f - u * (0.2f - u * 0.16666667f)))));
    if (u > 0.0625f) l = __logf(1.0f + u);
    return -l * 1.4426950408889634f;
}
__device__ __forceinline__ float rstd_from_ss(const float* ss) {
    const f32x4* sp = (const f32x4*)ss; const f32x4 a = sp[0], b = sp[1], c = sp[2], d = sp[3];
    const f32x4 t = (a + b) + (c + d); const float s = (t[0] + t[1]) + (t[2] + t[3]);
    return __builtin_amdgcn_rsqf(s * (1.0f / 1024.0f) + 1e-6f);
}

__device__ __forceinline__ float shx(float v, int lane, int m) { return __int_as_float(__builtin_amdgcn_ds_bpermute((lane ^ m) << 2, __float_as_int(v))); }
__device__ __forceinline__ int lane_now() { int l; asm volatile("v_mbcnt_lo_u32_b32 %0, -1, 0\n\tv_mbcnt_hi_u32_b32 %0, -1, %0" : "=v"(l)); return l; }
namespace pg8 {
constexpr int BM = 256, BK = 64, HALF = 128, HTB = HALF * BK * 2, STAGE_BYTES = 8 * HTB, NXCD = 8, WGM = 8;
__host__ __device__ __forceinline__ int lds_byte(int r, int c) { const int st = (r >> 4) * 2 + (c >> 5), rr = r & 15, cc = c & 31, ob = rr * 64 + cc * 2; return st * 1024 + (ob ^ (((ob >> 9) & 1) << 5)); }
__host__ __device__ __forceinline__ void stage_rc(int b, int& R, int& C) { const int st = b / 1024, sb = b % 1024, swz = sb ^ (((sb >> 9) & 1) << 5); R = (st >> 1) * 16 + swz / 64; C = (st & 1) * 32 + (swz % 64) / 2; }
__host__ __device__ __forceinline__ int perm32(int rho) { const int n = rho >> 4, i = rho & 15; return 8 * (i >> 2) + 4 * n + (i & 3); }
struct Unit { int pm, pn; };
struct Gemm { const bf16_t* A; const bf16_t* Bt; int M, N, K; };
struct StaticOrder {
    int nM, nN, nwg, G, c, rot;
    __device__ void init(int M, int N, int G_, int c_, int rot_ = 0) { nM = M / BM; nN = N / BM; nwg = nM * nN; G = G_; c = c_; rot = rot_; }
    __device__ bool next(int i, Unit& u) const {
        const long L = (long)i * G + c; if (L >= nwg) return false;
        int wgid = (int)L; { const int q = nwg / NXCD, r = nwg % NXCD, xcd = wgid % NXCD, off = wgid / NXCD; wgid = (xcd < r ? xcd * (q + 1) : r * (q + 1) + (xcd - r) * q) + off; }
        const int nig = WGM * nN, gid = wgid / nig, fm = gid * WGM, gsz = (nM - fm) < WGM ? (nM - fm) : WGM;
        u.pm = fm + ((wgid % nig) % gsz); { const int p = (wgid % nig) / gsz + rot; u.pn = p >= nN ? p - nN : p; } return true;
    }
};
template <class Epi>
__device__ __forceinline__ void gemm_phase(const int tid, LAS unsigned char* lds, const Gemm g, const StaticOrder& S, const Epi& E) {
    const int wid = __builtin_amdgcn_readfirstlane(tid >> 6), lane = tid & 63, wr = wid >> 2, wc = wid & 3, fr = lane & 15, fq = lane >> 4;
    const int K = g.K, nt = K / BK;
    unsigned voffA[2], voffB[2];
#pragma unroll
    for (int i = 0; i < 2; ++i) { int R, C; stage_rc(tid * 16 + i * 8192, R, C); const int Rb = Epi::PERM ? ((R & ~31) + perm32(R & 31)) : R;
        voffA[i] = (unsigned)(R * K + C) * 2u; voffB[i] = (unsigned)(Rb * K + C) * 2u; }
    const size_t kstep = (size_t)(BK * 2);
    const size_t hstep = (size_t)HALF * K * 2;
    const size_t tstep = 2 * hstep;
    const unsigned ldsw = (unsigned)wid * 1024u;
    const int aoff = lds_byte(wr * 64 + fr, fq * 8), boff = lds_byte(wc * 32 + fr, fq * 8);
#define PG8_SA(b, h) (((b) * 2 + (h)) * HTB)
#define PG8_SB(b, h) ((4 + (b) * 2 + (h)) * HTB)
#define PG8_STAGE(bufoff, gbase, voff) do { _Pragma("unroll") for (int _i = 0; _i < 2; ++_i) { unsigned _vo = (voff)[_i]; asm volatile("" : "+v"(_vo)); \
        __builtin_amdgcn_global_load_lds((const unsigned*)((const char*)(gbase) + _vo), (LAS unsigned*)(lds + (bufoff) + ldsw + _i * 8192), 16, 0, 0); } } while (0)
#define PG8_LDA(dst, b, h) do { _Pragma("unroll") for (int m = 0; m < 4; ++m) _Pragma("unroll") for (int k = 0; k < 2; ++k) dst[m][k] = *(const LAS bf16x8*)(lds + PG8_SA(b, h) + aoff + m * 2048 + k * 1024); } while (0)
#define PG8_LDB(dst, b, h) do { _Pragma("unroll") for (int n = 0; n < 2; ++n) _Pragma("unroll") for (int k = 0; k < 2; ++k) dst[n][k] = *(const LAS bf16x8*)(lds + PG8_SB(b, h) + boff + n * 2048 + k * 1024); } while (0)
#define PG8_MMA(ai, bj, At, Bt) do { __builtin_amdgcn_s_setprio(1); _Pragma("unroll") for (int m = 0; m < 4; ++m) _Pragma("unroll") for (int n = 0; n < 2; ++n) _Pragma("unroll") for (int k = 0; k < 2; ++k) \
        acc[ai][bj][m][n] = __builtin_amdgcn_mfma_f32_16x16x32_bf16(Bt[n][k], At[m][k], acc[ai][bj][m][n], 0, 0, 0); __builtin_amdgcn_s_setprio(0); } while (0)
#define PG8_WAIT_V(n) asm volatile("s_waitcnt vmcnt(" #n ")" ::: "memory")
#define PG8_WAIT_L(n) asm volatile("s_waitcnt lgkmcnt(" #n ")" ::: "memory")
#define PG8_BAR __builtin_amdgcn_s_barrier()
#define PG8_SCHED __builtin_amdgcn_sched_barrier(0)
    Unit cur, nxt; int ui = 0;
    if (!S.next(0, cur)) return;
    f32x4 acc[2][2][4][2];
#pragma unroll
    for (int a = 0; a < 2; ++a)
#pragma unroll
        for (int b = 0; b < 2; ++b)
#pragma unroll
            for (int m = 0; m < 4; ++m)
#pragma unroll
                for (int n = 0; n < 2; ++n) acc[a][b][m][n] = (f32x4){0.f, 0.f, 0.f, 0.f};
    bf16x8 At[4][2], B0[2][2], B1[2][2];
    const char* cA = (const char*)g.A + (size_t)cur.pm * tstep; const char* cB = (const char*)g.Bt + (size_t)cur.pn * tstep;
    PG8_STAGE(PG8_SB(0, 0), cB, voffB); PG8_STAGE(PG8_SA(0, 0), cA, voffA); PG8_STAGE(PG8_SB(0, 1), cB + hstep, voffB); PG8_STAGE(PG8_SA(0, 1), cA + hstep, voffA);
    if (wr == 1) PG8_BAR;
    PG8_WAIT_V(4); PG8_BAR;
    PG8_STAGE(PG8_SB(1, 0), cB + kstep, voffB); PG8_STAGE(PG8_SA(1, 0), cA + kstep, voffA); PG8_STAGE(PG8_SB(1, 1), cB + hstep + kstep, voffB);
    PG8_WAIT_V(6); PG8_BAR;
    for (;;) {
        const bool has_next = S.next(ui + 1, nxt);
        const char* nA = has_next ? (const char*)g.A + (size_t)nxt.pm * tstep : cA; const char* nB = has_next ? (const char*)g.Bt + (size_t)nxt.pn * tstep : cB;
        for (int t = 0; t < nt; t += 2) {
            const bool last = (t == nt - 2);
            const char* a1 = cA + (size_t)(t + 1) * kstep;
            const char* a2 = last ? nA : cA + (size_t)(t + 2) * kstep; const char* b2 = last ? nB : cB + (size_t)(t + 2) * kstep;
            const char* a3 = a2 + kstep; const char* b3 = b2 + kstep;
            PG8_LDB(B0, 0, 0); PG8_SCHED; PG8_LDA(At, 0, 0); PG8_STAGE(PG8_SA(1, 1), a1 + hstep, voffA);
            PG8_WAIT_L(8); PG8_BAR; PG8_WAIT_L(0); PG8_MMA(0, 0, At, B0); PG8_BAR; PG8_SCHED;
            PG8_LDB(B1, 0, 1); PG8_STAGE(PG8_SB(0, 0), b2, voffB);
            PG8_BAR; PG8_WAIT_L(0); PG8_MMA(0, 1, At, B1); PG8_BAR;
            PG8_LDA(At, 0, 1); PG8_STAGE(PG8_SA(0, 0), a2, voffA);
            PG8_BAR; PG8_WAIT_L(0); PG8_MMA(1, 0, At, B0); PG8_BAR; PG8_SCHED;
            PG8_STAGE(PG8_SB(0, 1), b2 + hstep, voffB);
            PG8_WAIT_V(6); PG8_BAR; PG8_MMA(1, 1, At, B1); PG8_BAR;
            PG8_LDB(B0, 1, 0); PG8_SCHED; PG8_LDA(At, 1, 0); PG8_STAGE(PG8_SA(0, 1), a2 + hstep, voffA);
            PG8_WAIT_L(8); PG8_BAR; PG8_WAIT_L(0); PG8_MMA(0, 0, At, B0); PG8_BAR; PG8_SCHED;
            PG8_LDB(B1, 1, 1); PG8_STAGE(PG8_SB(1, 0), b3, voffB);
            PG8_BAR; PG8_WAIT_L(0); PG8_MMA(0, 1, At, B1); PG8_BAR;
            PG8_LDA(At, 1, 1); PG8_STAGE(PG8_SA(1, 0), a3, voffA);
            PG8_BAR; PG8_WAIT_L(0); PG8_MMA(1, 0, At, B0); PG8_BAR; PG8_SCHED;
            PG8_STAGE(PG8_SB(1, 1), b3 + hstep, voffB);
            PG8_WAIT_V(6); PG8_BAR; PG8_MMA(1, 1, At, B1); PG8_BAR;
        }
        E(acc, cur, wr, wc, fr, fq);
        if (!has_next) break;
#pragma unroll
        for (int a = 0; a < 2; ++a)
#pragma unroll
            for (int b = 0; b < 2; ++b)
#pragma unroll
                for (int m = 0; m < 4; ++m)
#pragma unroll
                    for (int n = 0; n < 2; ++n) acc[a][b][m][n] = (f32x4){0.f, 0.f, 0.f, 0.f};
        cur = nxt; cA = nA; cB = nB; ++ui;
    }
    PG8_WAIT_V(0);
    if (wr == 0) PG8_BAR;
    PG8_BAR;
#undef PG8_SA
#undef PG8_SB
#undef PG8_STAGE
#undef PG8_LDA
#undef PG8_LDB
#undef PG8_MMA
#undef PG8_WAIT_V
#undef PG8_WAIT_L
#undef PG8_BAR
#undef PG8_SCHED
}
}
using pg8::Unit;

__device__ __forceinline__ void load_rstd8(const float* SS, int row0, int fr, int fq, float (&rstd)[8]) {
    const int ln = fq * 16 + fr;
    f32x4 q[8];
#pragma unroll
    for (int i = 0; i < 8; ++i) q[i] = *(const f32x4*)(SS + (size_t)(row0 + (i >> 2) * 128 + (i & 3) * 16) * 16 + fq * 4);
#pragma unroll
    for (int i = 0; i < 8; ++i) { float s = (q[i][0] + q[i][1]) + (q[i][2] + q[i][3]); s += shx(s, ln, 16); s += shx(s, ln, 32); rstd[i] = __builtin_amdgcn_rsqf(s * (1.0f / 1024.0f) + 1e-6f); }
}

__device__ __forceinline__ void cached_rstd8(LAS unsigned char* lds, const float* SS, int pm, int wave, int row0, int fr, int fq, float (&rs)[8]) {
    LAS float* slot = (LAS float*)(lds + LDS_RS) + (wave * 64 + fq * 16 + fr) * 8;
    LAS int* tag = (LAS int*)(lds + LDS_RSTAG) + wave;
    if (*tag == pm) {
        const f32x4 a = *(const LAS f32x4*)slot, b = *(const LAS f32x4*)(slot + 4);
        rs[0] = a[0]; rs[1] = a[1]; rs[2] = a[2]; rs[3] = a[3]; rs[4] = b[0]; rs[5] = b[1]; rs[6] = b[2]; rs[7] = b[3];
    } else {
        load_rstd8(SS, row0, fr, fq, rs);
        *(LAS f32x4*)slot = (f32x4){rs[0], rs[1], rs[2], rs[3]}; *(LAS f32x4*)(slot + 4) = (f32x4){rs[4], rs[5], rs[6], rs[7]};
        if (fq * 16 + fr == 0) *tag = pm;
    }
}

struct EpiZ {
    static constexpr bool PERM = true;
    bf16_t* Z; const float* SS; const float* COS; const float* SIN; LAS unsigned char* lds;
    __device__ __forceinline__ void operator()(const f32x4 (&acc)[2][2][4][2], const Unit& u, int wr, int wc, int fr, int fq) const {
        { const int l_ = lane_now(); fr = l_ & 15; fq = l_ >> 4; }
        const int row0 = u.pm * 256 + wr * 64 + fr, pn = u.pn, colw = wc * 32 + 8 * fq;
        float rs[8]; cached_rstd8(lds, SS, u.pm, wr * 4 + wc, row0, fr, fq, rs);
#pragma unroll
        for (int ai = 0; ai < 2; ++ai)
#pragma unroll
            for (int m = 0; m < 4; ++m) {
                const int row = row0 + ai * 128 + m * 16;
                const float rstd = rs[ai * 4 + m];
                bf16_t* rowp = Z + (size_t)row * INW + pn * 256 + colw;
                if (pn >= 2 && pn < 6) {
                    const int i1 = 16 * wc + 4 * fq;
                    const f32x4 cs = *(const f32x4*)(COS + (size_t)row * 64 + i1), sn = *(const f32x4*)(SIN + (size_t)row * 64 + i1);
                    const float sc = rstd * (pn >= 4 ? 0.08838834764831845f : 1.0f);
#pragma unroll
                    for (int bj = 0; bj < 2; ++bj) {
                        const f32x4 x1 = acc[ai][bj][m][0] * sc, x2 = acc[ai][bj][m][1] * sc;
                        const f32x4 o1 = x1 * cs - x2 * sn, o2 = x1 * sn + x2 * cs;
                        *(u32x4*)(rowp + bj * 128) = pack8(o1, o2);
                    }
                } else {
#pragma unroll
                    for (int bj = 0; bj < 2; ++bj) {
                        f32x4 v0 = acc[ai][bj][m][0], v1 = acc[ai][bj][m][1];
                        const float nrl = rstd * -1.4426950408889634f;
                        if (pn >= 14) {
#pragma unroll
                            for (int j = 0; j < 4; ++j) { v0[j] = sigmoid_sc(v0[j], nrl); v1[j] = sigmoid_sc(v1[j], nrl); }
                        } else if (pn >= 10) {
                            { const float ir = __builtin_amdgcn_rcpf(rstd);
#pragma unroll
                            for (int j = 0; j < 4; ++j) { v0[j] = v0[j] * sigmoid_scm(v0[j], nrl, ir); v1[j] = v1[j] * sigmoid_scm(v1[j], nrl, ir); } }
                        } else { v0 = v0 * rstd; v1 = v1 * rstd; }
                        *(u32x4*)(rowp + bj * 128) = pack8(v0, v1);
                    }
                }
            }
    }
};
struct EpiSwiGLU {
    static constexpr bool PERM = true;
    bf16_t* ACT; const float* SS; LAS unsigned char* lds;
    __device__ __forceinline__ void operator()(const f32x4 (&acc)[2][2][4][2], const Unit& u, int wr, int wc, int fr, int fq) const {
        { const int l_ = lane_now(); fr = l_ & 15; fq = l_ >> 4; }
        const int row0 = u.pm * 256 + wr * 64 + fr, col = u.pn * 128 + wc * 32 + 8 * fq;
        float rs[8]; cached_rstd8(lds, SS, u.pm, wr * 4 + wc, row0, fr, fq, rs);
#pragma unroll
        for (int ai = 0; ai < 2; ++ai)
#pragma unroll
            for (int m = 0; m < 4; ++m) {
                const int row = row0 + ai * 128 + m * 16;
                const float rstd = rs[ai * 4 + m];
                f32x4 o[2];
                const float ir2 = __builtin_amdgcn_rcpf(rstd * rstd), nrl = rstd * -1.4426950408889634f;
#pragma unroll
                for (int n = 0; n < 2; ++n) { const f32x4 gt = acc[ai][0][m][n], up = acc[ai][1][m][n];
#pragma unroll
                    for (int j = 0; j < 4; ++j) o[n][j] = (gt[j] * up[j]) * sigmoid_scm(gt[j], nrl, ir2); }
                *(u32x4*)(ACT + (size_t)row * DFF + col) = pack8(o[0], o[1]);
            }
    }
};
template <int MODE> struct EpiGen {
    static constexpr bool PERM = true;
    bf16_t* O; const bf16_t* T; const bf16_t* G; const float* SS;
    __device__ __forceinline__ void operator()(const f32x4 (&acc)[2][2][4][2], const Unit& u, int wr, int wc, int fr, int fq) const {
        { const int l_ = lane_now(); fr = l_ & 15; fq = l_ >> 4; }
        const int row0 = u.pm * 256 + wr * 64 + fr, col0 = u.pn * 256 + wc * 32 + 8 * fq;
        if (MODE == 2) {
            float rs[8]; load_rstd8(SS, row0, fr, fq, rs);
#pragma unroll
            for (int rg = 0; rg < 8; ++rg) {
                const int ai = rg >> 2, m = rg & 3, row = row0 + ai * 128 + m * 16; const float rstd = rs[rg];
#pragma unroll
                for (int bj = 0; bj < 2; ++bj) {
                    f32x4 v0 = acc[ai][bj][m][0], v1 = acc[ai][bj][m][1];
#pragma unroll
                    for (int j = 0; j < 4; ++j) { v0[j] = sigmoid_sc(v0[j], rstd * -1.4426950408889634f); v1[j] = sigmoid_sc(v1[j], rstd * -1.4426950408889634f); }
                    *(u32x4*)(O + (size_t)row * DM + col0 + bj * 128) = pack8(v0, v1);
                }
            }
        } else {
            constexpr int NB = (MODE == 1) ? 2 : 1, RGP = 8 / NB;
#pragma unroll
            for (int b = 0; b < NB; ++b) {
                u32x4 gw[RGP][2], tw[RGP][2];
#pragma unroll
                for (int q = 0; q < RGP; ++q)
#pragma unroll
                    for (int bj = 0; bj < 2; ++bj) {
                        const int rg = b * RGP + q, row = row0 + (rg >> 2) * 128 + (rg & 3) * 16, col = col0 + bj * 128;
                        gw[q][bj] = *(const u32x4*)(G + (size_t)row * INW + col);
                        if (MODE == 1) tw[q][bj] = *(const u32x4*)(T + (size_t)row * DM + col);
                    }
#pragma unroll
                for (int q = 0; q < RGP; ++q)
#pragma unroll
                    for (int bj = 0; bj < 2; ++bj) {
                        const int rg = b * RGP + q, ai = rg >> 2, m = rg & 3, row = row0 + ai * 128 + m * 16, col = col0 + bj * 128;
                        f32x4 v0 = acc[ai][bj][m][0] * unpack_lo4(gw[q][bj]), v1 = acc[ai][bj][m][1] * unpack_hi4(gw[q][bj]);
                        if (MODE == 1) { v0 = v0 + unpack_lo4(tw[q][bj]); v1 = v1 + unpack_hi4(tw[q][bj]); }
                        *(u32x4*)(O + (size_t)row * DM + col) = pack8(v0, v1);
                    }
                asm volatile("" ::: "memory");
            }
        }
    }
};
template <bool MUL, bool SRC32> struct EpiResid {
    static constexpr bool PERM = true;
    const float* x32; const bf16_t* xb; bf16_t* XBo; float* SSo; const bf16_t* T;
    __device__ __forceinline__ void operator()(const f32x4 (&acc)[2][2][4][2], const Unit& u, int wr, int wc, int fr, int fq) const {
        { const int l_ = lane_now(); fr = l_ & 15; fq = l_ >> 4; }
        const int row0 = u.pm * 256 + wr * 64 + fr, col0 = u.pn * 256 + wc * 32 + 8 * fq;
        constexpr int NB = SRC32 ? 4 : (MUL ? 2 : 1), RG_PER = 8 / NB;
#pragma unroll
        for (int b = 0; b < NB; ++b) {
            f32x4 xr[RG_PER][2][2]; u32x4 xw[RG_PER][2], tw[RG_PER][2];
#pragma unroll
            for (int q = 0; q < RG_PER; ++q)
#pragma unroll
                for (int bj = 0; bj < 2; ++bj) {
                    const int rg = b * RG_PER + q;
                    const size_t off = (size_t)(row0 + (rg >> 2) * 128 + (rg & 3) * 16) * DM + col0 + bj * 128;
                    if (SRC32) { xr[q][bj][0] = *(const f32x4*)(x32 + off); xr[q][bj][1] = *(const f32x4*)(x32 + off + 4); } else xw[q][bj] = *(const u32x4*)(xb + off);
                    if (MUL) tw[q][bj] = *(const u32x4*)(T + off);
                }
#pragma unroll
            for (int q = 0; q < RG_PER; ++q) {
                const int rg = b * RG_PER + q, ai = rg >> 2, m = rg & 3, row = row0 + ai * 128 + m * 16;
                float ss = 0.f;
#pragma unroll
                for (int bj = 0; bj < 2; ++bj) {
                    const size_t off = (size_t)row * DM + col0 + bj * 128;
                    f32x4 v0 = acc[ai][bj][m][0], v1 = acc[ai][bj][m][1];
                    if (MUL) { v0 = v0 * unpack_lo4(tw[q][bj]); v1 = v1 * unpack_hi4(tw[q][bj]); }
                    if (SRC32) { v0 = v0 + xr[q][bj][0]; v1 = v1 + xr[q][bj][1]; } else { v0 = v0 + unpack_lo4(xw[q][bj]); v1 = v1 + unpack_hi4(xw[q][bj]); }
                    *(u32x4*)(XBo + off) = pack8(v0, v1);
                    ss += (v0[0] * v0[0] + v0[1] * v0[1]) + (v0[2] * v0[2] + v0[3] * v0[3]) + (v1[0] * v1[0] + v1[1] * v1[1]) + (v1[2] * v1[2] + v1[3] * v1[3]);
                }
                { const int ln = fq * 16 + fr; ss += shx(ss, ln, 16); ss += shx(ss, ln, 32); }
                if (fq == 0) SSo[(size_t)row * 16 + u.pn * 4 + wc] = ss;
            }
            asm volatile("" ::: "memory");
        }
    }
};

struct Params { const float* in[19]; float* out; unsigned char* ws; int ph_lo, ph_hi; };
typedef const __attribute__((address_space(4))) Params* KPtr;
struct Ctx {
    KPtr P; float* out; unsigned char* ws; int wv, bid, G;
    __device__ __forceinline__ int ftid() const { return wv * 64 + lane_now(); }
    __device__ __forceinline__ bf16_t* W(int layer, size_t off) const { return (bf16_t*)(ws + WS_W + (size_t)layer * W_LAYER + off); }
    __device__ __forceinline__ float* COS() const { return (float*)(ws + WS_COS); }
    __device__ __forceinline__ float* SIN() const { return (float*)(ws + WS_SIN); }
    __device__ __forceinline__ bf16_t* XB(int i) const { return (bf16_t*)(ws + WS_XB + (size_t)i * SEQ * DM * 2); }
    __device__ __forceinline__ float* SS(int i) const { return (float*)(ws + WS_SS + (size_t)i * SEQ * 16 * 4); }
    __device__ __forceinline__ bf16_t* Z() const { return (bf16_t*)(ws + WS_Z); }
    __device__ __forceinline__ bf16_t* KV() const { return (bf16_t*)(ws + WS_KV); }
    __device__ __forceinline__ bf16_t* TMP() const { return (bf16_t*)(ws + WS_KV); }
    __device__ __forceinline__ bf16_t* MG() const { return (bf16_t*)(ws + WS_KV + (size_t)SEQ * DM * 2); }
    __device__ __forceinline__ bf16_t* PA() const { return (bf16_t*)(ws + WS_PA); }
    __device__ __forceinline__ bf16_t* RG() const { return (bf16_t*)(ws + WS_RG); }
    __device__ __forceinline__ bf16_t* PB(int layer) const { return (bf16_t*)(ws + WS_PB + (size_t)layer * SEQ * PLE * 2); }
    __device__ __forceinline__ const float* xin(int s) const { return s == 0 ? P->in[0] : P->in[1] + (size_t)(s - 1) * SEQ * DM; }
    __device__ __forceinline__ const float* pin(int s, int layer) const { return s == 0 ? P->in[2] + (size_t)layer * SEQ * PLE : P->in[3] + (size_t)(layer * 2 + (s - 1)) * SEQ * PLE; }
    __device__ __forceinline__ float* xout(int s) const { return out + (size_t)s * SEQ * DM; }
};

__device__ __forceinline__ int dperm(int c) { return ((c >> 2) & 1) * 64 + 16 * (c >> 5) + 4 * ((c >> 3) & 3) + (c & 3); }
struct MatDesc { const float* W; int ldw, K, N; bf16_t* out; const float* gk; const float* gn; int cm; };
__device__ __forceinline__ MatDesc mat_desc(const Ctx& C, int l, int j) {
    switch (j) {
    case 0: return MatDesc{C.P->in[5] + (size_t)l * DM * INW, INW, DM, INW, C.W(l, W_IN), C.P->in[4] + l * DM, nullptr, 1};
    case 1: return MatDesc{C.P->in[9] + (size_t)l * 512 * DM, DM, 512, DM, C.W(l, W_PO), nullptr, nullptr, 0};
    case 2: return MatDesc{C.P->in[10] + (size_t)l * DM * DM, DM, DM, DM, C.W(l, W_RO), nullptr, nullptr, 0};
    case 3: return MatDesc{C.P->in[11] + (size_t)l * DM * DM, DM, DM, DM, C.W(l, W_O), nullptr, nullptr, 0};
    case 4: return MatDesc{C.P->in[13] + (size_t)l * DM * INW, INW, DM, INW, C.W(l, W_FFI), C.P->in[12] + l * DM, nullptr, 2};
    case 5: return MatDesc{C.P->in[14] + (size_t)l * DFF * DM, DM, DFF, DM, C.W(l, W_FFO), nullptr, nullptr, 0};
    case 6: return MatDesc{C.P->in[16] + (size_t)l * DM * DM, DM, DM, DM, C.W(l, W_PG), C.P->in[15] + l * DM, nullptr, 0};
    case 7: return MatDesc{C.P->in[17] + (size_t)l * PLE * DM, DM, PLE, DM, C.W(l, W_PP), nullptr, nullptr, 0};
    default: { const int g = j - 8; return MatDesc{C.P->in[6] + (size_t)(l * 4 + g) * 128 * 128, 128, 128, 128, C.W(l, W_PW) + g * 128 * 128, nullptr, C.P->in[7] + l * 512 + g * 128, 0}; }
    }
}
__device__ __forceinline__ int mat_items(int j) { return (j == 0 || j == 4) ? (DM / 32) * INW : (j == 1) ? (512 / 32) * DM : (j == 5) ? (DFF / 32) * DM : (j == 7) ? (PLE / 32) * DM : (j >= 8) ? (128 / 32) * 128 : (DM / 32) * DM; }
__device__ void conv_range(const Ctx& C, int l, int jlo, int jhi, int w, int nw) {
    int total = 0;
    for (int j = jlo; j < jhi; ++j) total += mat_items(j);
    for (int it0 = w; it0 < total; it0 += nw) {
        int it = it0, j = jlo;
        for (; j < jhi - 1; ++j) { const int cnt = mat_items(j); if (it < cnt) break; it -= cnt; }
        const MatDesc md = mat_desc(C, l, j);
        const int N = md.N, K = md.K, kb = it / N, n = it - kb * N, k0 = kb * 32;
        int src = n;
        if (md.cm == 1) { if (n >= 512 && n < 1536) { const int sec = (n - 512) >> 7, c = (n - 512) & 127; src = 512 + sec * 128 + dperm(c); } }
        if (md.cm == 2) { const int pn = n >> 8, r = n & 255; src = (r < 128) ? (128 * pn + r) : (DFF + 128 * pn + (r - 128)); }
        const float sn = md.gn ? md.gn[n] : 1.0f;
        const float* wp = md.W + (size_t)k0 * md.ldw + src;
        float v[32];
#pragma unroll
        for (int i = 0; i < 32; ++i) v[i] = wp[(size_t)i * md.ldw];
        if (md.gk) {
#pragma unroll
            for (int i = 0; i < 32; i += 4) { const f32x4 g4 = *(const f32x4*)(md.gk + k0 + i); v[i] *= g4[0]; v[i + 1] *= g4[1]; v[i + 2] *= g4[2]; v[i + 3] *= g4[3]; }
        }
        u32x4* op = (u32x4*)(md.out + (size_t)n * K + k0);
#pragma unroll
        for (int i = 0; i < 4; ++i) { u32x4 wv; wv.x = cvt_pk_bf16(v[8 * i] * sn, v[8 * i + 1] * sn); wv.y = cvt_pk_bf16(v[8 * i + 2] * sn, v[8 * i + 3] * sn);
            wv.z = cvt_pk_bf16(v[8 * i + 4] * sn, v[8 * i + 5] * sn); wv.w = cvt_pk_bf16(v[8 * i + 6] * sn, v[8 * i + 7] * sn); op[i] = wv; }
    }
}
__device__ void phase_p0(const Ctx& C, LAS unsigned char* lds) {
    (void)lds;
    {
        const int w = C.bid * 512 + C.ftid(), nw = C.G * 512;
        conv_range(C, 0, 0, 4, w, nw); conv_range(C, 0, 8, 12, w, nw); conv_range(C, 1, 8, 12, w, nw);
        if (C.G != 256) { conv_range(C, 0, 4, 8, w, nw); conv_range(C, 1, 0, 8, w, nw); }
    }
    float* COS = C.COS(); float* SIN = C.SIN();
    for (int e = C.bid * 512 + C.ftid(); e < SEQ * 64; e += C.G * 512) {
        const int pos = e >> 6, i = e & 63;
        double inv = 1.0; for (int k = 0; k < i; ++k) inv *= 0.8659643233600653;
        const double x = (double)pos * inv;
        const double n = rint(x * 0.15915494309189535);
        const double r = fma(-n, 2.4492935982947064e-16, fma(-n, 6.283185307179586, x));
        const double r2 = r * r;
        double s = 1.0, c = 1.0;
#pragma unroll
        for (int k = 17; k >= 1; --k) { s = 1.0 - s * r2 * (1.0 / (double)((2 * k) * (2 * k + 1))); c = 1.0 - c * r2 * (1.0 / (double)((2 * k - 1) * (2 * k))); }
        COS[e] = (float)c; SIN[e] = (float)(s * r);
    }
}
__device__ void phase_rows(const Ctx& C, int s_fin, int s_pre) {
    const int tid0 = C.ftid(), wid = tid0 >> 6, lane = tid0 & 63;
    float* SS0 = C.SS(0); bf16_t* XB0 = C.XB(0);
    for (int row = C.bid * 8 + wid; row < SEQ; row += C.G * 8) {
        if (s_fin >= 0) {
            float* x = C.xout(s_fin) + (size_t)row * DM; const float* gf = C.P->in[18];
            const float rstd = rstd_from_ss(SS0 + (size_t)row * 16);
#pragma unroll
            for (int i = 0; i < 4; ++i) { const int col = lane * 4 + 256 * i; const f32x4 v = unpack4(*(const u32x2*)(XB0 + (size_t)row * DM + col)), g = *(const f32x4*)(gf + col); *(f32x4*)(x + col) = v * rstd * g; }
        }
        if (s_pre >= 0) {
            const float* x = C.xin(s_pre) + (size_t)row * DM; float ss = 0.f;
#pragma unroll
            for (int i = 0; i < 4; ++i) { const int col = lane * 4 + 256 * i; const f32x4 v = *(const f32x4*)(x + col);
                ss += (v[0] * v[0] + v[1] * v[1]) + (v[2] * v[2] + v[3] * v[3]); *(u32x2*)(XB0 + (size_t)row * DM + col) = pack4(v); }
#pragma unroll
            for (int o = 32; o >= 1; o >>= 1) ss += shx(ss, lane, o);
            if (lane < 16) SS0[(size_t)row * 16 + lane] = (lane == 0) ? ss : 0.f;
#pragma unroll
            for (int l = 0; l < 2; ++l) { const f32x4 v = *(const f32x4*)(C.pin(s_pre, l) + (size_t)row * PLE + lane * 4); *(u32x2*)(C.PB(l) + (size_t)row * PLE + lane * 4) = pack4(v); }
        }
    }
}

__device__ __forceinline__ bf16x8 tr_frag(const LAS bf16_t* T, int pitch, int r0, int c0, int fr, int fq) {
#if SLOW_TR
    bf16x8 f;
#pragma unroll
    for (int j = 0; j < 8; ++j) f[j] = (short)T[(r0 + 8 * fq + j) * pitch + c0 + fr];
    return f;
#endif
    const int q = fr >> 2, p = fr & 3;
    const LAS bf16_t* a = T + (r0 + 8 * fq + q) * pitch + c0 + 4 * p;
    const s16x4 lo = __builtin_amdgcn_ds_read_tr16_b64_v4i16((LAS s16x4*)a);
    const s16x4 hi = __builtin_amdgcn_ds_read_tr16_b64_v4i16((LAS s16x4*)(a + 4 * pitch));
    return __builtin_shufflevector(lo, hi, 0, 1, 2, 3, 4, 5, 6, 7);
}
__device__ __forceinline__ bf16x8 tr_frag_cs(const LAS bf16_t* T, int pitch, int r0, int c0, int fr, int fq) {
    const int q = fr >> 2, p = fr & 3;
    const LAS bf16_t* a = T + (r0 + 8 * fq + q) * pitch + c0 + 8 * p;
    const s16x4 lo = __builtin_amdgcn_ds_read_tr16_b64_v4i16((LAS s16x4*)a);
    const s16x4 hi = __builtin_amdgcn_ds_read_tr16_b64_v4i16((LAS s16x4*)(a + 4 * pitch));
    return __builtin_shufflevector(lo, hi, 0, 1, 2, 3, 4, 5, 6, 7);
}
#define MFMA16(a, b, c) __builtin_amdgcn_mfma_f32_16x16x32_bf16((a), (b), (c), 0, 0, 0)

template <int W2> __device__ __forceinline__ void pool_window(const bf16_t* col, int tpos, f32x4& s0, f32x4& s1) {
    u32x4 d[2 * W2];
#pragma unroll
    for (int k = 0; k < 2 * W2; ++k) { const int sp = tpos - W2 + k; const int sc = ((unsigned)sp < (unsigned)SEQ) ? sp : tpos; d[k] = *(const u32x4*)(col + (size_t)sc * INW); }
#pragma unroll
    for (int k = 0; k < 2 * W2; ++k) { const int sp = tpos - W2 + k; const float m = ((unsigned)sp < (unsigned)SEQ) ? 1.0f : 0.0f; s0 = s0 + unpack_lo4(d[k]) * m; s1 = s1 + unpack_hi4(d[k]) * m; }
}
__device__ void phase_a(const Ctx& C, LAS unsigned char* lds, int layer) {
    const int tid = C.ftid(), wid = __builtin_amdgcn_readfirstlane(tid >> 6), lane = tid & 63, fr = lane & 15, fq = lane >> 4;
    LAS bf16_t* Vs = (LAS bf16_t*)lds;
    LAS bf16_t* Kf = Vs + 128 * 264;
    LAS bf16_t* Kb = Kf + 128 * 136;
    const bf16_t* Z = C.Z();
    for (int t = C.bid; t < 1024; t += C.G) {
        __syncthreads();
        if (t < 512) {
            const int c = t >> 2, h = t & 3;
            const float lgf = log2g(C.P->in[8] + layer * 8 + h), lgb = log2g(C.P->in[8] + layer * 8 + 4 + h);
            const bf16_t* zrow = Z + (size_t)(c * 128) * INW;
#pragma unroll
            for (int i = 0; i < 8; ++i) { const int idx = tid + i * 512, r = idx >> 5, v = idx & 31;
                *(LAS u32x4*)(Vs + r * 264 + v * 8) = *(const u32x4*)(zrow + (size_t)r * INW + 1536 + h * 256 + v * 8); }
#pragma unroll
            for (int i = 0; i < 4; ++i) { const int idx = tid + i * 512, r = idx >> 4, v = idx & 15;
                const u32x4 d = *(const u32x4*)(zrow + (size_t)r * INW + 1024 + h * 128 + v * 8);
                const float wf = exp2f(lgf * (float)(127 - r)), wb = exp2f(lgb * (float)r);
                const f32x4 a = unpack_lo4(d), b = unpack_hi4(d);
                *(LAS u32x4*)(Kf + r * 136 + v * 8) = pack8(a * wf, b * wf);
                *(LAS u32x4*)(Kb + r * 136 + v * 8) = pack8(a * wb, b * wb); }
            __syncthreads();
            const int eq = wid & 3, dh = wid >> 2;
            f32x4 acc[2][4][4];
#pragma unroll
            for (int a = 0; a < 2; ++a)
#pragma unroll
                for (int b = 0; b < 4; ++b)
#pragma unroll
                    for (int e4 = 0; e4 < 4; ++e4) acc[a][b][e4] = (f32x4){0.f, 0.f, 0.f, 0.f};
#pragma unroll 1
            for (int kk = 0; kk < 4; ++kk) {
                int fr = lane & 15, fq = lane >> 4; asm volatile("" : "+v"(fr), "+v"(fq));
                bf16x8 vf[4];
#pragma unroll
                for (int et = 0; et < 4; ++et) vf[et] = tr_frag(Vs, 264, 32 * kk, 64 * eq + 16 * et, fr, fq);
#pragma unroll
                for (int dir = 0; dir < 2; ++dir)
#pragma unroll
                    for (int dt = 0; dt < 4; ++dt) {
                        const bf16x8 kf = tr_frag_cs(dir ? Kb : Kf, 136, 32 * kk, 64 * dh + 32 * (dt >> 1) + 4 * (dt & 1), fr, fq);
#pragma unroll
                        for (int et = 0; et < 4; ++et) acc[dir][dt][et] = MFMA16(kf, vf[et], acc[dir][dt][et]);
                    }
            }
            bf16_t* KV = C.KV();
#pragma unroll
            for (int dir = 0; dir < 2; ++dir)
#pragma unroll
                for (int j = 0; j < 2; ++j)
#pragma unroll
                    for (int et = 0; et < 4; ++et) {
                        const int e = 64 * eq + 16 * et + fr, d = 64 * dh + 32 * j + 8 * fq;
                        *(u32x4*)(KV + ((size_t)(((c * 4 + h) * 2 + dir) * 256 + e)) * 128 + d) = pack8(acc[dir][2 * j][et], acc[dir][2 * j + 1][et]);
                    }
        } else {
            const int pt = t - 512, tb = pt >> 2, g = (pt >= 256) ? 3 - (pt & 3) : (pt & 3), w2 = 1 << g;
            LAS bf16_t* Ds = (LAS bf16_t*)lds;
#pragma unroll 1
            for (int i = 0; i < 4; ++i) {
                const int idx = tid + i * 512, r = idx >> 4, v = idx & 15, tpos = tb * 128 + r;
                const int lo = max(tpos - w2, 0), hi = min(tpos + w2, SEQ);
                const bf16_t* col = Z + g * 128 + v * 8;
                f32x4 s0 = (f32x4){0.f, 0.f, 0.f, 0.f}, s1 = s0;
                if (g == 3) pool_window<8>(col, tpos, s0, s1); else if (g == 2) pool_window<4>(col, tpos, s0, s1); else if (g == 1) pool_window<2>(col, tpos, s0, s1); else pool_window<1>(col, tpos, s0, s1);
                const float inv = 1.0f / (float)(hi - lo);
                const u32x4 d = *(const u32x4*)(col + (size_t)tpos * INW);
                *(LAS u32x4*)(Ds + r * 136 + v * 8) = pack8(s0 * inv - unpack_lo4(d), s1 * inv - unpack_hi4(d));
            }
            __syncthreads();
            const bf16_t* PW = C.W(layer, W_PW) + g * 128 * 128;
            f32x4 acc[8];
#pragma unroll
            for (int dt = 0; dt < 8; ++dt) acc[dt] = (f32x4){0.f, 0.f, 0.f, 0.f};
#pragma unroll 1
            for (int kk = 0; kk < 4; ++kk) {
                const bf16x8 df = *(const LAS bf16x8*)(Ds + (16 * wid + fr) * 136 + 32 * kk + 8 * fq);
#pragma unroll
                for (int dt = 0; dt < 8; ++dt) { const bf16x8 wf = *(const bf16x8*)(PW + (16 * dt + fr) * 128 + 32 * kk + 8 * fq); acc[dt] = MFMA16(wf, df, acc[dt]); }
            }
            bf16_t* PA = C.PA();
            const int row = tb * 128 + 16 * wid + fr;
#pragma unroll
            for (int dt = 0; dt < 8; ++dt) *(u32x2*)(PA + (size_t)row * 512 + g * 128 + 16 * dt + 4 * fq) = pack4(acc[dt]);
        }
    }
}
__device__ void phase_b(const Ctx& C, int layer) {
    u32x4* KV = (u32x4*)C.KV();
    const int tid = C.ftid();
    if (tid >= 128) return;
    for (int it = C.bid * 128 + tid; it < 32768; it += C.G * 128) {
        const int idx = it * 8, h = idx >> 16, dir = (idx >> 15) & 1;
        const float cd = exp2f(log2g(C.P->in[8] + layer * 8 + dir * 4 + h) * 128.0f);
        u32x4* base = KV + it;
        f32x4 ra = (f32x4){0.f, 0.f, 0.f, 0.f}, rb = ra;
        const int c0 = dir ? 127 : 0, st = dir ? -1 : 1;
        for (int cc = 0; cc < 128; cc += 8) { u32x4 v[8];
#pragma unroll
            for (int i = 0; i < 8; ++i) v[i] = base[(size_t)(c0 + st * (cc + i)) * 32768];
#pragma unroll
            for (int i = 0; i < 8; ++i) { base[(size_t)(c0 + st * (cc + i)) * 32768] = pack8(ra, rb); ra = ra * cd + unpack_lo4(v[i]); rb = rb * cd + unpack_hi4(v[i]); } }
    }
}
__device__ void phase_c(const Ctx& C, LAS unsigned char* lds, int layer) {
    const int tid0 = C.ftid(), wid = __builtin_amdgcn_readfirstlane(tid0 >> 6), lane = tid0 & 63;
    LAS bf16_t* Qs = (LAS bf16_t*)lds;
    LAS bf16_t* Ps = Qs + 128 * 136;
    LAS bf16_t* Vs = Ps + 128 * 136;
    LAS float* St = (LAS float*)(Vs + 128 * 264);
    const bf16_t* Z = C.Z(); const bf16_t* KV = C.KV(); bf16_t* RG = C.RG();
    for (int t = C.bid; t < 512; t += C.G) {
        const int c = t >> 2, h = t & 3;
        const float lgf = log2g(C.P->in[8] + layer * 8 + h), lgb = log2g(C.P->in[8] + layer * 8 + 4 + h);
        const bf16_t* zrow = Z + (size_t)(c * 128) * INW;
        const int e0 = 32 * wid;
        int fr = lane & 15, fq = lane >> 4;
        asm volatile("" : "+v"(fr), "+v"(fq));
        bf16x8 sf[2][2][4];
#pragma unroll
        for (int dir = 0; dir < 2; ++dir) {
            const bf16_t* sb = KV + (size_t)(((c * 4 + h) * 2 + dir) * 256) * 128;
#pragma unroll
            for (int et = 0; et < 2; ++et)
#pragma unroll
                for (int kk = 0; kk < 4; ++kk) sf[dir][et][kk] = *(const bf16x8*)(sb + (size_t)(e0 + 16 * et + fr) * 128 + 32 * kk + 8 * fq);
        }
        __syncthreads();
        { const int tid = C.ftid();
#pragma unroll
        for (int i = 0; i < 8; ++i) { const int idx = tid + i * 512, r = idx >> 5, v = idx & 31;
            *(LAS u32x4*)(Vs + r * 264 + v * 8) = *(const u32x4*)(zrow + (size_t)r * INW + 1536 + h * 256 + v * 8); }
#pragma unroll
        for (int i = 0; i < 4; ++i) { const int idx = tid + i * 512, r = idx >> 4, v = idx & 15;
            *(LAS u32x4*)(Qs + r * 136 + v * 8) = *(const u32x4*)(zrow + (size_t)r * INW + 512 + h * 128 + v * 8);
            *(LAS u32x4*)(Ps + r * 136 + v * 8) = *(const u32x4*)(zrow + (size_t)r * INW + 1024 + h * 128 + v * 8); }
        }
        __syncthreads();
        asm volatile("" : "+v"(fr), "+v"(fq));
        f32x4 sc[8];
        {
            const int i0 = 16 * wid;
            bf16x8 qf[4];
#pragma unroll
            for (int kk = 0; kk < 4; ++kk) qf[kk] = *(const LAS bf16x8*)(Qs + (i0 + fr) * 136 + 32 * kk + 8 * fq);
#pragma unroll
            for (int jt = 0; jt < 8; ++jt) {
                f32x4 a = (f32x4){0.f, 0.f, 0.f, 0.f};
#pragma unroll
                for (int kk = 0; kk < 4; ++kk) { const bf16x8 kf = *(const LAS bf16x8*)(Ps + (16 * jt + fr) * 136 + 32 * kk + 8 * fq); a = MFMA16(kf, qf[kk], a); }
                const int i = i0 + fr;
#pragma unroll
                for (int r = 0; r < 4; ++r) { const int j = 16 * jt + 4 * fq + r, dl = i - j; a[r] *= (dl >= 0) ? exp2f(lgf * (float)dl) : exp2f(lgb * (float)(-dl)); }
                sc[jt] = a;
            }
        }
        __syncthreads();
        {
            const int i = 16 * wid + fr;
#pragma unroll
            for (int jt = 0; jt < 8; ++jt) *(LAS u32x2*)(Ps + i * 136 + 16 * jt + 4 * fq) = pack4(sc[jt]);
        }
        __syncthreads();
        asm volatile("" : "+v"(fr), "+v"(fq));
        f32x4 y[8][2];
#pragma unroll
        for (int m = 0; m < 8; ++m) { y[m][0] = (f32x4){0.f, 0.f, 0.f, 0.f}; y[m][1] = (f32x4){0.f, 0.f, 0.f, 0.f}; }
#pragma unroll 1
        for (int kk = 0; kk < 4; ++kk) {
            bf16x8 vf[2];
#pragma unroll
            for (int et = 0; et < 2; ++et) vf[et] = tr_frag(Vs, 264, 32 * kk, e0 + 16 * et, fr, fq);
#pragma unroll
            for (int m = 0; m < 8; ++m) { const bf16x8 pf = *(const LAS bf16x8*)(Ps + (16 * m + fr) * 136 + 32 * kk + 8 * fq);
                y[m][0] = MFMA16(vf[0], pf, y[m][0]); y[m][1] = MFMA16(vf[1], pf, y[m][1]); }
        }
#pragma unroll
        for (int dir = 0; dir < 2; ++dir) {
            asm volatile("" : "+v"(fr), "+v"(fq));
#pragma unroll
            for (int m = 0; m < 8; ++m) {
                f32x4 t0 = (f32x4){0.f, 0.f, 0.f, 0.f}, t1 = t0;
#pragma unroll
                for (int kk = 0; kk < 4; ++kk) { const bf16x8 qq = *(const LAS bf16x8*)(Qs + (16 * m + fr) * 136 + 32 * kk + 8 * fq); t0 = MFMA16(sf[dir][0][kk], qq, t0); t1 = MFMA16(sf[dir][1][kk], qq, t1); }
                const int i = 16 * m + fr;
                const float scl = (dir == 0) ? exp2f(lgf * (float)(i + 1)) : exp2f(lgb * (float)(128 - i));
                y[m][0] = y[m][0] + t0 * scl; y[m][1] = y[m][1] + t1 * scl;
                if (m & 1) asm volatile("" ::: "memory");
            }
        }
        asm volatile("" : "+v"(fr), "+v"(fq));
        u32x2 gsw[8][2];
#pragma unroll
        for (int m = 0; m < 8; ++m)
#pragma unroll
            for (int et = 0; et < 2; ++et) gsw[m][et] = *(const u32x2*)(zrow + (size_t)(16 * m + fr) * INW + 2560 + h * 256 + e0 + 16 * et + 4 * fq);
#pragma unroll
        for (int m = 0; m < 8; ++m) {
            const f32x4 a = y[m][0], b = y[m][1];
            float s = (a[0] + a[1]) + (a[2] + a[3]) + (b[0] + b[1]) + (b[2] + b[3]);
            float q = (a[0] * a[0] + a[1] * a[1]) + (a[2] * a[2] + a[3] * a[3]) + (b[0] * b[0] + b[1] * b[1]) + (b[2] * b[2] + b[3] * b[3]);
            { const int ln = fq * 16 + fr; s += shx(s, ln, 16); s += shx(s, ln, 32); q += shx(q, ln, 16); q += shx(q, ln, 32); }
            if (fq == 0) { St[(16 * m + fr) * 16 + wid * 2] = s; St[(16 * m + fr) * 16 + wid * 2 + 1] = q; }
        }
        __syncthreads();
#pragma unroll
        for (int m = 0; m < 8; ++m) {
            const int i = 16 * m + fr;
            const LAS f32x4* sp = (const LAS f32x4*)(St + i * 16);
            const f32x4 p0 = sp[0], p1 = sp[1], p2 = sp[2], p3 = sp[3];
            const float s = (p0[0] + p0[2]) + (p1[0] + p1[2]) + (p2[0] + p2[2]) + (p3[0] + p3[2]);
            const float q = (p0[1] + p0[3]) + (p1[1] + p1[3]) + (p2[1] + p2[3]) + (p3[1] + p3[3]);
            const float mean = s * (1.0f / 256.0f), var = fmaxf(q * (1.0f / 256.0f) - mean * mean, 0.f);
            const float rstd = __builtin_amdgcn_rsqf(var + 1e-5f);
            const size_t row = (size_t)(c * 128 + i);
#pragma unroll
            for (int et = 0; et < 2; ++et) {
                const int e = e0 + 16 * et + 4 * fq;
                *(u32x2*)(RG + row * DM + h * 256 + e) = pack4((y[m][et] - mean) * rstd * unpack4(gsw[m][et]));
            }
        }
    }
}

__device__ __forceinline__ void run_phase(const Ctx& C, LAS unsigned char* lds, int ph) {
    if (ph == 0) { phase_p0(C, lds); phase_rows(C, -1, 0); return; }
    const int q = ph - 1, s = q / 19, r = q % 19;
    if (r == 18) { phase_rows(C, s, s < 2 ? s + 1 : -1); return; }
    const int layer = r / 9, st = r % 9, cur = layer, G = C.G, bid = C.bid;
    pg8::StaticOrder S;
    switch (st) {
    case 0: { pg8::Gemm g{C.XB(cur), C.W(layer, W_IN), SEQ, INW, DM}; S.init(SEQ, INW, G, bid, 2);
              { const int t_ = C.ftid(); if ((t_ & 63) == 0) ((LAS int*)(lds + LDS_RSTAG))[t_ >> 6] = -1; }
              EpiZ E{C.Z(), C.SS(cur), C.COS(), C.SIN(), lds}; pg8::gemm_phase(C.ftid(), lds, g, S, E);
              if (s == 0 && G == 256 && bid >= 128) conv_range(C, layer, 4, 8, (bid - 128) * 512 + C.ftid(), 128 * 512); } break;
    case 1: phase_a(C, lds, layer); break;
    case 2: phase_b(C, layer); break;
    case 3: phase_c(C, lds, layer); break;
    case 4: { S.init(SEQ, DM, G, bid);
              { pg8::Gemm g{C.PA(), C.W(layer, W_PO), SEQ, DM, 512}; EpiGen<0> E{C.TMP(), nullptr, C.Z() + 3584, nullptr}; pg8::gemm_phase(C.ftid(), lds, g, S, E); }
              { pg8::Gemm g{C.RG(), C.W(layer, W_RO), SEQ, DM, DM}; EpiGen<1> E{C.MG(), C.TMP(), C.Z() + 3584 + 1024, nullptr}; pg8::gemm_phase(C.ftid(), lds, g, S, E); } } break;
    case 5: { pg8::Gemm g{C.MG(), C.W(layer, W_O), SEQ, DM, DM}; S.init(SEQ, DM, G, bid);
              if (layer == 0) { EpiResid<false, true> E{C.xin(s), nullptr, C.XB(cur ^ 1), C.SS(cur ^ 1), nullptr}; pg8::gemm_phase(C.ftid(), lds, g, S, E); }
              else { EpiResid<false, false> E{nullptr, C.XB(cur), C.XB(cur ^ 1), C.SS(cur ^ 1), nullptr}; pg8::gemm_phase(C.ftid(), lds, g, S, E); } } break;
    case 6: { pg8::Gemm g{C.XB(cur ^ 1), C.W(layer, W_FFI), SEQ, INW, DM}; S.init(SEQ, INW, G, bid);
              { const int t_ = C.ftid(); if ((t_ & 63) == 0) ((LAS int*)(lds + LDS_RSTAG))[t_ >> 6] = -1; }
              EpiSwiGLU E{C.Z(), C.SS(cur ^ 1), lds}; pg8::gemm_phase(C.ftid(), lds, g, S, E);
              if (s == 0 && layer == 0 && G == 256 && bid >= 128) conv_range(C, 1, 0, 4, (bid - 128) * 512 + C.ftid(), 128 * 512); } break;
    case 7: { pg8::Gemm g{C.Z(), C.W(layer, W_FFO), SEQ, DM, DFF}; S.init(SEQ, DM, G, bid);
              EpiResid<false, false> E{nullptr, C.XB(cur ^ 1), C.XB(cur), C.SS(cur), nullptr}; pg8::gemm_phase(C.ftid(), lds, g, S, E); } break;
    default: { S.init(SEQ, DM, G, bid);
              { pg8::Gemm g{C.XB(cur), C.W(layer, W_PG), SEQ, DM, DM}; EpiGen<2> E{C.TMP(), nullptr, nullptr, C.SS(cur)}; pg8::gemm_phase(C.ftid(), lds, g, S, E); }
              { pg8::Gemm g{C.PB(layer), C.W(layer, W_PP), SEQ, DM, PLE}; EpiResid<true, false> E{nullptr, C.XB(cur), C.XB(cur ^ 1), C.SS(cur ^ 1), C.TMP()}; pg8::gemm_phase(C.ftid(), lds, g, S, E); } } break;
    }
}


#define XB_TMO      128
#define XB_XCNT(j)  (256  + 64 * (j))
#define XB_XSUB(j)  (1280 + 64 * (j))
#define XB_XGEN(j)  (2304 + 64 * (j))
#define XB_TOP      3328
#define XB_TOPGEN   3392
#define XCD_BAR_WORDS 3456
#define XB_SPIN_CAP (1u << 18)
__device__ __forceinline__ unsigned xb_ld(unsigned* p)              { return __hip_atomic_load(p, __ATOMIC_RELAXED, __HIP_MEMORY_SCOPE_AGENT); }
__device__ __forceinline__ unsigned xb_add(unsigned* p, unsigned v) { return __hip_atomic_fetch_add(p, v, __ATOMIC_RELAXED, __HIP_MEMORY_SCOPE_AGENT); }
__device__ __forceinline__ unsigned xb_xcc_id() { return (unsigned)__builtin_amdgcn_s_getreg((3 << 11) | 20) & 0xFu; }
#define XB_SPIN(cond, bar) do { unsigned _sp = 0; while (cond) { __builtin_amdgcn_s_sleep(1); \
    if ((++_sp & 255u) == 0u) { if (xb_ld(&(bar)[XB_TMO])) break; if (_sp > XB_SPIN_CAP) { atomicAdd(&(bar)[XB_TMO], 1u); break; } } } } while (0)
struct XcdBarrier { unsigned* bar; unsigned x; volatile LAS unsigned* st; };
__device__ __forceinline__ XcdBarrier xcd_barrier_post(unsigned* bar, volatile LAS unsigned* st, bool leader) {
    XcdBarrier b; b.bar = bar; b.x = xb_xcc_id(); b.st = st;
    if (leader) (void)xb_add(&bar[XB_XCNT(b.x)], 1u);
    return b;
}
__device__ __forceinline__ void xcd_barrier_complete(unsigned* bar, unsigned x, unsigned& nloc, unsigned& nx) {
    const unsigned G = gridDim.x * gridDim.y * gridDim.z;
    unsigned sum, cnt, mine, sp = 0u;
    for (;;) {
        sum = 0u; cnt = 0u; mine = 0u;
#pragma unroll
        for (unsigned j = 0; j < 16; ++j) { const unsigned c = xb_ld(&bar[XB_XCNT(j)]); sum += c; cnt += (c > 0u) ? 1u : 0u; mine = (j == x) ? c : mine; }
        if (sum == G) break;
        __builtin_amdgcn_s_sleep(1);
        if ((++sp & 255u) == 0u) { if (xb_ld(&bar[XB_TMO])) break; if (sp > XB_SPIN_CAP) { atomicAdd(&bar[XB_TMO], 1u); break; } }
    }
    nloc = mine > 0u ? mine : 1u; nx = cnt > 0u ? cnt : 1u;
}
__device__ __forceinline__ void xcd_barrier(const XcdBarrier& b, int wv) {
    asm volatile("s_waitcnt vmcnt(0)" ::: "memory");
    __syncthreads();
    if (wv == 0 && lane_now() == 0) {
        unsigned* bar = b.bar;
        __builtin_amdgcn_s_waitcnt(0);
        unsigned nloc = b.st[0], nx = b.st[1];
        if (nloc == 0u) { xcd_barrier_complete(bar, b.x, nloc, nx); b.st[0] = nloc; b.st[1] = nx; }
        const unsigned old = xb_add(&bar[XB_XSUB(b.x)], 1u);
        const unsigned gen = old / nloc;
        if (old + 1u == (gen + 1u) * nloc) {
            __builtin_amdgcn_fence(__ATOMIC_RELEASE, "agent");
            asm volatile("s_waitcnt vmcnt(0)" ::: "memory");
            const unsigned og = xb_add(&bar[XB_TOP], 1u);
            const unsigned tg = og / nx;
            if (og + 1u == (tg + 1u) * nx) xb_add(&bar[XB_TOPGEN], 1u);
            else XB_SPIN(xb_ld(&bar[XB_TOPGEN]) == tg, bar);
            __builtin_amdgcn_fence(__ATOMIC_ACQUIRE, "agent");
            xb_add(&bar[XB_XGEN(b.x)], 1u);
            asm volatile("s_waitcnt vmcnt(0)" ::: "memory");
        } else {
            XB_SPIN(xb_ld(&bar[XB_XGEN(b.x)]) == gen, bar);
            __builtin_amdgcn_fence(__ATOMIC_ACQUIRE, "agent");
            asm volatile("s_waitcnt vmcnt(0)" ::: "memory");
        }
    }
    __syncthreads();
}

__global__ void __launch_bounds__(512, 2) mk_fwd(Params P) {
    extern __shared__ __attribute__((aligned(16))) unsigned char lds_raw[];
    LAS unsigned char* lds = (LAS unsigned char*)lds_raw;
    const int wv0 = __builtin_amdgcn_readfirstlane((int)threadIdx.x >> 6);
    const bool leader0 = (threadIdx.x == 0);
    volatile LAS unsigned* bst = (volatile LAS unsigned*)(lds + LDS_BYTES - 16);
    XcdBarrier bar; bar.bar = (unsigned*)(P.ws + WS_END); bar.x = 0; bar.st = bst;
    if (P.ph_hi - P.ph_lo > 1) {
        if (leader0) { bst[0] = 0u; bst[1] = 0u; }
        __syncthreads();
        bar = xcd_barrier_post((unsigned*)(P.ws + WS_END), bst, leader0);
    }
    for (int ph = P.ph_lo; ph < P.ph_hi; ++ph) {
        int wv = wv0, bid = blockIdx.x, G = gridDim.x;
        asm volatile("" : "+s"(wv), "+s"(bid), "+s"(G));
        KPtr pp = (KPtr)__builtin_amdgcn_kernarg_segment_ptr();
        asm volatile("" : "+s"(pp));
        Ctx C{pp, pp->out, pp->ws, wv, bid, G};
        run_phase(C, lds, ph);
#if REP_MASK
        { int cls; if (ph == 0) cls = 10; else { const int r = (ph - 1) % 19; cls = (r == 18) ? 9 : (r % 9); }
          if ((REP_MASK >> cls) & 1) { __syncthreads(); run_phase(C, lds, ph); } }
#endif
        if (ph + 1 < P.ph_hi) { if (ph == P.ph_lo) cg::this_grid().sync(); else xcd_barrier(bar, wv0); }
    }
}

extern "C" void kernel_launch(void* const* d_in, const int* in_sizes, int n_in, void* d_out, int out_size, void* d_ws, size_t ws_size, hipStream_t stream) {
    static int grid = 0;
    if (grid == 0) {
        if (n_in != 19 || ws_size < WS_END + XCD_BAR_WORDS * 4) { fprintf(stderr, "kernel_launch: unexpected n_in %d / ws %zu (need %zu)\n", n_in, ws_size, (size_t)WS_END); grid = -1; return; }
        int dev = 0, cus = 0, per_cu = 0;
        hipGetDevice(&dev); hipDeviceGetAttribute(&cus, hipDeviceAttributeMultiprocessorCount, dev);
        hipFuncSetAttribute((const void*)mk_fwd, hipFuncAttributeMaxDynamicSharedMemorySize, LDS_BYTES);
        hipOccupancyMaxActiveBlocksPerMultiprocessor(&per_cu, (const void*)mk_fwd, 512, LDS_BYTES);
        if (per_cu < 1) per_cu = 1;
        (void)hipGetLastError();
        grid = cus * per_cu;
    }
    if (grid < 0) return;
    if (hipMemsetAsync((char*)d_ws + WS_END, 0, XCD_BAR_WORDS * 4, stream) != hipSuccess) { fprintf(stderr, "kernel_launch: memset of barrier words failed\n"); return; }
    Params p{};
    for (int i = 0; i < 19; ++i) p.in[i] = (const float*)d_in[i];
    p.out = (float*)d_out; p.ws = (unsigned char*)d_ws;
#if MULTI_LAUNCH
    for (int ph = 0; ph < NPH; ++ph) { p.ph_lo = ph; p.ph_hi = ph + 1; hipLaunchKernelGGL(mk_fwd, dim3(grid), dim3(512), LDS_BYTES, stream, p); }
#else
    p.ph_lo = 0; p.ph_hi = NPH;
    void* args[] = {&p};
    hipError_t e = hipLaunchCooperativeKernel((const void*)mk_fwd, dim3(grid), dim3(512), args, LDS_BYTES, stream);
    if (e != hipSuccess) fprintf(stderr, "cooperative launch failed: %s (grid %d)\n", hipGetErrorString(e), grid);
#endif
}
```

```cpp
#include <hip/hip_runtime.h>
#include <hip/hip_cooperative_groups.h>
#include <cstdio>
namespace cg = cooperative_groups;

#ifndef SLOW_TR
#define SLOW_TR 0
#endif
#ifndef REP_MASK
#define REP_MASK 0
#endif
#ifndef MULTI_LAUNCH
#define MULTI_LAUNCH 0
#endif

#define LAS __attribute__((address_space(3)))
typedef unsigned short bf16_t;
typedef short bf16x8 __attribute__((ext_vector_type(8)));
typedef short s16x4 __attribute__((ext_vector_type(4)));
typedef float f32x4 __attribute__((ext_vector_type(4)));
typedef unsigned u32x4 __attribute__((ext_vector_type(4)));
typedef unsigned u32x2 __attribute__((ext_vector_type(2)));

constexpr int SEQ = 16384, DM = 1024, INW = 5632, DFF = 2816, PLE = 256;
constexpr int NPH = 58;
constexpr size_t W_IN = 0, W_PO = W_IN + (size_t)INW * DM * 2, W_RO = W_PO + (size_t)DM * 512 * 2, W_O = W_RO + (size_t)DM * DM * 2,
                 W_FFI = W_O + (size_t)DM * DM * 2, W_FFO = W_FFI + (size_t)INW * DM * 2, W_PG = W_FFO + (size_t)DM * DFF * 2,
                 W_PP = W_PG + (size_t)DM * DM * 2, W_PW = W_PP + (size_t)DM * PLE * 2, W_LAYER = W_PW + (size_t)4 * 128 * 128 * 2;
constexpr size_t WS_W = 0, WS_COS = WS_W + 2 * W_LAYER, WS_SIN = WS_COS + (size_t)SEQ * 64 * 4, WS_XB = WS_SIN + (size_t)SEQ * 64 * 4,
                 WS_SS = WS_XB + 2 * (size_t)SEQ * DM * 2, WS_Z = WS_SS + 2 * (size_t)SEQ * 16 * 4, WS_KV = WS_Z + (size_t)SEQ * INW * 2,
                 WS_PA = WS_KV + (size_t)128 * 4 * 2 * 256 * 128 * 2, WS_RG = WS_PA + (size_t)SEQ * 512 * 2, WS_PB = WS_RG + (size_t)SEQ * DM * 2,
                 WS_END = WS_PB + 2 * (size_t)SEQ * PLE * 2;
constexpr int LDS_BYTES = 147456 + 64;
constexpr int LDS_RS = 131072, LDS_RSTAG = 131072 + 16384;

typedef float f32x2_t __attribute__((ext_vector_type(2)));
typedef __bf16 bf16x2_t __attribute__((ext_vector_type(2)));
__device__ __forceinline__ unsigned cvt_pk_bf16(float lo, float hi) { const f32x2_t v = {lo, hi}; return __builtin_bit_cast(unsigned, __builtin_convertvector(v, bf16x2_t)); }
__device__ __forceinline__ float bf_lo(unsigned u) { return __uint_as_float(u << 16); }
__device__ __forceinline__ float bf_hi(unsigned u) { return __uint_as_float(u & 0xffff0000u); }
__device__ __forceinline__ float sigmoid_f(float x) { return __builtin_amdgcn_rcpf(1.0f + __expf(-x)); }
__device__ __forceinline__ float sigmoid_sc(float v, float nrl) { return __builtin_amdgcn_rcpf(1.0f + __builtin_amdgcn_exp2f(v * nrl)); }
__device__ __forceinline__ float sigmoid_scm(float v, float nrl, float ic) { return __builtin_amdgcn_rcpf(__builtin_fmaf(__builtin_amdgcn_exp2f(v * nrl), ic, ic)); }
__device__ __forceinline__ float silu_f(float x) { return x * sigmoid_f(x); }
__device__ __forceinline__ u32x2 pack4(f32x4 v) { u32x2 w; w.x = cvt_pk_bf16(v[0], v[1]); w.y = cvt_pk_bf16(v[2], v[3]); return w; }
__device__ __forceinline__ u32x4 pack8(f32x4 a, f32x4 b) { u32x4 w; w.x = cvt_pk_bf16(a[0], a[1]); w.y = cvt_pk_bf16(a[2], a[3]); w.z = cvt_pk_bf16(b[0], b[1]); w.w = cvt_pk_bf16(b[2], b[3]); return w; }
__device__ __forceinline__ f32x4 unpack_lo4(u32x4 w) { return (f32x4){bf_lo(w.x), bf_hi(w.x), bf_lo(w.y), bf_hi(w.y)}; }
__device__ __forceinline__ f32x4 unpack_hi4(u32x4 w) { return (f32x4){bf_lo(w.z), bf_hi(w.z), bf_lo(w.w), bf_hi(w.w)}; }
__device__ __forceinline__ f32x4 unpack4(u32x2 w) { return (f32x4){bf_lo(w.x), bf_hi(w.x), bf_lo(w.y), bf_hi(w.y)}; }
__device__ __forceinline__ float log2g(const float* logit) {
    const float x = *logit, u = __expf(-x);
    float l = u * (1.f - u * (0.5f - u * (0.33333334f - u * (0.25f - u * (0.2f - u * 0.16666667f)))));
    if (u > 0.0625f) l = __logf(1.0f + u);
    return -l * 1.4426950408889634f;
}
__device__ __forceinline__ float rstd_from_ss(const float* ss) {
    const f32x4* sp = (const f32x4*)ss; const f32x4 a = sp[0], b = sp[1], c = sp[2], d = sp[3];
    const f32x4 t = (a + b) + (c + d); const float s = (t[0] + t[1]) + (t[2] + t[3]);
    return __builtin_amdgcn_rsqf(s * (1.0f / 1024.0f) + 1e-6f);
}

__device__ __forceinline__ float shx(float v, int lane, int m) { return __int_as_float(__builtin_amdgcn_ds_bpermute((lane ^ m) << 2, __float_as_int(v))); }
__device__ __forceinline__ int lane_now() { int l; asm volatile("v_mbcnt_lo_u32_b32 %0, -1, 0\n\tv_mbcnt_hi_u32_b32 %0, -1, %0" : "=v"(l)); return l; }
namespace pg8 {
constexpr int BM = 256, BK = 64, HALF = 128, HTB = HALF * BK * 2, STAGE_BYTES = 8 * HTB, NXCD = 8, WGM = 8;
__host__ __device__ __forceinline__ int lds_byte(int r, int c) { const int st = (r >> 4) * 2 + (c >> 5), rr = r & 15, cc = c & 31, ob = rr * 64 + cc * 2; return st * 1024 + (ob ^ (((ob >> 9) & 1) << 5)); }
__host__ __device__ __forceinline__ void stage_rc(int b, int& R, int& C) { const int st = b / 1024, sb = b % 1024, swz = sb ^ (((sb >> 9) & 1) << 5); R = (st >> 1) * 16 + swz / 64; C = (st & 1) * 32 + (swz % 64) / 2; }
__host__ __device__ __forceinline__ int perm32(int rho) { const int n = rho >> 4, i = rho & 15; return 8 * (i >> 2) + 4 * n + (i & 3); }
struct Unit { int pm, pn; };
struct Gemm { const bf16_t* A; const bf16_t* Bt; int M, N, K; };
struct StaticOrder {
    int nM, nN, nwg, G, c, rot;
    __device__ void init(int M, int N, int G_, int c_, int rot_ = 0) { nM = M / BM; nN = N / BM; nwg = nM * nN; G = G_; c = c_; rot = rot_; }
    __device__ bool next(int i, Unit& u) const {
        const long L = (long)i * G + c; if (L >= nwg) return false;
        int wgid = (int)L; { const int q = nwg / NXCD, r = nwg % NXCD, xcd = wgid % NXCD, off = wgid / NXCD; wgid = (xcd < r ? xcd * (q + 1) : r * (q + 1) + (xcd - r) * q) + off; }
        const int nig = WGM * nN, gid = wgid / nig, fm = gid * WGM, gsz = (nM - fm) < WGM ? (nM - fm) : WGM;
        u.pm = fm + ((wgid % nig) % gsz); { const int p = (wgid % nig) / gsz + rot; u.pn = p >= nN ? p - nN : p; } return true;
    }
};
template <class Epi>
__device__ __forceinline__ void gemm_phase(const int tid, LAS unsigned char* lds, const Gemm g, const StaticOrder& S, const Epi& E) {
    const int wid = __builtin_amdgcn_readfirstlane(tid >> 6), lane = tid & 63, wr = wid >> 2, wc = wid & 3, fr = lane & 15, fq = lane >> 4;
    const int K = g.K, nt = K / BK;
    unsigned voffA[2], voffB[2];
#pragma unroll
    for (int i = 0; i < 2; ++i) { int R, C; stage_rc(tid * 16 + i * 8192, R, C); const int Rb = Epi::PERM ? ((R & ~31) + perm32(R & 31)) : R;
        voffA[i] = (unsigned)(R * K + C) * 2u; voffB[i] = (unsigned)(Rb * K + C) * 2u; }
    const size_t kstep = (size_t)(BK * 2);
    const size_t hstep = (size_t)HALF * K * 2;
    const size_t tstep = 2 * hstep;
    const unsigned ldsw = (unsigned)wid * 1024u;
    const int aoff = lds_byte(wr * 64 + fr, fq * 8), boff = lds_byte(wc * 32 + fr, fq * 8);
#define PG8_SA(b, h) (((b) * 2 + (h)) * HTB)
#define PG8_SB(b, h) ((4 + (b) * 2 + (h)) * HTB)
#define PG8_STAGE(bufoff, gbase, voff) do { _Pragma("unroll") for (int _i = 0; _i < 2; ++_i) { unsigned _vo = (voff)[_i]; asm volatile("" : "+v"(_vo)); \
        __builtin_amdgcn_global_load_lds((const unsigned*)((const char*)(gbase) + _vo), (LAS unsigned*)(lds + (bufoff) + ldsw + _i * 8192), 16, 0, 0); } } while (0)
#define PG8_LDA(dst, b, h) do { _Pragma("unroll") for (int m = 0; m < 4; ++m) _Pragma("unroll") for (int k = 0; k < 2; ++k) dst[m][k] = *(const LAS bf16x8*)(lds + PG8_SA(b, h) + aoff + m * 2048 + k * 1024); } while (0)
#define PG8_LDB(dst, b, h) do { _Pragma("unroll") for (int n = 0; n < 2; ++n) _Pragma("unroll") for (int k = 0; k < 2; ++k) dst[n][k] = *(const LAS bf16x8*)(lds + PG8_SB(b, h) + boff + n * 2048 + k * 1024); } while (0)
#define PG8_MMA(ai, bj, At, Bt) do { __builtin_amdgcn_s_setprio(1); _Pragma("unroll") for (int m = 0; m < 4; ++m) _Pragma("unroll") for (int n = 0; n < 2; ++n) _Pragma("unroll") for (int k = 0; k < 2; ++k) \
        acc[ai][bj][m][n] = __builtin_amdgcn_mfma_f32_16x16x32_bf16(Bt[n][k], At[m][k], acc[ai][bj][m][n], 0, 0, 0); __builtin_amdgcn_s_setprio(0); } while (0)
#define PG8_WAIT_V(n) asm volatile("s_waitcnt vmcnt(" #n ")" ::: "memory")
#define PG8_WAIT_L(n) asm volatile("s_waitcnt lgkmcnt(" #n ")" ::: "memory")
#define PG8_BAR __builtin_amdgcn_s_barrier()
#define PG8_SCHED __builtin_amdgcn_sched_barrier(0)
    Unit cur, nxt; int ui = 0;
    if (!S.next(0, cur)) return;
    f32x4 acc[2][2][4][2];
#pragma unroll
    for (int a = 0; a < 2; ++a)
#pragma unroll
        for (int b = 0; b < 2; ++b)
#pragma unroll
            for (int m = 0; m < 4; ++m)
#pragma unroll
                for (int n = 0; n < 2; ++n) acc[a][b][m][n] = (f32x4){0.f, 0.f, 0.f, 0.f};
    bf16x8 At[4][2], B0[2][2], B1[2][2];
    const char* cA = (const char*)g.A + (size_t)cur.pm * tstep; const char* cB = (const char*)g.Bt + (size_t)cur.pn * tstep;
    PG8_STAGE(PG8_SB(0, 0), cB, voffB); PG8_STAGE(PG8_SA(0, 0), cA, voffA); PG8_STAGE(PG8_SB(0, 1), cB + hstep, voffB); PG8_STAGE(PG8_SA(0, 1), cA + hstep, voffA);
    if (wr == 1) PG8_BAR;
    PG8_WAIT_V(4); PG8_BAR;
    PG8_STAGE(PG8_SB(1, 0), cB + kstep, voffB); PG8_STAGE(PG8_SA(1, 0), cA + kstep, voffA); PG8_STAGE(PG8_SB(1, 1), cB + hstep + kstep, voffB);
    if constexpr (Epi::PREADD) E.preadd(acc, cur, wr, wc);
    PG8_WAIT_V(6); PG8_BAR;
    for (;;) {
        const bool has_next = S.next(ui + 1, nxt);
        const char* nA = has_next ? (const char*)g.A + (size_t)nxt.pm * tstep : cA; const char* nB = has_next ? (const char*)g.Bt + (size_t)nxt.pn * tstep : cB;
        for (int t = 0; t < nt; t += 2) {
            const bool last = (t == nt - 2);
            const char* a1 = cA + (size_t)(t + 1) * kstep;
            const char* a2 = last ? nA : cA + (size_t)(t + 2) * kstep; const char* b2 = last ? nB : cB + (size_t)(t + 2) * kstep;
            const char* a3 = a2 + kstep; const char* b3 = b2 + kstep;
            PG8_LDB(B0, 0, 0); PG8_SCHED; PG8_LDA(At, 0, 0); PG8_STAGE(PG8_SA(1, 1), a1 + hstep, voffA);
            PG8_WAIT_L(8); PG8_BAR; PG8_WAIT_L(0); PG8_MMA(0, 0, At, B0); PG8_BAR; PG8_SCHED;
            PG8_LDB(B1, 0, 1); PG8_STAGE(PG8_SB(0, 0), b2, voffB);
            PG8_BAR; PG8_WAIT_L(0); PG8_MMA(0, 1, At, B1); PG8_BAR;
            PG8_LDA(At, 0, 1); PG8_STAGE(PG8_SA(0, 0), a2, voffA);
            PG8_BAR; PG8_WAIT_L(0); PG8_MMA(1, 0, At, B0); PG8_BAR; PG8_SCHED;
            PG8_STAGE(PG8_SB(0, 1), b2 + hstep, voffB);
            PG8_WAIT_V(6); PG8_BAR; PG8_MMA(1, 1, At, B1); PG8_BAR;
            PG8_LDB(B0, 1, 0); PG8_SCHED; PG8_LDA(At, 1, 0); PG8_STAGE(PG8_SA(0, 1), a2 + hstep, voffA);
            PG8_WAIT_L(8); PG8_BAR; PG8_WAIT_L(0); PG8_MMA(0, 0, At, B0); PG8_BAR; PG8_SCHED;
            PG8_LDB(B1, 1, 1); PG8_STAGE(PG8_SB(1, 0), b3, voffB);
            PG8_BAR; PG8_WAIT_L(0); PG8_MMA(0, 1, At, B1); PG8_BAR;
            PG8_LDA(At, 1, 1); PG8_STAGE(PG8_SA(1, 0), a3, voffA);
            PG8_BAR; PG8_WAIT_L(0); PG8_MMA(1, 0, At, B0); PG8_BAR; PG8_SCHED;
            PG8_STAGE(PG8_SB(1, 1), b3 + hstep, voffB);
            PG8_WAIT_V(6); PG8_BAR; PG8_MMA(1, 1, At, B1); PG8_BAR;
        }
        E(acc, cur, wr, wc, fr, fq);
        if (!has_next) break;
#pragma unroll
        for (int a = 0; a < 2; ++a)
#pragma unroll
            for (int b = 0; b < 2; ++b)
#pragma unroll
                for (int m = 0; m < 4; ++m)
#pragma unroll
                    for (int n = 0; n < 2; ++n) acc[a][b][m][n] = (f32x4){0.f, 0.f, 0.f, 0.f};
        cur = nxt; cA = nA; cB = nB; ++ui;
        if constexpr (Epi::PREADD) E.preadd(acc, cur, wr, wc);
    }
    PG8_WAIT_V(0);
    if (wr == 0) PG8_BAR;
    PG8_BAR;
#undef PG8_SA
#undef PG8_SB
#undef PG8_STAGE
#undef PG8_LDA
#undef PG8_LDB
#undef PG8_MMA
#undef PG8_WAIT_V
#undef PG8_WAIT_L
#undef PG8_BAR
#undef PG8_SCHED
}
}
using pg8::Unit;

__device__ __forceinline__ void load_rstd8(const float* SS, int row0, int fr, int fq, float (&rstd)[8]) {
    const int ln = fq * 16 + fr;
    f32x4 q[8];
#pragma unroll
    for (int i = 0; i < 8; ++i) q[i] = *(const f32x4*)(SS + (size_t)(row0 + (i >> 2) * 128 + (i & 3) * 16) * 16 + fq * 4);
#pragma unroll
    for (int i = 0; i < 8; ++i) { float s = (q[i][0] + q[i][1]) + (q[i][2] + q[i][3]); s += shx(s, ln, 16); s += shx(s, ln, 32); rstd[i] = __builtin_amdgcn_rsqf(s * (1.0f / 1024.0f) + 1e-6f); }
}

__device__ __forceinline__ void cached_rstd8(LAS unsigned char* lds, const float* SS, int pm, int wave, int row0, int fr, int fq, float (&rs)[8]) {
    LAS float* slot = (LAS float*)(lds + LDS_RS) + (wave * 64 + fq * 16 + fr) * 8;
    LAS int* tag = (LAS int*)(lds + LDS_RSTAG) + wave;
    if (*tag == pm) {
        const f32x4 a = *(const LAS f32x4*)slot, b = *(const LAS f32x4*)(slot + 4);
        rs[0] = a[0]; rs[1] = a[1]; rs[2] = a[2]; rs[3] = a[3]; rs[4] = b[0]; rs[5] = b[1]; rs[6] = b[2]; rs[7] = b[3];
    } else {
        load_rstd8(SS, row0, fr, fq, rs);
        *(LAS f32x4*)slot = (f32x4){rs[0], rs[1], rs[2], rs[3]}; *(LAS f32x4*)(slot + 4) = (f32x4){rs[4], rs[5], rs[6], rs[7]};
        if (fq * 16 + fr == 0) *tag = pm;
    }
}

struct EpiZ {
    static constexpr bool PERM = true, PREADD = false;
    bf16_t* Z; const float* SS; const float* COS; const float* SIN; LAS unsigned char* lds;
    __device__ __forceinline__ void operator()(const f32x4 (&acc)[2][2][4][2], const Unit& u, int wr, int wc, int fr, int fq) const {
        { const int l_ = lane_now(); fr = l_ & 15; fq = l_ >> 4; }
        const int row0 = u.pm * 256 + wr * 64 + fr, pn = u.pn, colw = wc * 32 + 8 * fq;
        float rs[8]; cached_rstd8(lds, SS, u.pm, wr * 4 + wc, row0, fr, fq, rs);
#pragma unroll
        for (int ai = 0; ai < 2; ++ai)
#pragma unroll
            for (int m = 0; m < 4; ++m) {
                const int row = row0 + ai * 128 + m * 16;
                const float rstd = rs[ai * 4 + m];
                bf16_t* rowp = Z + (size_t)row * INW + pn * 256 + colw;
                if (pn >= 2 && pn < 6) {
                    const int i1 = 16 * wc + 4 * fq;
                    const f32x4 cs = *(const f32x4*)(COS + (size_t)row * 64 + i1), sn = *(const f32x4*)(SIN + (size_t)row * 64 + i1);
                    const float sc = rstd * (pn >= 4 ? 0.08838834764831845f : 1.0f);
#pragma unroll
                    for (int bj = 0; bj < 2; ++bj) {
                        const f32x4 x1 = acc[ai][bj][m][0] * sc, x2 = acc[ai][bj][m][1] * sc;
                        const f32x4 o1 = x1 * cs - x2 * sn, o2 = x1 * sn + x2 * cs;
                        *(u32x4*)(rowp + bj * 128) = pack8(o1, o2);
                    }
                } else {
#pragma unroll
                    for (int bj = 0; bj < 2; ++bj) {
                        f32x4 v0 = acc[ai][bj][m][0], v1 = acc[ai][bj][m][1];
                        const float nrl = rstd * -1.4426950408889634f;
                        if (pn >= 14) {
#pragma unroll
                            for (int j = 0; j < 4; ++j) { v0[j] = sigmoid_sc(v0[j], nrl); v1[j] = sigmoid_sc(v1[j], nrl); }
                        } else if (pn >= 10) {
                            { const float ir = __builtin_amdgcn_rcpf(rstd);
#pragma unroll
                            for (int j = 0; j < 4; ++j) { v0[j] = v0[j] * sigmoid_scm(v0[j], nrl, ir); v1[j] = v1[j] * sigmoid_scm(v1[j], nrl, ir); } }
                        } else { v0 = v0 * rstd; v1 = v1 * rstd; }
                        *(u32x4*)(rowp + bj * 128) = pack8(v0, v1);
                    }
                }
            }
    }
};
struct EpiSwiGLU {
    static constexpr bool PERM = true, PREADD = false;
    bf16_t* ACT; const float* SS; LAS unsigned char* lds;
    __device__ __forceinline__ void operator()(const f32x4 (&acc)[2][2][4][2], const Unit& u, int wr, int wc, int fr, int fq) const {
        { const int l_ = lane_now(); fr = l_ & 15; fq = l_ >> 4; }
        const int row0 = u.pm * 256 + wr * 64 + fr, col = u.pn * 128 + wc * 32 + 8 * fq;
        float rs[8]; cached_rstd8(lds, SS, u.pm, wr * 4 + wc, row0, fr, fq, rs);
#pragma unroll
        for (int ai = 0; ai < 2; ++ai)
#pragma unroll
            for (int m = 0; m < 4; ++m) {
                const int row = row0 + ai * 128 + m * 16;
                const float rstd = rs[ai * 4 + m];
                f32x4 o[2];
                const float ir2 = __builtin_amdgcn_rcpf(rstd * rstd), nrl = rstd * -1.4426950408889634f;
#pragma unroll
                for (int n = 0; n < 2; ++n) { const f32x4 gt = acc[ai][0][m][n], up = acc[ai][1][m][n];
#pragma unroll
                    for (int j = 0; j < 4; ++j) o[n][j] = (gt[j] * up[j]) * sigmoid_scm(gt[j], nrl, ir2); }
                *(u32x4*)(ACT + (size_t)row * DFF + col) = pack8(o[0], o[1]);
            }
    }
};
template <int MODE> struct EpiGen {
    static constexpr bool PERM = true, PREADD = false;
    bf16_t* O; const bf16_t* T; const bf16_t* G; const float* SS;
    __device__ __forceinline__ void operator()(const f32x4 (&acc)[2][2][4][2], const Unit& u, int wr, int wc, int fr, int fq) const {
        { const int l_ = lane_now(); fr = l_ & 15; fq = l_ >> 4; }
        const int row0 = u.pm * 256 + wr * 64 + fr, col0 = u.pn * 256 + wc * 32 + 8 * fq;
        if (MODE == 2) {
            float rs[8]; load_rstd8(SS, row0, fr, fq, rs);
#pragma unroll
            for (int rg = 0; rg < 8; ++rg) {
                const int ai = rg >> 2, m = rg & 3, row = row0 + ai * 128 + m * 16; const float rstd = rs[rg];
#pragma unroll
                for (int bj = 0; bj < 2; ++bj) {
                    f32x4 v0 = acc[ai][bj][m][0], v1 = acc[ai][bj][m][1];
#pragma unroll
                    for (int j = 0; j < 4; ++j) { v0[j] = sigmoid_sc(v0[j], rstd * -1.4426950408889634f); v1[j] = sigmoid_sc(v1[j], rstd * -1.4426950408889634f); }
                    *(u32x4*)(O + (size_t)row * DM + col0 + bj * 128) = pack8(v0, v1);
                }
            }
        } else {
            constexpr int NB = (MODE == 1) ? 2 : 1, RGP = 8 / NB;
#pragma unroll
            for (int b = 0; b < NB; ++b) {
                u32x4 gw[RGP][2], tw[RGP][2];
#pragma unroll
                for (int q = 0; q < RGP; ++q)
#pragma unroll
                    for (int bj = 0; bj < 2; ++bj) {
                        const int rg = b * RGP + q, row = row0 + (rg >> 2) * 128 + (rg & 3) * 16, col = col0 + bj * 128;
                        gw[q][bj] = *(const u32x4*)(G + (size_t)row * INW + col);
                        if (MODE == 1) tw[q][bj] = *(const u32x4*)(T + (size_t)row * DM + col);
                    }
#pragma unroll
                for (int q = 0; q < RGP; ++q)
#pragma unroll
                    for (int bj = 0; bj < 2; ++bj) {
                        const int rg = b * RGP + q, ai = rg >> 2, m = rg & 3, row = row0 + ai * 128 + m * 16, col = col0 + bj * 128;
                        f32x4 v0 = acc[ai][bj][m][0] * unpack_lo4(gw[q][bj]), v1 = acc[ai][bj][m][1] * unpack_hi4(gw[q][bj]);
                        if (MODE == 1) { v0 = v0 + unpack_lo4(tw[q][bj]); v1 = v1 + unpack_hi4(tw[q][bj]); }
                        *(u32x4*)(O + (size_t)row * DM + col) = pack8(v0, v1);
                    }
                asm volatile("" ::: "memory");
            }
        }
    }
};
template <bool MUL, bool SRC32> struct EpiResid {
    static constexpr bool PERM = true, PREADD = !MUL && !SRC32;
    __device__ __forceinline__ void preadd(f32x4 (&acc)[2][2][4][2], const Unit& u, int wr, int wc) const {
        const int l_ = lane_now(), fr = l_ & 15, fq = l_ >> 4;
        const int row0 = u.pm * 256 + wr * 64 + fr, col0 = u.pn * 256 + wc * 32 + 8 * fq;
        u32x4 xw[8][2];
#pragma unroll
        for (int rg = 0; rg < 8; ++rg)
#pragma unroll
            for (int bj = 0; bj < 2; ++bj) xw[rg][bj] = *(const u32x4*)(xb + (size_t)(row0 + (rg >> 2) * 128 + (rg & 3) * 16) * DM + col0 + bj * 128);
#pragma unroll
        for (int rg = 0; rg < 8; ++rg)
#pragma unroll
            for (int bj = 0; bj < 2; ++bj) { acc[rg >> 2][bj][rg & 3][0] = unpack_lo4(xw[rg][bj]); acc[rg >> 2][bj][rg & 3][1] = unpack_hi4(xw[rg][bj]); }
    }
    const float* x32; const bf16_t* xb; bf16_t* XBo; float* SSo; const bf16_t* T;
    __device__ __forceinline__ void operator()(const f32x4 (&acc)[2][2][4][2], const Unit& u, int wr, int wc, int fr, int fq) const {
        { const int l_ = lane_now(); fr = l_ & 15; fq = l_ >> 4; }
        const int row0 = u.pm * 256 + wr * 64 + fr, col0 = u.pn * 256 + wc * 32 + 8 * fq;
        constexpr int NB = SRC32 ? 4 : (MUL ? 2 : 1), RG_PER = 8 / NB;
#pragma unroll
        for (int b = 0; b < NB; ++b) {
            f32x4 xr[RG_PER][2][2]; u32x4 xw[RG_PER][2], tw[RG_PER][2];
#pragma unroll
            for (int q = 0; q < RG_PER; ++q)
#pragma unroll
                for (int bj = 0; bj < 2; ++bj) {
                    const int rg = b * RG_PER + q;
                    const size_t off = (size_t)(row0 + (rg >> 2) * 128 + (rg & 3) * 16) * DM + col0 + bj * 128;
                    if (SRC32) { xr[q][bj][0] = *(const f32x4*)(x32 + off); xr[q][bj][1] = *(const f32x4*)(x32 + off + 4); } else if (!PREADD) xw[q][bj] = *(const u32x4*)(xb + off);
                    if (MUL) tw[q][bj] = *(const u32x4*)(T + off);
                }
#pragma unroll
            for (int q = 0; q < RG_PER; ++q) {
                const int rg = b * RG_PER + q, ai = rg >> 2, m = rg & 3, row = row0 + ai * 128 + m * 16;
                float ss = 0.f;
#pragma unroll
                for (int bj = 0; bj < 2; ++bj) {
                    const size_t off = (size_t)row * DM + col0 + bj * 128;
                    f32x4 v0 = acc[ai][bj][m][0], v1 = acc[ai][bj][m][1];
                    if (MUL) { v0 = v0 * unpack_lo4(tw[q][bj]); v1 = v1 * unpack_hi4(tw[q][bj]); }
                    if (SRC32) { v0 = v0 + xr[q][bj][0]; v1 = v1 + xr[q][bj][1]; } else if (!PREADD) { v0 = v0 + unpack_lo4(xw[q][bj]); v1 = v1 + unpack_hi4(xw[q][bj]); }
                    *(u32x4*)(XBo + off) = pack8(v0, v1);
                    ss += (v0[0] * v0[0] + v0[1] * v0[1]) + (v0[2] * v0[2] + v0[3] * v0[3]) + (v1[0] * v1[0] + v1[1] * v1[1]) + (v1[2] * v1[2] + v1[3] * v1[3]);
                }
                { const int ln = fq * 16 + fr; ss += shx(ss, ln, 16); ss += shx(ss, ln, 32); }
                if (fq == 0) SSo[(size_t)row * 16 + u.pn * 4 + wc] = ss;
            }
            asm volatile("" ::: "memory");
        }
    }
};

struct Params { const float* in[19]; float* out; unsigned char* ws; int ph_lo, ph_hi; };
typedef const __attribute__((address_space(4))) Params* KPtr;
struct Ctx {
    KPtr P; float* out; unsigned char* ws; int wv, bid, G;
    __device__ __forceinline__ int ftid() const { return wv * 64 + lane_now(); }
    __device__ __forceinline__ bf16_t* W(int layer, size_t off) const { return (bf16_t*)(ws + WS_W + (size_t)layer * W_LAYER + off); }
    __device__ __forceinline__ float* COS() const { return (float*)(ws + WS_COS); }
    __device__ __forceinline__ float* SIN() const { return (float*)(ws + WS_SIN); }
    __device__ __forceinline__ bf16_t* XB(int i) const { return (bf16_t*)(ws + WS_XB + (size_t)i * SEQ * DM * 2); }
    __device__ __forceinline__ float* SS(int i) const { return (float*)(ws + WS_SS + (size_t)i * SEQ * 16 * 4); }
    __device__ __forceinline__ bf16_t* Z() const { return (bf16_t*)(ws + WS_Z); }
    __device__ __forceinline__ bf16_t* KV() const { return (bf16_t*)(ws + WS_KV); }
    __device__ __forceinline__ bf16_t* TMP() const { return (bf16_t*)(ws + WS_KV); }
    __device__ __forceinline__ bf16_t* MG() const { return (bf16_t*)(ws + WS_KV + (size_t)SEQ * DM * 2); }
    __device__ __forceinline__ bf16_t* PA() const { return (bf16_t*)(ws + WS_PA); }
    __device__ __forceinline__ bf16_t* RG() const { return (bf16_t*)(ws + WS_RG); }
    __device__ __forceinline__ bf16_t* PB(int layer) const { return (bf16_t*)(ws + WS_PB + (size_t)layer * SEQ * PLE * 2); }
    __device__ __forceinline__ const float* xin(int s) const { return s == 0 ? P->in[0] : P->in[1] + (size_t)(s - 1) * SEQ * DM; }
    __device__ __forceinline__ const float* pin(int s, int layer) const { return s == 0 ? P->in[2] + (size_t)layer * SEQ * PLE : P->in[3] + (size_t)(layer * 2 + (s - 1)) * SEQ * PLE; }
    __device__ __forceinline__ float* xout(int s) const { return out + (size_t)s * SEQ * DM; }
};

__device__ __forceinline__ int dperm(int c) { return ((c >> 2) & 1) * 64 + 16 * (c >> 5) + 4 * ((c >> 3) & 3) + (c & 3); }
struct MatDesc { const float* W; int ldw, K, N; bf16_t* out; const float* gk; const float* gn; int cm; };
__device__ __forceinline__ MatDesc mat_desc(const Ctx& C, int l, int j) {
    switch (j) {
    case 0: return MatDesc{C.P->in[5] + (size_t)l * DM * INW, INW, DM, INW, C.W(l, W_IN), C.P->in[4] + l * DM, nullptr, 1};
    case 1: return MatDesc{C.P->in[9] + (size_t)l * 512 * DM, DM, 512, DM, C.W(l, W_PO), nullptr, nullptr, 0};
    case 2: return MatDesc{C.P->in[10] + (size_t)l * DM * DM, DM, DM, DM, C.W(l, W_RO), nullptr, nullptr, 0};
    case 3: return MatDesc{C.P->in[11] + (size_t)l * DM * DM, DM, DM, DM, C.W(l, W_O), nullptr, nullptr, 0};
    case 4: return MatDesc{C.P->in[13] + (size_t)l * DM * INW, INW, DM, INW, C.W(l, W_FFI), C.P->in[12] + l * DM, nullptr, 2};
    case 5: return MatDesc{C.P->in[14] + (size_t)l * DFF * DM, DM, DFF, DM, C.W(l, W_FFO), nullptr, nullptr, 0};
    case 6: return MatDesc{C.P->in[16] + (size_t)l * DM * DM, DM, DM, DM, C.W(l, W_PG), C.P->in[15] + l * DM, nullptr, 0};
    case 7: return MatDesc{C.P->in[17] + (size_t)l * PLE * DM, DM, PLE, DM, C.W(l, W_PP), nullptr, nullptr, 0};
    default: { const int g = j - 8; return MatDesc{C.P->in[6] + (size_t)(l * 4 + g) * 128 * 128, 128, 128, 128, C.W(l, W_PW) + g * 128 * 128, nullptr, C.P->in[7] + l * 512 + g * 128, 0}; }
    }
}
__device__ __forceinline__ int mat_items(int j) { return (j == 0 || j == 4) ? (DM / 32) * INW : (j == 1) ? (512 / 32) * DM : (j == 5) ? (DFF / 32) * DM : (j == 7) ? (PLE / 32) * DM : (j >= 8) ? (128 / 32) * 128 : (DM / 32) * DM; }
__device__ void conv_range(const Ctx& C, int l, int jlo, int jhi, int w, int nw) {
    int total = 0;
    for (int j = jlo; j < jhi; ++j) total += mat_items(j);
    for (int it0 = w; it0 < total; it0 += nw) {
        int it = it0, j = jlo;
        for (; j < jhi - 1; ++j) { const int cnt = mat_items(j); if (it < cnt) break; it -= cnt; }
        const MatDesc md = mat_desc(C, l, j);
        const int N = md.N, K = md.K, kb = it / N, n = it - kb * N, k0 = kb * 32;
        int src = n;
        if (md.cm == 1) { if (n >= 512 && n < 1536) { const int sec = (n - 512) >> 7, c = (n - 512) & 127; src = 512 + sec * 128 + dperm(c); } }
        if (md.cm == 2) { const int pn = n >> 8, r = n & 255; src = (r < 128) ? (128 * pn + r) : (DFF + 128 * pn + (r - 128)); }
        const float sn = md.gn ? md.gn[n] : 1.0f;
        const float* wp = md.W + (size_t)k0 * md.ldw + src;
        float v[32];
#pragma unroll
        for (int i = 0; i < 32; ++i) v[i] = wp[(size_t)i * md.ldw];
        if (md.gk) {
#pragma unroll
            for (int i = 0; i < 32; i += 4) { const f32x4 g4 = *(const f32x4*)(md.gk + k0 + i); v[i] *= g4[0]; v[i + 1] *= g4[1]; v[i + 2] *= g4[2]; v[i + 3] *= g4[3]; }
        }
        u32x4* op = (u32x4*)(md.out + (size_t)n * K + k0);
#pragma unroll
        for (int i = 0; i < 4; ++i) { u32x4 wv; wv.x = cvt_pk_bf16(v[8 * i] * sn, v[8 * i + 1] * sn); wv.y = cvt_pk_bf16(v[8 * i + 2] * sn, v[8 * i + 3] * sn);
            wv.z = cvt_pk_bf16(v[8 * i + 4] * sn, v[8 * i + 5] * sn); wv.w = cvt_pk_bf16(v[8 * i + 6] * sn, v[8 * i + 7] * sn); op[i] = wv; }
    }
}
__device__ void phase_p0(const Ctx& C, LAS unsigned char* lds) {
    (void)lds;
    {
        const int w = C.bid * 512 + C.ftid(), nw = C.G * 512;
        conv_range(C, 0, 0, 4, w, nw); conv_range(C, 0, 8, 12, w, nw); conv_range(C, 1, 8, 12, w, nw);
        if (C.G != 256) { conv_range(C, 0, 4, 8, w, nw); conv_range(C, 1, 0, 8, w, nw); }
    }
    float* COS = C.COS(); float* SIN = C.SIN();
    for (int e = C.bid * 512 + C.ftid(); e < SEQ * 64; e += C.G * 512) {
        const int pos = e >> 6, i = e & 63;
        double inv = 1.0; for (int k = 0; k < i; ++k) inv *= 0.8659643233600653;
        const double x = (double)pos * inv;
        const double n = rint(x * 0.15915494309189535);
        const double r = fma(-n, 2.4492935982947064e-16, fma(-n, 6.283185307179586, x));
        const double r2 = r * r;
        double s = 1.0, c = 1.0;
#pragma unroll
        for (int k = 17; k >= 1; --k) { s = 1.0 - s * r2 * (1.0 / (double)((2 * k) * (2 * k + 1))); c = 1.0 - c * r2 * (1.0 / (double)((2 * k - 1) * (2 * k))); }
        COS[e] = (float)c; SIN[e] = (float)(s * r);
    }
}
__device__ void phase_rows(const Ctx& C, int s_fin, int s_pre) {
    const int tid0 = C.ftid(), wid = tid0 >> 6, lane = tid0 & 63;
    float* SS0 = C.SS(0); bf16_t* XB0 = C.XB(0);
    for (int row = C.bid * 8 + wid; row < SEQ; row += C.G * 8) {
        if (s_fin >= 0) {
            float* x = C.xout(s_fin) + (size_t)row * DM; const float* gf = C.P->in[18];
            const float rstd = rstd_from_ss(SS0 + (size_t)row * 16);
#pragma unroll
            for (int i = 0; i < 4; ++i) { const int col = lane * 4 + 256 * i; const f32x4 v = unpack4(*(const u32x2*)(XB0 + (size_t)row * DM + col)), g = *(const f32x4*)(gf + col); *(f32x4*)(x + col) = v * rstd * g; }
        }
        if (s_pre >= 0) {
            const float* x = C.xin(s_pre) + (size_t)row * DM; float ss = 0.f;
#pragma unroll
            for (int i = 0; i < 4; ++i) { const int col = lane * 4 + 256 * i; const f32x4 v = *(const f32x4*)(x + col);
                ss += (v[0] * v[0] + v[1] * v[1]) + (v[2] * v[2] + v[3] * v[3]); *(u32x2*)(XB0 + (size_t)row * DM + col) = pack4(v); }
#pragma unroll
            for (int o = 32; o >= 1; o >>= 1) ss += shx(ss, lane, o);
            if (lane < 16) SS0[(size_t)row * 16 + lane] = (lane == 0) ? ss : 0.f;
#pragma unroll
            for (int l = 0; l < 2; ++l) { const f32x4 v = *(const f32x4*)(C.pin(s_pre, l) + (size_t)row * PLE + lane * 4); *(u32x2*)(C.PB(l) + (size_t)row * PLE + lane * 4) = pack4(v); }
        }
    }
}

__device__ __forceinline__ bf16x8 tr_frag(const LAS bf16_t* T, int pitch, int r0, int c0, int fr, int fq) {
#if SLOW_TR
    bf16x8 f;
#pragma unroll
    for (int j = 0; j < 8; ++j) f[j] = (short)T[(r0 + 8 * fq + j) * pitch + c0 + fr];
    return f;
#endif
    const int q = fr >> 2, p = fr & 3;
    const LAS bf16_t* a = T + (r0 + 8 * fq + q) * pitch + c0 + 4 * p;
    const s16x4 lo = __builtin_amdgcn_ds_read_tr16_b64_v4i16((LAS s16x4*)a);
    const s16x4 hi = __builtin_amdgcn_ds_read_tr16_b64_v4i16((LAS s16x4*)(a + 4 * pitch));
    return __builtin_shufflevector(lo, hi, 0, 1, 2, 3, 4, 5, 6, 7);
}
__device__ __forceinline__ bf16x8 tr_frag_cs(const LAS bf16_t* T, int pitch, int r0, int c0, int fr, int fq) {
    const int q = fr >> 2, p = fr & 3;
    const LAS bf16_t* a = T + (r0 + 8 * fq + q) * pitch + c0 + 8 * p;
    const s16x4 lo = __builtin_amdgcn_ds_read_tr16_b64_v4i16((LAS s16x4*)a);
    const s16x4 hi = __builtin_amdgcn_ds_read_tr16_b64_v4i16((LAS s16x4*)(a + 4 * pitch));
    return __builtin_shufflevector(lo, hi, 0, 1, 2, 3, 4, 5, 6, 7);
}
#define MFMA16(a, b, c) __builtin_amdgcn_mfma_f32_16x16x32_bf16((a), (b), (c), 0, 0, 0)

template <int W2> __device__ __forceinline__ void pool_window(const bf16_t* col, int tpos, f32x4& s0, f32x4& s1) {
    u32x4 d[2 * W2];
#pragma unroll
    for (int k = 0; k < 2 * W2; ++k) { const int sp = tpos - W2 + k; const int sc = ((unsigned)sp < (unsigned)SEQ) ? sp : tpos; d[k] = *(const u32x4*)(col + (size_t)sc * INW); }
#pragma unroll
    for (int k = 0; k < 2 * W2; ++k) { const int sp = tpos - W2 + k; const float m = ((unsigned)sp < (unsigned)SEQ) ? 1.0f : 0.0f; s0 = s0 + unpack_lo4(d[k]) * m; s1 = s1 + unpack_hi4(d[k]) * m; }
}
__device__ void phase_a(const Ctx& C, LAS unsigned char* lds, int layer) {
    const int tid = C.ftid(), wid = __builtin_amdgcn_readfirstlane(tid >> 6), lane = tid & 63, fr = lane & 15, fq = lane >> 4;
    LAS bf16_t* Vs = (LAS bf16_t*)lds;
    LAS bf16_t* Kf = Vs + 128 * 264;
    LAS bf16_t* Kb = Kf + 128 * 136;
    const bf16_t* Z = C.Z();
    for (int t = C.bid; t < 1024; t += C.G) {
        __syncthreads();
        if (t < 512) {
            const int c = t >> 2, h = t & 3;
            const float lgf = log2g(C.P->in[8] + layer * 8 + h), lgb = log2g(C.P->in[8] + layer * 8 + 4 + h);
            const bf16_t* zrow = Z + (size_t)(c * 128) * INW;
#pragma unroll
            for (int i = 0; i < 8; ++i) { const int idx = tid + i * 512, r = idx >> 5, v = idx & 31;
                *(LAS u32x4*)(Vs + r * 264 + v * 8) = *(const u32x4*)(zrow + (size_t)r * INW + 1536 + h * 256 + v * 8); }
#pragma unroll
            for (int i = 0; i < 4; ++i) { const int idx = tid + i * 512, r = idx >> 4, v = idx & 15;
                const u32x4 d = *(const u32x4*)(zrow + (size_t)r * INW + 1024 + h * 128 + v * 8);
                const float wf = exp2f(lgf * (float)(127 - r)), wb = exp2f(lgb * (float)r);
                const f32x4 a = unpack_lo4(d), b = unpack_hi4(d);
                *(LAS u32x4*)(Kf + r * 136 + v * 8) = pack8(a * wf, b * wf);
                *(LAS u32x4*)(Kb + r * 136 + v * 8) = pack8(a * wb, b * wb); }
            __syncthreads();
            const int eq = wid & 3, dh = wid >> 2;
            f32x4 acc[2][4][4];
#pragma unroll
            for (int a = 0; a < 2; ++a)
#pragma unroll
                for (int b = 0; b < 4; ++b)
#pragma unroll
                    for (int e4 = 0; e4 < 4; ++e4) acc[a][b][e4] = (f32x4){0.f, 0.f, 0.f, 0.f};
#pragma unroll 1
            for (int kk = 0; kk < 4; ++kk) {
                int fr = lane & 15, fq = lane >> 4; asm volatile("" : "+v"(fr), "+v"(fq));
                bf16x8 vf[4];
#pragma unroll
                for (int et = 0; et < 4; ++et) vf[et] = tr_frag(Vs, 264, 32 * kk, 64 * eq + 16 * et, fr, fq);
#pragma unroll
                for (int dir = 0; dir < 2; ++dir)
#pragma unroll
                    for (int dt = 0; dt < 4; ++dt) {
                        const bf16x8 kf = tr_frag_cs(dir ? Kb : Kf, 136, 32 * kk, 64 * dh + 32 * (dt >> 1) + 4 * (dt & 1), fr, fq);
#pragma unroll
                        for (int et = 0; et < 4; ++et) acc[dir][dt][et] = MFMA16(kf, vf[et], acc[dir][dt][et]);
                    }
            }
            bf16_t* KV = C.KV();
#pragma unroll
            for (int dir = 0; dir < 2; ++dir)
#pragma unroll
                for (int j = 0; j < 2; ++j)
#pragma unroll
                    for (int et = 0; et < 4; ++et) {
                        const int e = 64 * eq + 16 * et + fr, d = 64 * dh + 32 * j + 8 * fq;
                        *(u32x4*)(KV + ((size_t)(((c * 4 + h) * 2 + dir) * 256 + e)) * 128 + d) = pack8(acc[dir][2 * j][et], acc[dir][2 * j + 1][et]);
                    }
        } else {
            const int pt = t - 512, tb = pt >> 2, g = (pt >= 256) ? 3 - (pt & 3) : (pt & 3), w2 = 1 << g;
            LAS bf16_t* Ds = (LAS bf16_t*)lds;
#pragma unroll 1
            for (int i = 0; i < 4; ++i) {
                const int idx = tid + i * 512, r = idx >> 4, v = idx & 15, tpos = tb * 128 + r;
                const int lo = max(tpos - w2, 0), hi = min(tpos + w2, SEQ);
                const bf16_t* col = Z + g * 128 + v * 8;
                f32x4 s0 = (f32x4){0.f, 0.f, 0.f, 0.f}, s1 = s0;
                if (g == 3) pool_window<8>(col, tpos, s0, s1); else if (g == 2) pool_window<4>(col, tpos, s0, s1); else if (g == 1) pool_window<2>(col, tpos, s0, s1); else pool_window<1>(col, tpos, s0, s1);
                const float inv = 1.0f / (float)(hi - lo);
                const u32x4 d = *(const u32x4*)(col + (size_t)tpos * INW);
                *(LAS u32x4*)(Ds + r * 136 + v * 8) = pack8(s0 * inv - unpack_lo4(d), s1 * inv - unpack_hi4(d));
            }
            __syncthreads();
            const bf16_t* PW = C.W(layer, W_PW) + g * 128 * 128;
            f32x4 acc[8];
#pragma unroll
            for (int dt = 0; dt < 8; ++dt) acc[dt] = (f32x4){0.f, 0.f, 0.f, 0.f};
#pragma unroll 1
            for (int kk = 0; kk < 4; ++kk) {
                const bf16x8 df = *(const LAS bf16x8*)(Ds + (16 * wid + fr) * 136 + 32 * kk + 8 * fq);
#pragma unroll
                for (int dt = 0; dt < 8; ++dt) { const bf16x8 wf = *(const bf16x8*)(PW + (16 * dt + fr) * 128 + 32 * kk + 8 * fq); acc[dt] = MFMA16(wf, df, acc[dt]); }
            }
            bf16_t* PA = C.PA();
            const int row = tb * 128 + 16 * wid + fr;
#pragma unroll
            for (int dt = 0; dt < 8; ++dt) *(u32x2*)(PA + (size_t)row * 512 + g * 128 + 16 * dt + 4 * fq) = pack4(acc[dt]);
        }
    }
}
__device__ void phase_b(const Ctx& C, int layer) {
    u32x4* KV = (u32x4*)C.KV();
    const int tid = C.ftid();
    if (tid >= 128) return;
    for (int it = C.bid * 128 + tid; it < 32768; it += C.G * 128) {
        const int idx = it * 8, h = idx >> 16, dir = (idx >> 15) & 1;
        const float cd = exp2f(log2g(C.P->in[8] + layer * 8 + dir * 4 + h) * 128.0f);
        u32x4* base = KV + it;
        f32x4 ra = (f32x4){0.f, 0.f, 0.f, 0.f}, rb = ra;
        const int c0 = dir ? 127 : 0, st = dir ? -1 : 1;
        for (int cc = 0; cc < 128; cc += 8) { u32x4 v[8];
#pragma unroll
            for (int i = 0; i < 8; ++i) v[i] = base[(size_t)(c0 + st * (cc + i)) * 32768];
#pragma unroll
            for (int i = 0; i < 8; ++i) { base[(size_t)(c0 + st * (cc + i)) * 32768] = pack8(ra, rb); ra = ra * cd + unpack_lo4(v[i]); rb = rb * cd + unpack_hi4(v[i]); } }
    }
}
__device__ void phase_c(const Ctx& C, LAS unsigned char* lds, int layer) {
    const int tid0 = C.ftid(), wid = __builtin_amdgcn_readfirstlane(tid0 >> 6), lane = tid0 & 63;
    LAS bf16_t* Qs = (LAS bf16_t*)lds;
    LAS bf16_t* Ps = Qs + 128 * 136;
    LAS bf16_t* Vs = Ps + 128 * 136;
    LAS float* St = (LAS float*)(Vs + 128 * 264);
    const bf16_t* Z = C.Z(); const bf16_t* KV = C.KV(); bf16_t* RG = C.RG();
    for (int t = C.bid; t < 512; t += C.G) {
        const int c = t >> 2, h = t & 3;
        const float lgf = log2g(C.P->in[8] + layer * 8 + h), lgb = log2g(C.P->in[8] + layer * 8 + 4 + h);
        const bf16_t* zrow = Z + (size_t)(c * 128) * INW;
        const int e0 = 32 * wid;
        int fr = lane & 15, fq = lane >> 4;
        asm volatile("" : "+v"(fr), "+v"(fq));
        bf16x8 sf[2][2][4];
#pragma unroll
        for (int dir = 0; dir < 2; ++dir) {
            const bf16_t* sb = KV + (size_t)(((c * 4 + h) * 2 + dir) * 256) * 128;
#pragma unroll
            for (int et = 0; et < 2; ++et)
#pragma unroll
                for (int kk = 0; kk < 4; ++kk) sf[dir][et][kk] = *(const bf16x8*)(sb + (size_t)(e0 + 16 * et + fr) * 128 + 32 * kk + 8 * fq);
        }
        __syncthreads();
        { const int tid = C.ftid();
#pragma unroll
        for (int i = 0; i < 8; ++i) { const int idx = tid + i * 512, r = idx >> 5, v = idx & 31;
            *(LAS u32x4*)(Vs + r * 264 + v * 8) = *(const u32x4*)(zrow + (size_t)r * INW + 1536 + h * 256 + v * 8); }
#pragma unroll
        for (int i = 0; i < 4; ++i) { const int idx = tid + i * 512, r = idx >> 4, v = idx & 15;
            *(LAS u32x4*)(Qs + r * 136 + v * 8) = *(const u32x4*)(zrow + (size_t)r * INW + 512 + h * 128 + v * 8);
            *(LAS u32x4*)(Ps + r * 136 + v * 8) = *(const u32x4*)(zrow + (size_t)r * INW + 1024 + h * 128 + v * 8); }
        }
        __syncthreads();
        asm volatile("" : "+v"(fr), "+v"(fq));
        f32x4 sc[8];
        {
            const int i0 = 16 * wid;
            bf16x8 qf[4];
#pragma unroll
            for (int kk = 0; kk < 4; ++kk) qf[kk] = *(const LAS bf16x8*)(Qs + (i0 + fr) * 136 + 32 * kk + 8 * fq);
#pragma unroll
            for (int jt = 0; jt < 8; ++jt) {
                f32x4 a = (f32x4){0.f, 0.f, 0.f, 0.f};
#pragma unroll
                for (int kk = 0; kk < 4; ++kk) { const bf16x8 kf = *(const LAS bf16x8*)(Ps + (16 * jt + fr) * 136 + 32 * kk + 8 * fq); a = MFMA16(kf, qf[kk], a); }
                const int i = i0 + fr;
#pragma unroll
                for (int r = 0; r < 4; ++r) { const int j = 16 * jt + 4 * fq + r, dl = i - j; a[r] *= (dl >= 0) ? exp2f(lgf * (float)dl) : exp2f(lgb * (float)(-dl)); }
                sc[jt] = a;
            }
        }
        __syncthreads();
        {
            const int i = 16 * wid + fr;
#pragma unroll
            for (int jt = 0; jt < 8; ++jt) *(LAS u32x2*)(Ps + i * 136 + 16 * jt + 4 * fq) = pack4(sc[jt]);
        }
        __syncthreads();
        asm volatile("" : "+v"(fr), "+v"(fq));
        f32x4 y[8][2];
#pragma unroll
        for (int m = 0; m < 8; ++m) { y[m][0] = (f32x4){0.f, 0.f, 0.f, 0.f}; y[m][1] = (f32x4){0.f, 0.f, 0.f, 0.f}; }
#pragma unroll 1
        for (int kk = 0; kk < 4; ++kk) {
            bf16x8 vf[2];
#pragma unroll
            for (int et = 0; et < 2; ++et) vf[et] = tr_frag(Vs, 264, 32 * kk, e0 + 16 * et, fr, fq);
#pragma unroll
            for (int m = 0; m < 8; ++m) { const bf16x8 pf = *(const LAS bf16x8*)(Ps + (16 * m + fr) * 136 + 32 * kk + 8 * fq);
                y[m][0] = MFMA16(vf[0], pf, y[m][0]); y[m][1] = MFMA16(vf[1], pf, y[m][1]); }
        }
#pragma unroll
        for (int dir = 0; dir < 2; ++dir) {
            asm volatile("" : "+v"(fr), "+v"(fq));
#pragma unroll
            for (int m = 0; m < 8; ++m) {
                f32x4 t0 = (f32x4){0.f, 0.f, 0.f, 0.f}, t1 = t0;
#pragma unroll
                for (int kk = 0; kk < 4; ++kk) { const bf16x8 qq = *(const LAS bf16x8*)(Qs + (16 * m + fr) * 136 + 32 * kk + 8 * fq); t0 = MFMA16(sf[dir][0][kk], qq, t0); t1 = MFMA16(sf[dir][1][kk], qq, t1); }
                const int i = 16 * m + fr;
                const float scl = (dir == 0) ? exp2f(lgf * (float)(i + 1)) : exp2f(lgb * (float)(128 - i));
                y[m][0] = y[m][0] + t0 * scl; y[m][1] = y[m][1] + t1 * scl;
                if (m & 1) asm volatile("" ::: "memory");
            }
        }
        asm volatile("" : "+v"(fr), "+v"(fq));
        u32x2 gsw[8][2];
#pragma unroll
        for (int m = 0; m < 8; ++m)
#pragma unroll
            for (int et = 0; et < 2; ++et) gsw[m][et] = *(const u32x2*)(zrow + (size_t)(16 * m + fr) * INW + 2560 + h * 256 + e0 + 16 * et + 4 * fq);
#pragma unroll
        for (int m = 0; m < 8; ++m) {
            const f32x4 a = y[m][0], b = y[m][1];
            float s = (a[0] + a[1]) + (a[2] + a[3]) + (b[0] + b[1]) + (b[2] + b[3]);
            float q = (a[0] * a[0] + a[1] * a[1]) + (a[2] * a[2] + a[3] * a[3]) + (b[0] * b[0] + b[1] * b[1]) + (b[2] * b[2] + b[3] * b[3]);
            { const int ln = fq * 16 + fr; s += shx(s, ln, 16); s += shx(s, ln, 32); q += shx(q, ln, 16); q += shx(q, ln, 32); }
            if (fq == 0) { St[(16 * m + fr) * 16 + wid * 2] = s; St[(16 * m + fr) * 16 + wid * 2 + 1] = q; }
        }
        __syncthreads();
#pragma unroll
        for (int m = 0; m < 8; ++m) {
            const int i = 16 * m + fr;
            const LAS f32x4* sp = (const LAS f32x4*)(St + i * 16);
            const f32x4 p0 = sp[0], p1 = sp[1], p2 = sp[2], p3 = sp[3];
            const float s = (p0[0] + p0[2]) + (p1[0] + p1[2]) + (p2[0] + p2[2]) + (p3[0] + p3[2]);
            const float q = (p0[1] + p0[3]) + (p1[1] + p1[3]) + (p2[1] + p2[3]) + (p3[1] + p3[3]);
            const float mean = s * (1.0f / 256.0f), var = fmaxf(q * (1.0f / 256.0f) - mean * mean, 0.f);
            const float rstd = __builtin_amdgcn_rsqf(var + 1e-5f);
            const size_t row = (size_t)(c * 128 + i);
#pragma unroll
            for (int et = 0; et < 2; ++et) {
                const int e = e0 + 16 * et + 4 * fq;
                *(u32x2*)(RG + row * DM + h * 256 + e) = pack4((y[m][et] - mean) * rstd * unpack4(gsw[m][et]));
            }
        }
    }
}

__device__ __forceinline__ void run_phase(const Ctx& C, LAS unsigned char* lds, int ph) {
    if (ph == 0) { phase_p0(C, lds); phase_rows(C, -1, 0); return; }
    const int q = ph - 1, s = q / 19, r = q % 19;
    if (r == 18) { phase_rows(C, s, s < 2 ? s + 1 : -1); return; }
    const int layer = r / 9, st = r % 9, cur = layer, G = C.G, bid = C.bid;
    pg8::StaticOrder S;
    switch (st) {
    case 0: { pg8::Gemm g{C.XB(cur), C.W(layer, W_IN), SEQ, INW, DM}; S.init(SEQ, INW, G, bid, 2);
              { const int t_ = C.ftid(); if ((t_ & 63) == 0) ((LAS int*)(lds + LDS_RSTAG))[t_ >> 6] = -1; }
              EpiZ E{C.Z(), C.SS(cur), C.COS(), C.SIN(), lds}; pg8::gemm_phase(C.ftid(), lds, g, S, E);
              if (s == 0 && G == 256 && bid >= 128) conv_range(C, layer, 4, 8, (bid - 128) * 512 + C.ftid(), 128 * 512); } break;
    case 1: phase_a(C, lds, layer); break;
    case 2: phase_b(C, layer); break;
    case 3: phase_c(C, lds, layer); break;
    case 4: { S.init(SEQ, DM, G, bid);
              { pg8::Gemm g{C.PA(), C.W(layer, W_PO), SEQ, DM, 512}; EpiGen<0> E{C.TMP(), nullptr, C.Z() + 3584, nullptr}; pg8::gemm_phase(C.ftid(), lds, g, S, E); }
              { pg8::Gemm g{C.RG(), C.W(layer, W_RO), SEQ, DM, DM}; EpiGen<1> E{C.MG(), C.TMP(), C.Z() + 3584 + 1024, nullptr}; pg8::gemm_phase(C.ftid(), lds, g, S, E); } } break;
    case 5: { pg8::Gemm g{C.MG(), C.W(layer, W_O), SEQ, DM, DM}; S.init(SEQ, DM, G, bid);
              if (layer == 0) { EpiResid<false, true> E{C.xin(s), nullptr, C.XB(cur ^ 1), C.SS(cur ^ 1), nullptr}; pg8::gemm_phase(C.ftid(), lds, g, S, E); }
              else { EpiResid<false, false> E{nullptr, C.XB(cur), C.XB(cur ^ 1), C.SS(cur ^ 1), nullptr}; pg8::gemm_phase(C.ftid(), lds, g, S, E); } } break;
    case 6: { pg8::Gemm g{C.XB(cur ^ 1), C.W(layer, W_FFI), SEQ, INW, DM}; S.init(SEQ, INW, G, bid);
              { const int t_ = C.ftid(); if ((t_ & 63) == 0) ((LAS int*)(lds + LDS_RSTAG))[t_ >> 6] = -1; }
              EpiSwiGLU E{C.Z(), C.SS(cur ^ 1), lds}; pg8::gemm_phase(C.ftid(), lds, g, S, E);
              if (s == 0 && layer == 0 && G == 256 && bid >= 128) conv_range(C, 1, 0, 4, (bid - 128) * 512 + C.ftid(), 128 * 512); } break;
    case 7: { pg8::Gemm g{C.Z(), C.W(layer, W_FFO), SEQ, DM, DFF}; S.init(SEQ, DM, G, bid);
              EpiResid<false, false> E{nullptr, C.XB(cur ^ 1), C.XB(cur), C.SS(cur), nullptr}; pg8::gemm_phase(C.ftid(), lds, g, S, E); } break;
    default: { S.init(SEQ, DM, G, bid);
              { pg8::Gemm g{C.XB(cur), C.W(layer, W_PG), SEQ, DM, DM}; EpiGen<2> E{C.TMP(), nullptr, nullptr, C.SS(cur)}; pg8::gemm_phase(C.ftid(), lds, g, S, E); }
              { pg8::Gemm g{C.PB(layer), C.W(layer, W_PP), SEQ, DM, PLE}; EpiResid<true, false> E{nullptr, C.XB(cur), C.XB(cur ^ 1), C.SS(cur ^ 1), C.TMP()}; pg8::gemm_phase(C.ftid(), lds, g, S, E); } } break;
    }
}


#define XB_TMO      128
#define XB_XCNT(j)  (256  + 64 * (j))
#define XB_XSUB(j)  (1280 + 64 * (j))
#define XB_XGEN(j)  (2304 + 64 * (j))
#define XB_TOP      3328
#define XB_TOPGEN   3392
#define XCD_BAR_WORDS 3456
#define XB_SPIN_CAP (1u << 18)
__device__ __forceinline__ unsigned xb_ld(unsigned* p)              { return __hip_atomic_load(p, __ATOMIC_RELAXED, __HIP_MEMORY_SCOPE_AGENT); }
__device__ __forceinline__ unsigned xb_add(unsigned* p, unsigned v) { return __hip_atomic_fetch_add(p, v, __ATOMIC_RELAXED, __HIP_MEMORY_SCOPE_AGENT); }
__device__ __forceinline__ unsigned xb_xcc_id() { return (unsigned)__builtin_amdgcn_s_getreg((3 << 11) | 20) & 0xFu; }
#define XB_SPIN(cond, bar) do { unsigned _sp = 0; while (cond) { __builtin_amdgcn_s_sleep(1); \
    if ((++_sp & 255u) == 0u) { if (xb_ld(&(bar)[XB_TMO])) break; if (_sp > XB_SPIN_CAP) { atomicAdd(&(bar)[XB_TMO], 1u); break; } } } } while (0)
struct XcdBarrier { unsigned* bar; unsigned x; volatile LAS unsigned* st; };
__device__ __forceinline__ XcdBarrier xcd_barrier_post(unsigned* bar, volatile LAS unsigned* st, bool leader) {
    XcdBarrier b; b.bar = bar; b.x = xb_xcc_id(); b.st = st;
    if (leader) (void)xb_add(&bar[XB_XCNT(b.x)], 1u);
    return b;
}
__device__ __forceinline__ void xcd_barrier_complete(unsigned* bar, unsigned x, unsigned& nloc, unsigned& nx) {
    const unsigned G = gridDim.x * gridDim.y * gridDim.z;
    unsigned sum, cnt, mine, sp = 0u;
    for (;;) {
        sum = 0u; cnt = 0u; mine = 0u;
#pragma unroll
        for (unsigned j = 0; j < 16; ++j) { const unsigned c = xb_ld(&bar[XB_XCNT(j)]); sum += c; cnt += (c > 0u) ? 1u : 0u; mine = (j == x) ? c : mine; }
        if (sum == G) break;
        __builtin_amdgcn_s_sleep(1);
        if ((++sp & 255u) == 0u) { if (xb_ld(&bar[XB_TMO])) break; if (sp > XB_SPIN_CAP) { atomicAdd(&bar[XB_TMO], 1u); break; } }
    }
    nloc = mine > 0u ? mine : 1u; nx = cnt > 0u ? cnt : 1u;
}
__device__ __forceinline__ void xcd_barrier(const XcdBarrier& b, int wv) {
    asm volatile("s_waitcnt vmcnt(0)" ::: "memory");
    __syncthreads();
    if (wv == 0 && lane_now() == 0) {
        unsigned* bar = b.bar;
        __builtin_amdgcn_s_waitcnt(0);
        unsigned nloc = b.st[0], nx = b.st[1];
        if (nloc == 0u) { xcd_barrier_complete(bar, b.x, nloc, nx); b.st[0] = nloc; b.st[1] = nx; }
        const unsigned old = xb_add(&bar[XB_XSUB(b.x)], 1u);
        const unsigned gen = old / nloc;
        if (old + 1u == (gen + 1u) * nloc) {
            __builtin_amdgcn_fence(__ATOMIC_RELEASE, "agent");
            asm volatile("s_waitcnt vmcnt(0)" ::: "memory");
            const unsigned og = xb_add(&bar[XB_TOP], 1u);
            const unsigned tg = og / nx;
            if (og + 1u == (tg + 1u) * nx) xb_add(&bar[XB_TOPGEN], 1u);
            else XB_SPIN(xb_ld(&bar[XB_TOPGEN]) == tg, bar);
            __builtin_amdgcn_fence(__ATOMIC_ACQUIRE, "agent");
            xb_add(&bar[XB_XGEN(b.x)], 1u);
            asm volatile("s_waitcnt vmcnt(0)" ::: "memory");
        } else {
            XB_SPIN(xb_ld(&bar[XB_XGEN(b.x)]) == gen, bar);
            __builtin_amdgcn_fence(__ATOMIC_ACQUIRE, "agent");
            asm volatile("s_waitcnt vmcnt(0)" ::: "memory");
        }
    }
    __syncthreads();
}

__global__ void __launch_bounds__(512, 2) mk_fwd(Params P) {
    extern __shared__ __attribute__((aligned(16))) unsigned char lds_raw[];
    LAS unsigned char* lds = (LAS unsigned char*)lds_raw;
    const int wv0 = __builtin_amdgcn_readfirstlane((int)threadIdx.x >> 6);
    const bool leader0 = (threadIdx.x == 0);
    volatile LAS unsigned* bst = (volatile LAS unsigned*)(lds + LDS_BYTES - 16);
    XcdBarrier bar; bar.bar = (unsigned*)(P.ws + WS_END); bar.x = 0; bar.st = bst;
    if (P.ph_hi - P.ph_lo > 1) {
        if (leader0) { bst[0] = 0u; bst[1] = 0u; }
        __syncthreads();
        bar = xcd_barrier_post((unsigned*)(P.ws + WS_END), bst, leader0);
    }
    for (int ph = P.ph_lo; ph < P.ph_hi; ++ph) {
        int wv = wv0, bid = blockIdx.x, G = gridDim.x;
        asm volatile("" : "+s"(wv), "+s"(bid), "+s"(G));
        KPtr pp = (KPtr)__builtin_amdgcn_kernarg_segment_ptr();
        asm volatile("" : "+s"(pp));
        Ctx C{pp, pp->out, pp->ws, wv, bid, G};
        run_phase(C, lds, ph);
#if REP_MASK
        { int cls; if (ph == 0) cls = 10; else { const int r = (ph - 1) % 19; cls = (r == 18) ? 9 : (r % 9); }
          if ((REP_MASK >> cls) & 1) { __syncthreads(); run_phase(C, lds, ph); } }
#endif
        if (ph + 1 < P.ph_hi) { if (ph == P.ph_lo) cg::this_grid().sync(); else xcd_barrier(bar, wv0); }
    }
}

extern "C" void kernel_launch(void* const* d_in, const int* in_sizes, int n_in, void* d_out, int out_size, void* d_ws, size_t ws_size, hipStream_t stream) {
    static int grid = 0;
    if (grid == 0) {
        if (n_in != 19 || ws_size < WS_END + XCD_BAR_WORDS * 4) { fprintf(stderr, "kernel_launch: unexpected n_in %d / ws %zu (need %zu)\n", n_in, ws_size, (size_t)WS_END); grid = -1; return; }
        int dev = 0, cus = 0, per_cu = 0;
        hipGetDevice(&dev); hipDeviceGetAttribute(&cus, hipDeviceAttributeMultiprocessorCount, dev);
        hipFuncSetAttribute((const void*)mk_fwd, hipFuncAttributeMaxDynamicSharedMemorySize, LDS_BYTES);
        hipOccupancyMaxActiveBlocksPerMultiprocessor(&per_cu, (const void*)mk_fwd, 512, LDS_BYTES);
        if (per_cu < 1) per_cu = 1;
        (void)hipGetLastError();
        grid = cus * per_cu;
    }
    if (grid < 0) return;
    if (hipMemsetAsync((char*)d_ws + WS_END, 0, XCD_BAR_WORDS * 4, stream) != hipSuccess) { fprintf(stderr, "kernel_launch: memset of barrier words failed\n"); return; }
    Params p{};
    for (int i = 0; i < 19; ++i) p.in[i] = (const float*)d_in[i];
    p.out = (float*)d_out; p.ws = (unsigned char*)d_ws;
#if MULTI_LAUNCH
    for (int ph = 0; ph < NPH; ++ph) { p.ph_lo = ph; p.ph_hi = ph + 1; hipLaunchKernelGGL(mk_fwd, dim3(grid), dim3(512), LDS_BYTES, stream, p); }
#else
    p.ph_lo = 0; p.ph_hi = NPH;
    void* args[] = {&p};
    hipError_t e = hipLaunchCooperativeKernel((const void*)mk_fwd, dim3(grid), dim3(512), args, LDS_BYTES, stream);
    if (e != hipSuccess) fprintf(stderr, "cooperative launch failed: %s (grid %d)\n", hipGetErrorString(e), grid);
#endif
}
```

```cpp
#include <hip/hip_runtime.h>
#include <hip/hip_cooperative_groups.h>
#include <cstdio>
namespace cg = cooperative_groups;

#ifndef SLOW_TR
#define SLOW_TR 0
#endif
#ifndef REP_MASK
#define REP_MASK 0
#endif
#ifndef MULTI_LAUNCH
#define MULTI_LAUNCH 0
#endif

#define LAS __attribute__((address_space(3)))
typedef unsigned short bf16_t;
typedef short bf16x8 __attribute__((ext_vector_type(8)));
typedef short s16x4 __attribute__((ext_vector_type(4)));
typedef float f32x4 __attribute__((ext_vector_type(4)));
typedef unsigned u32x4 __attribute__((ext_vector_type(4)));
typedef unsigned u32x2 __attribute__((ext_vector_type(2)));

constexpr int SEQ = 16384, DM = 1024, INW = 5632, DFF = 2816, PLE = 256;
constexpr int NPH = 58;
constexpr size_t W_IN = 0, W_PO = W_IN + (size_t)INW * DM * 2, W_RO = W_PO + (size_t)DM * 512 * 2, W_O = W_RO + (size_t)DM * DM * 2,
                 W_FFI = W_O + (size_t)DM * DM * 2, W_FFO = W_FFI + (size_t)INW * DM * 2, W_PG = W_FFO + (size_t)DM * DFF * 2,
                 W_PP = W_PG + (size_t)DM * DM * 2, W_PW = W_PP + (size_t)DM * PLE * 2, W_LAYER = W_PW + (size_t)4 * 128 * 128 * 2;
constexpr size_t WS_W = 0, WS_COS = WS_W + 2 * W_LAYER, WS_SIN = WS_COS + (size_t)SEQ * 64 * 4, WS_XB = WS_SIN + (size_t)SEQ * 64 * 4,
                 WS_SS = WS_XB + 2 * (size_t)SEQ * DM * 2, WS_Z = WS_SS + 2 * (size_t)SEQ * 16 * 4, WS_KV = WS_Z + (size_t)SEQ * INW * 2,
                 WS_PA = WS_KV + (size_t)128 * 4 * 2 * 256 * 128 * 2, WS_RG = WS_PA + (size_t)SEQ * 512 * 2, WS_PB = WS_RG + (size_t)SEQ * DM * 2,
                 WS_END = WS_PB + 2 * (size_t)SEQ * PLE * 2;
constexpr int LDS_BYTES = 147456 + 64;
constexpr int LDS_RS = 131072, LDS_RSTAG = 131072 + 16384;

typedef float f32x2_t __attribute__((ext_vector_type(2)));
typedef __bf16 bf16x2_t __attribute__((ext_vector_type(2)));
__device__ __forceinline__ unsigned cvt_pk_bf16(float lo, float hi) { const f32x2_t v = {lo, hi}; return __builtin_bit_cast(unsigned, __builtin_convertvector(v, bf16x2_t)); }
__device__ __forceinline__ float bf_lo(unsigned u) { return __uint_as_float(u << 16); }
__device__ __forceinline__ float bf_hi(unsigned u) { return __uint_as_float(u & 0xffff0000u); }
__device__ __forceinline__ float sigmoid_f(float x) { return __builtin_amdgcn_rcpf(1.0f + __expf(-x)); }
__device__ __forceinline__ float sigmoid_sc(float v, float nrl) { return __builtin_amdgcn_rcpf(1.0f + __builtin_amdgcn_exp2f(v * nrl)); }
__device__ __forceinline__ float sigmoid_scm(float v, float nrl, float ic) { return __builtin_amdgcn_rcpf(__builtin_fmaf(__builtin_amdgcn_exp2f(v * nrl), ic, ic)); }
__device__ __forceinline__ float silu_f(float x) { return x * sigmoid_f(x); }
__device__ __forceinline__ u32x2 pack4(f32x4 v) { u32x2 w; w.x = cvt_pk_bf16(v[0], v[1]); w.y = cvt_pk_bf16(v[2], v[3]); return w; }
__device__ __forceinline__ u32x4 pack8(f32x4 a, f32x4 b) { u32x4 w; w.x = cvt_pk_bf16(a[0], a[1]); w.y = cvt_pk_bf16(a[2], a[3]); w.z = cvt_pk_bf16(b[0], b[1]); w.w = cvt_pk_bf16(b[2], b[3]); return w; }
__device__ __forceinline__ f32x4 unpack_lo4(u32x4 w) { return (f32x4){bf_lo(w.x), bf_hi(w.x), bf_lo(w.y), bf_hi(w.y)}; }
__device__ __forceinline__ f32x4 unpack_hi4(u32x4 w) { return (f32x4){bf_lo(w.z), bf_hi(w.z), bf_lo(w.w), bf_hi(w.w)}; }
__device__ __forceinline__ f32x4 unpack4(u32x2 w) { return (f32x4){bf_lo(w.x), bf_hi(w.x), bf_lo(w.y), bf_hi(w.y)}; }
__device__ __forceinline__ float log2g(const float* logit) {
    const float x = *logit, u = __expf(-x);
    float l = u * (1.f - u * (0.5f - u * (0.33333334f - u * (0.25f - u * (0.2f - u * 0.16666667f)))));
    if (u > 0.0625f) l = __logf(1.0f + u);
    return -l * 1.4426950408889634f;
}
__device__ __forceinline__ float rstd_from_ss(const float* ss) {
    const f32x4* sp = (const f32x4*)ss; const f32x4 a = sp[0], b = sp[1], c = sp[2], d = sp[3];
    const f32x4 t = (a + b) + (c + d); const float s = (t[0] + t[1]) + (t[2] + t[3]);
    return __builtin_amdgcn_rsqf(s * (1.0f / 1024.0f) + 1e-6f);
}

__device__ __forceinline__ float shx(float v, int lane, int m) { return __int_as_float(__builtin_amdgcn_ds_bpermute((lane ^ m) << 2, __float_as_int(v))); }
__device__ __forceinline__ int lane_now() { int l; asm volatile("v_mbcnt_lo_u32_b32 %0, -1, 0\n\tv_mbcnt_hi_u32_b32 %0, -1, %0" : "=v"(l)); return l; }
namespace pg8 {
constexpr int BM = 256, BK = 64, HALF = 128, HTB = HALF * BK * 2, STAGE_BYTES = 8 * HTB, NXCD = 8, WGM = 8;
__host__ __device__ __forceinline__ int lds_byte(int r, int c) { const int st = (r >> 4) * 2 + (c >> 5), rr = r & 15, cc = c & 31, ob = rr * 64 + cc * 2; return st * 1024 + (ob ^ (((ob >> 9) & 1) << 5)); }
__host__ __device__ __forceinline__ void stage_rc(int b, int& R, int& C) { const int st = b / 1024, sb = b % 1024, swz = sb ^ (((sb >> 9) & 1) << 5); R = (st >> 1) * 16 + swz / 64; C = (st & 1) * 32 + (swz % 64) / 2; }
__host__ __device__ __forceinline__ int perm32(int rho) { const int n = rho >> 4, i = rho & 15; return 8 * (i >> 2) + 4 * n + (i & 3); }
struct Unit { int pm, pn; };
struct Gemm { const bf16_t* A; const bf16_t* Bt; int M, N, K; };
struct StaticOrder {
    int nM, nN, nwg, G, c, rot;
    __device__ void init(int M, int N, int G_, int c_, int rot_ = 0) { nM = M / BM; nN = N / BM; nwg = nM * nN; G = G_; c = c_; rot = rot_; }
    __device__ bool next(int i, Unit& u) const {
        const long L = (long)i * G + c; if (L >= nwg) return false;
        int wgid = (int)L; { const int q = nwg / NXCD, r = nwg % NXCD, xcd = wgid % NXCD, off = wgid / NXCD; wgid = (xcd < r ? xcd * (q + 1) : r * (q + 1) + (xcd - r) * q) + off; }
        const int nig = WGM * nN, gid = wgid / nig, fm = gid * WGM, gsz = (nM - fm) < WGM ? (nM - fm) : WGM;
        u.pm = fm + ((wgid % nig) % gsz); { const int p = (wgid % nig) / gsz + rot; u.pn = p >= nN ? p - nN : p; } return true;
    }
};
template <class Epi>
__device__ __forceinline__ void gemm_phase(const int tid, LAS unsigned char* lds, const Gemm g, const StaticOrder& S, const Epi& E) {
    const int wid = __builtin_amdgcn_readfirstlane(tid >> 6), lane = tid & 63, wr = wid >> 2, wc = wid & 3, fr = lane & 15, fq = lane >> 4;
    const int K = g.K, nt = K / BK;
    unsigned voffA[2], voffB[2];
#pragma unroll
    for (int i = 0; i < 2; ++i) { int R, C; stage_rc(tid * 16 + i * 8192, R, C); const int Rb = Epi::PERM ? ((R & ~31) + perm32(R & 31)) : R;
        voffA[i] = (unsigned)(R * K + C) * 2u; voffB[i] = (unsigned)(Rb * K + C) * 2u; }
    const size_t kstep = (size_t)(BK * 2);
    const size_t hstep = (size_t)HALF * K * 2;
    const size_t tstep = 2 * hstep;
    const unsigned ldsw = (unsigned)wid * 1024u;
    const int aoff = lds_byte(wr * 64 + fr, fq * 8), boff = lds_byte(wc * 32 + fr, fq * 8);
#define PG8_SA(b, h) (((b) * 2 + (h)) * HTB)
#define PG8_SB(b, h) ((4 + (b) * 2 + (h)) * HTB)
#define PG8_STAGE(bufoff, gbase, voff) do { _Pragma("unroll") for (int _i = 0; _i < 2; ++_i) { unsigned _vo = (voff)[_i]; asm volatile("" : "+v"(_vo)); \
        __builtin_amdgcn_global_load_lds((const unsigned*)((const char*)(gbase) + _vo), (LAS unsigned*)(lds + (bufoff) + ldsw + _i * 8192), 16, 0, 0); } } while (0)
#define PG8_LDA(dst, b, h) do { _Pragma("unroll") for (int m = 0; m < 4; ++m) _Pragma("unroll") for (int k = 0; k < 2; ++k) dst[m][k] = *(const LAS bf16x8*)(lds + PG8_SA(b, h) + aoff + m * 2048 + k * 1024); } while (0)
#define PG8_LDB(dst, b, h) do { _Pragma("unroll") for (int n = 0; n < 2; ++n) _Pragma("unroll") for (int k = 0; k < 2; ++k) dst[n][k] = *(const LAS bf16x8*)(lds + PG8_SB(b, h) + boff + n * 2048 + k * 1024); } while (0)
#define PG8_MMA(ai, bj, At, Bt) do { __builtin_amdgcn_s_setprio(1); _Pragma("unroll") for (int m = 0; m < 4; ++m) _Pragma("unroll") for (int n = 0; n < 2; ++n) _Pragma("unroll") for (int k = 0; k < 2; ++k) \
        acc[ai][bj][m][n] = __builtin_amdgcn_mfma_f32_16x16x32_bf16(Bt[n][k], At[m][k], acc[ai][bj][m][n], 0, 0, 0); __builtin_amdgcn_s_setprio(0); } while (0)
#define PG8_WAIT_V(n) asm volatile("s_waitcnt vmcnt(" #n ")" ::: "memory")
#define PG8_WAIT_L(n) asm volatile("s_waitcnt lgkmcnt(" #n ")" ::: "memory")
#define PG8_BAR __builtin_amdgcn_s_barrier()
#define PG8_SCHED __builtin_amdgcn_sched_barrier(0)
    Unit cur, nxt; int ui = 0;
    if (!S.next(0, cur)) return;
    f32x4 acc[2][2][4][2];
#pragma unroll
    for (int a = 0; a < 2; ++a)
#pragma unroll
        for (int b = 0; b < 2; ++b)
#pragma unroll
            for (int m = 0; m < 4; ++m)
#pragma unroll
                for (int n = 0; n < 2; ++n) acc[a][b][m][n] = (f32x4){0.f, 0.f, 0.f, 0.f};
    bf16x8 At[4][2], B0[2][2], B1[2][2];
    const char* cA = (const char*)g.A + (size_t)cur.pm * tstep; const char* cB = (const char*)g.Bt + (size_t)cur.pn * tstep;
    PG8_STAGE(PG8_SB(0, 0), cB, voffB); PG8_STAGE(PG8_SA(0, 0), cA, voffA); PG8_STAGE(PG8_SB(0, 1), cB + hstep, voffB); PG8_STAGE(PG8_SA(0, 1), cA + hstep, voffA);
    if (wr == 1) PG8_BAR;
    PG8_WAIT_V(4); PG8_BAR;
    PG8_STAGE(PG8_SB(1, 0), cB + kstep, voffB); PG8_STAGE(PG8_SA(1, 0), cA + kstep, voffA); PG8_STAGE(PG8_SB(1, 1), cB + hstep + kstep, voffB);
    if constexpr (Epi::PREADD) E.preadd(acc, cur, wr, wc);
    PG8_WAIT_V(6); PG8_BAR;
    for (;;) {
        const bool has_next = S.next(ui + 1, nxt);
        const char* nA = has_next ? (const char*)g.A + (size_t)nxt.pm * tstep : cA; const char* nB = has_next ? (const char*)g.Bt + (size_t)nxt.pn * tstep : cB;
        for (int t = 0; t < nt; t += 2) {
            const bool last = (t == nt - 2);
            const char* a1 = cA + (size_t)(t + 1) * kstep;
            const char* a2 = last ? nA : cA + (size_t)(t + 2) * kstep; const char* b2 = last ? nB : cB + (size_t)(t + 2) * kstep;
            const char* a3 = a2 + kstep; const char* b3 = b2 + kstep;
            PG8_LDB(B0, 0, 0); PG8_SCHED; PG8_LDA(At, 0, 0); PG8_STAGE(PG8_SA(1, 1), a1 + hstep, voffA);
            PG8_WAIT_L(8); PG8_BAR; PG8_WAIT_L(0); PG8_MMA(0, 0, At, B0); PG8_BAR; PG8_SCHED;
            PG8_LDB(B1, 0, 1); PG8_STAGE(PG8_SB(0, 0), b2, voffB);
            PG8_BAR; PG8_WAIT_L(0); PG8_MMA(0, 1, At, B1); PG8_BAR;
            PG8_LDA(At, 0, 1); PG8_STAGE(PG8_SA(0, 0), a2, voffA);
            PG8_BAR; PG8_WAIT_L(0); PG8_MMA(1, 0, At, B0); PG8_BAR; PG8_SCHED;
            PG8_STAGE(PG8_SB(0, 1), b2 + hstep, voffB);
            PG8_WAIT_V(6); PG8_BAR; PG8_MMA(1, 1, At, B1); PG8_BAR;
            PG8_LDB(B0, 1, 0); PG8_SCHED; PG8_LDA(At, 1, 0); PG8_STAGE(PG8_SA(0, 1), a2 + hstep, voffA);
            PG8_WAIT_L(8); PG8_BAR; PG8_WAIT_L(0); PG8_MMA(0, 0, At, B0); PG8_BAR; PG8_SCHED;
            PG8_LDB(B1, 1, 1); PG8_STAGE(PG8_SB(1, 0), b3, voffB);
            PG8_BAR; PG8_WAIT_L(0); PG8_MMA(0, 1, At, B1); PG8_BAR;
            PG8_LDA(At, 1, 1); PG8_STAGE(PG8_SA(1, 0), a3, voffA);
            PG8_BAR; PG8_WAIT_L(0); PG8_MMA(1, 0, At, B0); PG8_BAR; PG8_SCHED;
            PG8_STAGE(PG8_SB(1, 1), b3 + hstep, voffB);
            PG8_WAIT_V(6); PG8_BAR; PG8_MMA(1, 1, At, B1); PG8_BAR;
        }
        E(acc, cur, wr, wc, fr, fq);
        if (!has_next) break;
#pragma unroll
        for (int a = 0; a < 2; ++a)
#pragma unroll
            for (int b = 0; b < 2; ++b)
#pragma unroll
                for (int m = 0; m < 4; ++m)
#pragma unroll
                    for (int n = 0; n < 2; ++n) acc[a][b][m][n] = (f32x4){0.f, 0.f, 0.f, 0.f};
        cur = nxt; cA = nA; cB = nB; ++ui;
        if constexpr (Epi::PREADD) E.preadd(acc, cur, wr, wc);
    }
    PG8_WAIT_V(0);
    if (wr == 0) PG8_BAR;
    PG8_BAR;
#undef PG8_SA
#undef PG8_SB
#undef PG8_STAGE
#undef PG8_LDA
#undef PG8_LDB
#undef PG8_MMA
#undef PG8_WAIT_V
#undef PG8_WAIT_L
#undef PG8_BAR
#undef PG8_SCHED
}
}
using pg8::Unit;

__device__ __forceinline__ void load_rstd8(const float* SS, int row0, int fr, int fq, float (&rstd)[8]) {
    const int ln = fq * 16 + fr;
    f32x4 q[8];
#pragma unroll
    for (int i = 0; i < 8; ++i) q[i] = *(const f32x4*)(SS + (size_t)(row0 + (i >> 2) * 128 + (i & 3) * 16) * 16 + fq * 4);
#pragma unroll
    for (int i = 0; i < 8; ++i) { float s = (q[i][0] + q[i][1]) + (q[i][2] + q[i][3]); s += shx(s, ln, 16); s += shx(s, ln, 32); rstd[i] = __builtin_amdgcn_rsqf(s * (1.0f / 1024.0f) + 1e-6f); }
}

__device__ __forceinline__ void cached_rstd8(LAS unsigned char* lds, const float* SS, int pm, int wave, int row0, int fr, int fq, float (&rs)[8]) {
    LAS float* slot = (LAS float*)(lds + LDS_RS) + (wave * 64 + fq * 16 + fr) * 8;
    LAS int* tag = (LAS int*)(lds + LDS_RSTAG) + wave;
    if (*tag == pm) {
        const f32x4 a = *(const LAS f32x4*)slot, b = *(const LAS f32x4*)(slot + 4);
        rs[0] = a[0]; rs[1] = a[1]; rs[2] = a[2]; rs[3] = a[3]; rs[4] = b[0]; rs[5] = b[1]; rs[6] = b[2]; rs[7] = b[3];
    } else {
        load_rstd8(SS, row0, fr, fq, rs);
        *(LAS f32x4*)slot = (f32x4){rs[0], rs[1], rs[2], rs[3]}; *(LAS f32x4*)(slot + 4) = (f32x4){rs[4], rs[5], rs[6], rs[7]};
        if (fq * 16 + fr == 0) *tag = pm;
    }
}

struct EpiZ {
    static constexpr bool PERM = true, PREADD = false;
    bf16_t* Z; const float* SS; const float* COS; const float* SIN; LAS unsigned char* lds;
    __device__ __forceinline__ void operator()(const f32x4 (&acc)[2][2][4][2], const Unit& u, int wr, int wc, int fr, int fq) const {
        { const int l_ = lane_now(); fr = l_ & 15; fq = l_ >> 4; }
        const int row0 = u.pm * 256 + wr * 64 + fr, pn = u.pn, colw = wc * 32 + 8 * fq;
        float rs[8]; cached_rstd8(lds, SS, u.pm, wr * 4 + wc, row0, fr, fq, rs);
#pragma unroll
        for (int ai = 0; ai < 2; ++ai)
#pragma unroll
            for (int m = 0; m < 4; ++m) {
                const int row = row0 + ai * 128 + m * 16;
                const float rstd = rs[ai * 4 + m];
                bf16_t* rowp = Z + (size_t)row * INW + pn * 256 + colw;
                if (pn >= 2 && pn < 6) {
                    const int i1 = 16 * wc + 4 * fq;
                    const f32x4 cs = *(const f32x4*)(COS + (size_t)row * 64 + i1), sn = *(const f32x4*)(SIN + (size_t)row * 64 + i1);
                    const float sc = rstd * (pn >= 4 ? 0.08838834764831845f : 1.0f);
#pragma unroll
                    for (int bj = 0; bj < 2; ++bj) {
                        const f32x4 x1 = acc[ai][bj][m][0] * sc, x2 = acc[ai][bj][m][1] * sc;
                        const f32x4 o1 = x1 * cs - x2 * sn, o2 = x1 * sn + x2 * cs;
                        *(u32x4*)(rowp + bj * 128) = pack8(o1, o2);
                    }
                } else {
#pragma unroll
                    for (int bj = 0; bj < 2; ++bj) {
                        f32x4 v0 = acc[ai][bj][m][0], v1 = acc[ai][bj][m][1];
                        const float nrl = rstd * -1.4426950408889634f;
                        if (pn >= 14) {
#pragma unroll
                            for (int j = 0; j < 4; ++j) { v0[j] = sigmoid_sc(v0[j], nrl); v1[j] = sigmoid_sc(v1[j], nrl); }
                        } else if (pn >= 10) {
                            { const float ir = __builtin_amdgcn_rcpf(rstd);
#pragma unroll
                            for (int j = 0; j < 4; ++j) { v0[j] = v0[j] * sigmoid_scm(v0[j], nrl, ir); v1[j] = v1[j] * sigmoid_scm(v1[j], nrl, ir); } }
                        } else { v0 = v0 * rstd; v1 = v1 * rstd; }
                        *(u32x4*)(rowp + bj * 128) = pack8(v0, v1);
                    }
                }
            }
    }
};
struct EpiSwiGLU {
    static constexpr bool PERM = true, PREADD = false;
    bf16_t* ACT; const float* SS; LAS unsigned char* lds;
    __device__ __forceinline__ void operator()(const f32x4 (&acc)[2][2][4][2], const Unit& u, int wr, int wc, int fr, int fq) const {
        { const int l_ = lane_now(); fr = l_ & 15; fq = l_ >> 4; }
        const int row0 = u.pm * 256 + wr * 64 + fr, col = u.pn * 128 + wc * 32 + 8 * fq;
        float rs[8]; cached_rstd8(lds, SS, u.pm, wr * 4 + wc, row0, fr, fq, rs);
#pragma unroll
        for (int ai = 0; ai < 2; ++ai)
#pragma unroll
            for (int m = 0; m < 4; ++m) {
                const int row = row0 + ai * 128 + m * 16;
                const float rstd = rs[ai * 4 + m];
                f32x4 o[2];
                const float ir2 = __builtin_amdgcn_rcpf(rstd * rstd), nrl = rstd * -1.4426950408889634f;
#pragma unroll
                for (int n = 0; n < 2; ++n) { const f32x4 gt = acc[ai][0][m][n], up = acc[ai][1][m][n];
#pragma unroll
                    for (int j = 0; j < 4; ++j) o[n][j] = (gt[j] * up[j]) * sigmoid_scm(gt[j], nrl, ir2); }
                *(u32x4*)(ACT + (size_t)row * DFF + col) = pack8(o[0], o[1]);
            }
    }
};
template <int MODE> struct EpiGen {
    static constexpr bool PERM = true, PREADD = false;
    bf16_t* O; const bf16_t* T; const bf16_t* G; const float* SS;
    __device__ __forceinline__ void operator()(const f32x4 (&acc)[2][2][4][2], const Unit& u, int wr, int wc, int fr, int fq) const {
        { const int l_ = lane_now(); fr = l_ & 15; fq = l_ >> 4; }
        const int row0 = u.pm * 256 + wr * 64 + fr, col0 = u.pn * 256 + wc * 32 + 8 * fq;
        if (MODE == 2) {
            float rs[8]; load_rstd8(SS, row0, fr, fq, rs);
#pragma unroll
            for (int rg = 0; rg < 8; ++rg) {
                const int ai = rg >> 2, m = rg & 3, row = row0 + ai * 128 + m * 16; const float rstd = rs[rg];
#pragma unroll
                for (int bj = 0; bj < 2; ++bj) {
                    f32x4 v0 = acc[ai][bj][m][0], v1 = acc[ai][bj][m][1];
#pragma unroll
                    for (int j = 0; j < 4; ++j) { v0[j] = sigmoid_sc(v0[j], rstd * -1.4426950408889634f); v1[j] = sigmoid_sc(v1[j], rstd * -1.4426950408889634f); }
                    *(u32x4*)(O + (size_t)row * DM + col0 + bj * 128) = pack8(v0, v1);
                }
            }
        } else {
            constexpr int NB = (MODE == 1) ? 2 : 1, RGP = 8 / NB;
#pragma unroll
            for (int b = 0; b < NB; ++b) {
                u32x4 gw[RGP][2], tw[RGP][2];
#pragma unroll
                for (int q = 0; q < RGP; ++q)
#pragma unroll
                    for (int bj = 0; bj < 2; ++bj) {
                        const int rg = b * RGP + q, row = row0 + (rg >> 2) * 128 + (rg & 3) * 16, col = col0 + bj * 128;
                        gw[q][bj] = *(const u32x4*)(G + (size_t)row * INW + col);
                        if (MODE == 1) tw[q][bj] = *(const u32x4*)(T + (size_t)row * DM + col);
                    }
#pragma unroll
                for (int q = 0; q < RGP; ++q)
#pragma unroll
                    for (int bj = 0; bj < 2; ++bj) {
                        const int rg = b * RGP + q, ai = rg >> 2, m = rg & 3, row = row0 + ai * 128 + m * 16, col = col0 + bj * 128;
                        f32x4 v0 = acc[ai][bj][m][0] * unpack_lo4(gw[q][bj]), v1 = acc[ai][bj][m][1] * unpack_hi4(gw[q][bj]);
                        if (MODE == 1) { v0 = v0 + unpack_lo4(tw[q][bj]); v1 = v1 + unpack_hi4(tw[q][bj]); }
                        *(u32x4*)(O + (size_t)row * DM + col) = pack8(v0, v1);
                    }
                asm volatile("" ::: "memory");
            }
        }
    }
};
template <bool MUL, bool SRC32> struct EpiResid {
    static constexpr bool PERM = true, PREADD = !MUL;
    __device__ __forceinline__ void preadd(f32x4 (&acc)[2][2][4][2], const Unit& u, int wr, int wc) const {
        const int l_ = lane_now(), fr = l_ & 15, fq = l_ >> 4;
        const int row0 = u.pm * 256 + wr * 64 + fr, col0 = u.pn * 256 + wc * 32 + 8 * fq;
        if (SRC32) {
#pragma unroll
            for (int rg = 0; rg < 8; ++rg)
#pragma unroll
                for (int bj = 0; bj < 2; ++bj) { const float* p = x32 + (size_t)(row0 + (rg >> 2) * 128 + (rg & 3) * 16) * DM + col0 + bj * 128;
                    acc[rg >> 2][bj][rg & 3][0] = *(const f32x4*)p; acc[rg >> 2][bj][rg & 3][1] = *(const f32x4*)(p + 4); }
            return;
        }
        u32x4 xw[8][2];
#pragma unroll
        for (int rg = 0; rg < 8; ++rg)
#pragma unroll
            for (int bj = 0; bj < 2; ++bj) xw[rg][bj] = *(const u32x4*)(xb + (size_t)(row0 + (rg >> 2) * 128 + (rg & 3) * 16) * DM + col0 + bj * 128);
#pragma unroll
        for (int rg = 0; rg < 8; ++rg)
#pragma unroll
            for (int bj = 0; bj < 2; ++bj) { acc[rg >> 2][bj][rg & 3][0] = unpack_lo4(xw[rg][bj]); acc[rg >> 2][bj][rg & 3][1] = unpack_hi4(xw[rg][bj]); }
    }
    const float* x32; const bf16_t* xb; bf16_t* XBo; float* SSo; const bf16_t* T;
    __device__ __forceinline__ void operator()(const f32x4 (&acc)[2][2][4][2], const Unit& u, int wr, int wc, int fr, int fq) const {
        { const int l_ = lane_now(); fr = l_ & 15; fq = l_ >> 4; }
        const int row0 = u.pm * 256 + wr * 64 + fr, col0 = u.pn * 256 + wc * 32 + 8 * fq;
        constexpr int NB = PREADD ? 1 : (SRC32 ? 4 : 2), RG_PER = 8 / NB;
#pragma unroll
        for (int b = 0; b < NB; ++b) {
            f32x4 xr[RG_PER][2][2]; u32x4 xw[RG_PER][2], tw[RG_PER][2];
#pragma unroll
            for (int q = 0; q < RG_PER; ++q)
#pragma unroll
                for (int bj = 0; bj < 2; ++bj) {
                    const int rg = b * RG_PER + q;
                    const size_t off = (size_t)(row0 + (rg >> 2) * 128 + (rg & 3) * 16) * DM + col0 + bj * 128;
                    if (!PREADD) { if (SRC32) { xr[q][bj][0] = *(const f32x4*)(x32 + off); xr[q][bj][1] = *(const f32x4*)(x32 + off + 4); } else xw[q][bj] = *(const u32x4*)(xb + off); }
                    if (MUL) tw[q][bj] = *(const u32x4*)(T + off);
                }
#pragma unroll
            for (int q = 0; q < RG_PER; ++q) {
                const int rg = b * RG_PER + q, ai = rg >> 2, m = rg & 3, row = row0 + ai * 128 + m * 16;
                float ss = 0.f;
#pragma unroll
                for (int bj = 0; bj < 2; ++bj) {
                    const size_t off = (size_t)row * DM + col0 + bj * 128;
                    f32x4 v0 = acc[ai][bj][m][0], v1 = acc[ai][bj][m][1];
                    if (MUL) { v0 = v0 * unpack_lo4(tw[q][bj]); v1 = v1 * unpack_hi4(tw[q][bj]); }
                    if (!PREADD) { if (SRC32) { v0 = v0 + xr[q][bj][0]; v1 = v1 + xr[q][bj][1]; } else { v0 = v0 + unpack_lo4(xw[q][bj]); v1 = v1 + unpack_hi4(xw[q][bj]); } }
                    *(u32x4*)(XBo + off) = pack8(v0, v1);
                    ss += (v0[0] * v0[0] + v0[1] * v0[1]) + (v0[2] * v0[2] + v0[3] * v0[3]) + (v1[0] * v1[0] + v1[1] * v1[1]) + (v1[2] * v1[2] + v1[3] * v1[3]);
                }
                { const int ln = fq * 16 + fr; ss += shx(ss, ln, 16); ss += shx(ss, ln, 32); }
                if (fq == 0) SSo[(size_t)row * 16 + u.pn * 4 + wc] = ss;
            }
            asm volatile("" ::: "memory");
        }
    }
};

struct Params { const float* in[19]; float* out; unsigned char* ws; int ph_lo, ph_hi; };
typedef const __attribute__((address_space(4))) Params* KPtr;
struct Ctx {
    KPtr P; float* out; unsigned char* ws; int wv, bid, G;
    __device__ __forceinline__ int ftid() const { return wv * 64 + lane_now(); }
    __device__ __forceinline__ bf16_t* W(int layer, size_t off) const { return (bf16_t*)(ws + WS_W + (size_t)layer * W_LAYER + off); }
    __device__ __forceinline__ float* COS() const { return (float*)(ws + WS_COS); }
    __device__ __forceinline__ float* SIN() const { return (float*)(ws + WS_SIN); }
    __device__ __forceinline__ bf16_t* XB(int i) const { return (bf16_t*)(ws + WS_XB + (size_t)i * SEQ * DM * 2); }
    __device__ __forceinline__ float* SS(int i) const { return (float*)(ws + WS_SS + (size_t)i * SEQ * 16 * 4); }
    __device__ __forceinline__ bf16_t* Z() const { return (bf16_t*)(ws + WS_Z); }
    __device__ __forceinline__ bf16_t* KV() const { return (bf16_t*)(ws + WS_KV); }
    __device__ __forceinline__ bf16_t* TMP() const { return (bf16_t*)(ws + WS_KV); }
    __device__ __forceinline__ bf16_t* MG() const { return (bf16_t*)(ws + WS_KV + (size_t)SEQ * DM * 2); }
    __device__ __forceinline__ bf16_t* PA() const { return (bf16_t*)(ws + WS_PA); }
    __device__ __forceinline__ bf16_t* RG() const { return (bf16_t*)(ws + WS_RG); }
    __device__ __forceinline__ bf16_t* PB(int layer) const { return (bf16_t*)(ws + WS_PB + (size_t)layer * SEQ * PLE * 2); }
    __device__ __forceinline__ const float* xin(int s) const { return s == 0 ? P->in[0] : P->in[1] + (size_t)(s - 1) * SEQ * DM; }
    __device__ __forceinline__ const float* pin(int s, int layer) const { return s == 0 ? P->in[2] + (size_t)layer * SEQ * PLE : P->in[3] + (size_t)(layer * 2 + (s - 1)) * SEQ * PLE; }
    __device__ __forceinline__ float* xout(int s) const { return out + (size_t)s * SEQ * DM; }
};

__device__ __forceinline__ int dperm(int c) { return ((c >> 2) & 1) * 64 + 16 * (c >> 5) + 4 * ((c >> 3) & 3) + (c & 3); }
struct MatDesc { const float* W; int ldw, K, N; bf16_t* out; const float* gk; const float* gn; int cm; };
__device__ __forceinline__ MatDesc mat_desc(const Ctx& C, int l, int j) {
    switch (j) {
    case 0: return MatDesc{C.P->in[5] + (size_t)l * DM * INW, INW, DM, INW, C.W(l, W_IN), C.P->in[4] + l * DM, nullptr, 1};
    case 1: return MatDesc{C.P->in[9] + (size_t)l * 512 * DM, DM, 512, DM, C.W(l, W_PO), nullptr, nullptr, 0};
    case 2: return MatDesc{C.P->in[10] + (size_t)l * DM * DM, DM, DM, DM, C.W(l, W_RO), nullptr, nullptr, 0};
    case 3: return MatDesc{C.P->in[11] + (size_t)l * DM * DM, DM, DM, DM, C.W(l, W_O), nullptr, nullptr, 0};
    case 4: return MatDesc{C.P->in[13] + (size_t)l * DM * INW, INW, DM, INW, C.W(l, W_FFI), C.P->in[12] + l * DM, nullptr, 2};
    case 5: return MatDesc{C.P->in[14] + (size_t)l * DFF * DM, DM, DFF, DM, C.W(l, W_FFO), nullptr, nullptr, 0};
    case 6: return MatDesc{C.P->in[16] + (size_t)l * DM * DM, DM, DM, DM, C.W(l, W_PG), C.P->in[15] + l * DM, nullptr, 0};
    case 7: return MatDesc{C.P->in[17] + (size_t)l * PLE * DM, DM, PLE, DM, C.W(l, W_PP), nullptr, nullptr, 0};
    default: { const int g = j - 8; return MatDesc{C.P->in[6] + (size_t)(l * 4 + g) * 128 * 128, 128, 128, 128, C.W(l, W_PW) + g * 128 * 128, nullptr, C.P->in[7] + l * 512 + g * 128, 0}; }
    }
}
__device__ __forceinline__ int mat_items(int j) { return (j == 0 || j == 4) ? (DM / 32) * INW : (j == 1) ? (512 / 32) * DM : (j == 5) ? (DFF / 32) * DM : (j == 7) ? (PLE / 32) * DM : (j >= 8) ? (128 / 32) * 128 : (DM / 32) * DM; }
__device__ void conv_range(const Ctx& C, int l, int jlo, int jhi, int w, int nw) {
    int total = 0;
    for (int j = jlo; j < jhi; ++j) total += mat_items(j);
    for (int it0 = w; it0 < total; it0 += nw) {
        int it = it0, j = jlo;
        for (; j < jhi - 1; ++j) { const int cnt = mat_items(j); if (it < cnt) break; it -= cnt; }
        const MatDesc md = mat_desc(C, l, j);
        const int N = md.N, K = md.K, kb = it / N, n = it - kb * N, k0 = kb * 32;
        int src = n;
        if (md.cm == 1) { if (n >= 512 && n < 1536) { const int sec = (n - 512) >> 7, c = (n - 512) & 127; src = 512 + sec * 128 + dperm(c); } }
        if (md.cm == 2) { const int pn = n >> 8, r = n & 255; src = (r < 128) ? (128 * pn + r) : (DFF + 128 * pn + (r - 128)); }
        const float sn = md.gn ? md.gn[n] : 1.0f;
        const float* wp = md.W + (size_t)k0 * md.ldw + src;
        float v[32];
#pragma unroll
        for (int i = 0; i < 32; ++i) v[i] = wp[(size_t)i * md.ldw];
        if (md.gk) {
#pragma unroll
            for (int i = 0; i < 32; i += 4) { const f32x4 g4 = *(const f32x4*)(md.gk + k0 + i); v[i] *= g4[0]; v[i + 1] *= g4[1]; v[i + 2] *= g4[2]; v[i + 3] *= g4[3]; }
        }
        u32x4* op = (u32x4*)(md.out + (size_t)n * K + k0);
#pragma unroll
        for (int i = 0; i < 4; ++i) { u32x4 wv; wv.x = cvt_pk_bf16(v[8 * i] * sn, v[8 * i + 1] * sn); wv.y = cvt_pk_bf16(v[8 * i + 2] * sn, v[8 * i + 3] * sn);
            wv.z = cvt_pk_bf16(v[8 * i + 4] * sn, v[8 * i + 5] * sn); wv.w = cvt_pk_bf16(v[8 * i + 6] * sn, v[8 * i + 7] * sn); op[i] = wv; }
    }
}
__device__ void phase_p0(const Ctx& C, LAS unsigned char* lds) {
    (void)lds;
    {
        const int w = C.bid * 512 + C.ftid(), nw = C.G * 512;
        conv_range(C, 0, 0, 4, w, nw); conv_range(C, 0, 8, 12, w, nw); conv_range(C, 1, 8, 12, w, nw);
        if (C.G != 256) { conv_range(C, 0, 4, 8, w, nw); conv_range(C, 1, 0, 8, w, nw); }
    }
    float* COS = C.COS(); float* SIN = C.SIN();
    for (int e = C.bid * 512 + C.ftid(); e < SEQ * 64; e += C.G * 512) {
        const int pos = e >> 6, i = e & 63;
        double inv = 1.0; for (int k = 0; k < i; ++k) inv *= 0.8659643233600653;
        const double x = (double)pos * inv;
        const double n = rint(x * 0.15915494309189535);
        const double r = fma(-n, 2.4492935982947064e-16, fma(-n, 6.283185307179586, x));
        const double r2 = r * r;
        double s = 1.0, c = 1.0;
#pragma unroll
        for (int k = 17; k >= 1; --k) { s = 1.0 - s * r2 * (1.0 / (double)((2 * k) * (2 * k + 1))); c = 1.0 - c * r2 * (1.0 / (double)((2 * k - 1) * (2 * k))); }
        COS[e] = (float)c; SIN[e] = (float)(s * r);
    }
}
__device__ void phase_rows(const Ctx& C, int s_fin, int s_pre) {
    const int tid0 = C.ftid(), wid = tid0 >> 6, lane = tid0 & 63;
    float* SS0 = C.SS(0); bf16_t* XB0 = C.XB(0);
    for (int row = C.bid * 8 + wid; row < SEQ; row += C.G * 8) {
        if (s_fin >= 0) {
            float* x = C.xout(s_fin) + (size_t)row * DM; const float* gf = C.P->in[18];
            const float rstd = rstd_from_ss(SS0 + (size_t)row * 16);
#pragma unroll
            for (int i = 0; i < 4; ++i) { const int col = lane * 4 + 256 * i; const f32x4 v = unpack4(*(const u32x2*)(XB0 + (size_t)row * DM + col)), g = *(const f32x4*)(gf + col); *(f32x4*)(x + col) = v * rstd * g; }
        }
        if (s_pre >= 0) {
            const float* x = C.xin(s_pre) + (size_t)row * DM; float ss = 0.f;
#pragma unroll
            for (int i = 0; i < 4; ++i) { const int col = lane * 4 + 256 * i; const f32x4 v = *(const f32x4*)(x + col);
                ss += (v[0] * v[0] + v[1] * v[1]) + (v[2] * v[2] + v[3] * v[3]); *(u32x2*)(XB0 + (size_t)row * DM + col) = pack4(v); }
#pragma unroll
            for (int o = 32; o >= 1; o >>= 1) ss += shx(ss, lane, o);
            if (lane < 16) SS0[(size_t)row * 16 + lane] = (lane == 0) ? ss : 0.f;
#pragma unroll
            for (int l = 0; l < 2; ++l) { const f32x4 v = *(const f32x4*)(C.pin(s_pre, l) + (size_t)row * PLE + lane * 4); *(u32x2*)(C.PB(l) + (size_t)row * PLE + lane * 4) = pack4(v); }
        }
    }
}

__device__ __forceinline__ bf16x8 tr_frag(const LAS bf16_t* T, int pitch, int r0, int c0, int fr, int fq) {
#if SLOW_TR
    bf16x8 f;
#pragma unroll
    for (int j = 0; j < 8; ++j) f[j] = (short)T[(r0 + 8 * fq + j) * pitch + c0 + fr];
    return f;
#endif
    const int q = fr >> 2, p = fr & 3;
    const LAS bf16_t* a = T + (r0 + 8 * fq + q) * pitch + c0 + 4 * p;
    const s16x4 lo = __builtin_amdgcn_ds_read_tr16_b64_v4i16((LAS s16x4*)a);
    const s16x4 hi = __builtin_amdgcn_ds_read_tr16_b64_v4i16((LAS s16x4*)(a + 4 * pitch));
    return __builtin_shufflevector(lo, hi, 0, 1, 2, 3, 4, 5, 6, 7);
}
__device__ __forceinline__ bf16x8 tr_frag_cs(const LAS bf16_t* T, int pitch, int r0, int c0, int fr, int fq) {
    const int q = fr >> 2, p = fr & 3;
    const LAS bf16_t* a = T + (r0 + 8 * fq + q) * pitch + c0 + 8 * p;
    const s16x4 lo = __builtin_amdgcn_ds_read_tr16_b64_v4i16((LAS s16x4*)a);
    const s16x4 hi = __builtin_amdgcn_ds_read_tr16_b64_v4i16((LAS s16x4*)(a + 4 * pitch));
    return __builtin_shufflevector(lo, hi, 0, 1, 2, 3, 4, 5, 6, 7);
}
#define MFMA16(a, b, c) __builtin_amdgcn_mfma_f32_16x16x32_bf16((a), (b), (c), 0, 0, 0)

template <int W2> __device__ __forceinline__ void pool_window(const bf16_t* col, int tpos, f32x4& s0, f32x4& s1) {
    u32x4 d[2 * W2];
#pragma unroll
    for (int k = 0; k < 2 * W2; ++k) { const int sp = tpos - W2 + k; const int sc = ((unsigned)sp < (unsigned)SEQ) ? sp : tpos; d[k] = *(const u32x4*)(col + (size_t)sc * INW); }
#pragma unroll
    for (int k = 0; k < 2 * W2; ++k) { const int sp = tpos - W2 + k; const float m = ((unsigned)sp < (unsigned)SEQ) ? 1.0f : 0.0f; s0 = s0 + unpack_lo4(d[k]) * m; s1 = s1 + unpack_hi4(d[k]) * m; }
}
__device__ void phase_a(const Ctx& C, LAS unsigned char* lds, int layer) {
    const int tid = C.ftid(), wid = __builtin_amdgcn_readfirstlane(tid >> 6), lane = tid & 63, fr = lane & 15, fq = lane >> 4;
    LAS bf16_t* Vs = (LAS bf16_t*)lds;
    LAS bf16_t* Kf = Vs + 128 * 264;
    LAS bf16_t* Kb = Kf + 128 * 136;
    const bf16_t* Z = C.Z();
    for (int t = C.bid; t < 1024; t += C.G) {
        __syncthreads();
        if (t < 512) {
            const int c = t >> 2, h = t & 3;
            const float lgf = log2g(C.P->in[8] + layer * 8 + h), lgb = log2g(C.P->in[8] + layer * 8 + 4 + h);
            const bf16_t* zrow = Z + (size_t)(c * 128) * INW;
#pragma unroll
            for (int i = 0; i < 8; ++i) { const int idx = tid + i * 512, r = idx >> 5, v = idx & 31;
                *(LAS u32x4*)(Vs + r * 264 + v * 8) = *(const u32x4*)(zrow + (size_t)r * INW + 1536 + h * 256 + v * 8); }
#pragma unroll
            for (int i = 0; i < 4; ++i) { const int idx = tid + i * 512, r = idx >> 4, v = idx & 15;
                const u32x4 d = *(const u32x4*)(zrow + (size_t)r * INW + 1024 + h * 128 + v * 8);
                const float wf = exp2f(lgf * (float)(127 - r)), wb = exp2f(lgb * (float)r);
                const f32x4 a = unpack_lo4(d), b = unpack_hi4(d);
                *(LAS u32x4*)(Kf + r * 136 + v * 8) = pack8(a * wf, b * wf);
                *(LAS u32x4*)(Kb + r * 136 + v * 8) = pack8(a * wb, b * wb); }
            __syncthreads();
            const int eq = wid & 3, dh = wid >> 2;
            f32x4 acc[2][4][4];
#pragma unroll
            for (int a = 0; a < 2; ++a)
#pragma unroll
                for (int b = 0; b < 4; ++b)
#pragma unroll
                    for (int e4 = 0; e4 < 4; ++e4) acc[a][b][e4] = (f32x4){0.f, 0.f, 0.f, 0.f};
#pragma unroll 1
            for (int kk = 0; kk < 4; ++kk) {
                int fr = lane & 15, fq = lane >> 4; asm volatile("" : "+v"(fr), "+v"(fq));
                bf16x8 vf[4];
#pragma unroll
                for (int et = 0; et < 4; ++et) vf[et] = tr_frag(Vs, 264, 32 * kk, 64 * eq + 16 * et, fr, fq);
#pragma unroll
                for (int dir = 0; dir < 2; ++dir)
#pragma unroll
                    for (int dt = 0; dt < 4; ++dt) {
                        const bf16x8 kf = tr_frag_cs(dir ? Kb : Kf, 136, 32 * kk, 64 * dh + 32 * (dt >> 1) + 4 * (dt & 1), fr, fq);
#pragma unroll
                        for (int et = 0; et < 4; ++et) acc[dir][dt][et] = MFMA16(kf, vf[et], acc[dir][dt][et]);
                    }
            }
            bf16_t* KV = C.KV();
#pragma unroll
            for (int dir = 0; dir < 2; ++dir)
#pragma unroll
                for (int j = 0; j < 2; ++j)
#pragma unroll
                    for (int et = 0; et < 4; ++et) {
                        const int e = 64 * eq + 16 * et + fr, d = 64 * dh + 32 * j + 8 * fq;
                        *(u32x4*)(KV + ((size_t)(((c * 4 + h) * 2 + dir) * 256 + e)) * 128 + d) = pack8(acc[dir][2 * j][et], acc[dir][2 * j + 1][et]);
                    }
        } else {
            const int pt = t - 512, tb = pt >> 2, g = (pt >= 256) ? 3 - (pt & 3) : (pt & 3), w2 = 1 << g;
            LAS bf16_t* Ds = (LAS bf16_t*)lds;
#pragma unroll 1
            for (int i = 0; i < 4; ++i) {
                const int idx = tid + i * 512, r = idx >> 4, v = idx & 15, tpos = tb * 128 + r;
                const int lo = max(tpos - w2, 0), hi = min(tpos + w2, SEQ);
                const bf16_t* col = Z + g * 128 + v * 8;
                f32x4 s0 = (f32x4){0.f, 0.f, 0.f, 0.f}, s1 = s0;
                if (g == 3) pool_window<8>(col, tpos, s0, s1); else if (g == 2) pool_window<4>(col, tpos, s0, s1); else if (g == 1) pool_window<2>(col, tpos, s0, s1); else pool_window<1>(col, tpos, s0, s1);
                const float inv = 1.0f / (float)(hi - lo);
                const u32x4 d = *(const u32x4*)(col + (size_t)tpos * INW);
                *(LAS u32x4*)(Ds + r * 136 + v * 8) = pack8(s0 * inv - unpack_lo4(d), s1 * inv - unpack_hi4(d));
            }
            __syncthreads();
            const bf16_t* PW = C.W(layer, W_PW) + g * 128 * 128;
            f32x4 acc[8];
#pragma unroll
            for (int dt = 0; dt < 8; ++dt) acc[dt] = (f32x4){0.f, 0.f, 0.f, 0.f};
#pragma unroll 1
            for (int kk = 0; kk < 4; ++kk) {
                const bf16x8 df = *(const LAS bf16x8*)(Ds + (16 * wid + fr) * 136 + 32 * kk + 8 * fq);
#pragma unroll
                for (int dt = 0; dt < 8; ++dt) { const bf16x8 wf = *(const bf16x8*)(PW + (16 * dt + fr) * 128 + 32 * kk + 8 * fq); acc[dt] = MFMA16(wf, df, acc[dt]); }
            }
            bf16_t* PA = C.PA();
            const int row = tb * 128 + 16 * wid + fr;
#pragma unroll
            for (int dt = 0; dt < 8; ++dt) *(u32x2*)(PA + (size_t)row * 512 + g * 128 + 16 * dt + 4 * fq) = pack4(acc[dt]);
        }
    }
}
__device__ void phase_b(const Ctx& C, int layer) {
    u32x4* KV = (u32x4*)C.KV();
    const int tid = C.ftid();
    if (tid >= 128) return;
    for (int it = C.bid * 128 + tid; it < 32768; it += C.G * 128) {
        const int idx = it * 8, h = idx >> 16, dir = (idx >> 15) & 1;
        const float cd = exp2f(log2g(C.P->in[8] + layer * 8 + dir * 4 + h) * 128.0f);
        u32x4* base = KV + it;
        f32x4 ra = (f32x4){0.f, 0.f, 0.f, 0.f}, rb = ra;
        const int c0 = dir ? 127 : 0, st = dir ? -1 : 1;
        for (int cc = 0; cc < 128; cc += 8) { u32x4 v[8];
#pragma unroll
            for (int i = 0; i < 8; ++i) v[i] = base[(size_t)(c0 + st * (cc + i)) * 32768];
#pragma unroll
            for (int i = 0; i < 8; ++i) { base[(size_t)(c0 + st * (cc + i)) * 32768] = pack8(ra, rb); ra = ra * cd + unpack_lo4(v[i]); rb = rb * cd + unpack_hi4(v[i]); } }
    }
}
__device__ void phase_c(const Ctx& C, LAS unsigned char* lds, int layer) {
    const int tid0 = C.ftid(), wid = __builtin_amdgcn_readfirstlane(tid0 >> 6), lane = tid0 & 63;
    LAS bf16_t* Qs = (LAS bf16_t*)lds;
    LAS bf16_t* Ps = Qs + 128 * 136;
    LAS bf16_t* Vs = Ps + 128 * 136;
    LAS float* St = (LAS float*)(Vs + 128 * 264);
    const bf16_t* Z = C.Z(); const bf16_t* KV = C.KV(); bf16_t* RG = C.RG();
    for (int t = C.bid; t < 512; t += C.G) {
        const int c = t >> 2, h = t & 3;
        const float lgf = log2g(C.P->in[8] + layer * 8 + h), lgb = log2g(C.P->in[8] + layer * 8 + 4 + h);
        const bf16_t* zrow = Z + (size_t)(c * 128) * INW;
        const int e0 = 32 * wid;
        int fr = lane & 15, fq = lane >> 4;
        asm volatile("" : "+v"(fr), "+v"(fq));
        bf16x8 sf[2][2][4];
#pragma unroll
        for (int dir = 0; dir < 2; ++dir) {
            const bf16_t* sb = KV + (size_t)(((c * 4 + h) * 2 + dir) * 256) * 128;
#pragma unroll
            for (int et = 0; et < 2; ++et)
#pragma unroll
                for (int kk = 0; kk < 4; ++kk) sf[dir][et][kk] = *(const bf16x8*)(sb + (size_t)(e0 + 16 * et + fr) * 128 + 32 * kk + 8 * fq);
        }
        __syncthreads();
        { const int tid = C.ftid();
#pragma unroll
        for (int i = 0; i < 8; ++i) { const int idx = tid + i * 512, r = idx >> 5, v = idx & 31;
            *(LAS u32x4*)(Vs + r * 264 + v * 8) = *(const u32x4*)(zrow + (size_t)r * INW + 1536 + h * 256 + v * 8); }
#pragma unroll
        for (int i = 0; i < 4; ++i) { const int idx = tid + i * 512, r = idx >> 4, v = idx & 15;
            *(LAS u32x4*)(Qs + r * 136 + v * 8) = *(const u32x4*)(zrow + (size_t)r * INW + 512 + h * 128 + v * 8);
            *(LAS u32x4*)(Ps + r * 136 + v * 8) = *(const u32x4*)(zrow + (size_t)r * INW + 1024 + h * 128 + v * 8); }
        }
        __syncthreads();
        asm volatile("" : "+v"(fr), "+v"(fq));
        f32x4 sc[8];
        {
            const int i0 = 16 * wid;
            bf16x8 qf[4];
#pragma unroll
            for (int kk = 0; kk < 4; ++kk) qf[kk] = *(const LAS bf16x8*)(Qs + (i0 + fr) * 136 + 32 * kk + 8 * fq);
#pragma unroll
            for (int jt = 0; jt < 8; ++jt) {
                f32x4 a = (f32x4){0.f, 0.f, 0.f, 0.f};
#pragma unroll
                for (int kk = 0; kk < 4; ++kk) { const bf16x8 kf = *(const LAS bf16x8*)(Ps + (16 * jt + fr) * 136 + 32 * kk + 8 * fq); a = MFMA16(kf, qf[kk], a); }
                const int i = i0 + fr;
#pragma unroll
                for (int r = 0; r < 4; ++r) { const int j = 16 * jt + 4 * fq + r, dl = i - j; a[r] *= (dl >= 0) ? exp2f(lgf * (float)dl) : exp2f(lgb * (float)(-dl)); }
                sc[jt] = a;
            }
        }
        __syncthreads();
        {
            const int i = 16 * wid + fr;
#pragma unroll
            for (int jt = 0; jt < 8; ++jt) *(LAS u32x2*)(Ps + i * 136 + 16 * jt + 4 * fq) = pack4(sc[jt]);
        }
        __syncthreads();
        asm volatile("" : "+v"(fr), "+v"(fq));
        f32x4 y[8][2];
#pragma unroll
        for (int m = 0; m < 8; ++m) { y[m][0] = (f32x4){0.f, 0.f, 0.f, 0.f}; y[m][1] = (f32x4){0.f, 0.f, 0.f, 0.f}; }
#pragma unroll 1
        for (int kk = 0; kk < 4; ++kk) {
            bf16x8 vf[2];
#pragma unroll
            for (int et = 0; et < 2; ++et) vf[et] = tr_frag(Vs, 264, 32 * kk, e0 + 16 * et, fr, fq);
#pragma unroll
            for (int m = 0; m < 8; ++m) { const bf16x8 pf = *(const LAS bf16x8*)(Ps + (16 * m + fr) * 136 + 32 * kk + 8 * fq);
                y[m][0] = MFMA16(vf[0], pf, y[m][0]); y[m][1] = MFMA16(vf[1], pf, y[m][1]); }
        }
#pragma unroll
        for (int dir = 0; dir < 2; ++dir) {
            asm volatile("" : "+v"(fr), "+v"(fq));
#pragma unroll
            for (int m = 0; m < 8; ++m) {
                f32x4 t0 = (f32x4){0.f, 0.f, 0.f, 0.f}, t1 = t0;
#pragma unroll
                for (int kk = 0; kk < 4; ++kk) { const bf16x8 qq = *(const LAS bf16x8*)(Qs + (16 * m + fr) * 136 + 32 * kk + 8 * fq); t0 = MFMA16(sf[dir][0][kk], qq, t0); t1 = MFMA16(sf[dir][1][kk], qq, t1); }
                const int i = 16 * m + fr;
                const float scl = (dir == 0) ? exp2f(lgf * (float)(i + 1)) : exp2f(lgb * (float)(128 - i));
                y[m][0] = y[m][0] + t0 * scl; y[m][1] = y[m][1] + t1 * scl;
                if (m & 1) asm volatile("" ::: "memory");
            }
        }
        asm volatile("" : "+v"(fr), "+v"(fq));
        u32x2 gsw[8][2];
#pragma unroll
        for (int m = 0; m < 8; ++m)
#pragma unroll
            for (int et = 0; et < 2; ++et) gsw[m][et] = *(const u32x2*)(zrow + (size_t)(16 * m + fr) * INW + 2560 + h * 256 + e0 + 16 * et + 4 * fq);
#pragma unroll
        for (int m = 0; m < 8; ++m) {
            const f32x4 a = y[m][0], b = y[m][1];
            float s = (a[0] + a[1]) + (a[2] + a[3]) + (b[0] + b[1]) + (b[2] + b[3]);
            float q = (a[0] * a[0] + a[1] * a[1]) + (a[2] * a[2] + a[3] * a[3]) + (b[0] * b[0] + b[1] * b[1]) + (b[2] * b[2] + b[3] * b[3]);
            { const int ln = fq * 16 + fr; s += shx(s, ln, 16); s += shx(s, ln, 32); q += shx(q, ln, 16); q += shx(q, ln, 32); }
            if (fq == 0) { St[(16 * m + fr) * 16 + wid * 2] = s; St[(16 * m + fr) * 16 + wid * 2 + 1] = q; }
        }
        __syncthreads();
#pragma unroll
        for (int m = 0; m < 8; ++m) {
            const int i = 16 * m + fr;
            const LAS f32x4* sp = (const LAS f32x4*)(St + i * 16);
            const f32x4 p0 = sp[0], p1 = sp[1], p2 = sp[2], p3 = sp[3];
            const float s = (p0[0] + p0[2]) + (p1[0] + p1[2]) + (p2[0] + p2[2]) + (p3[0] + p3[2]);
            const float q = (p0[1] + p0[3]) + (p1[1] + p1[3]) + (p2[1] + p2[3]) + (p3[1] + p3[3]);
            const float mean = s * (1.0f / 256.0f), var = fmaxf(q * (1.0f / 256.0f) - mean * mean, 0.f);
            const float rstd = __builtin_amdgcn_rsqf(var + 1e-5f);
            const size_t row = (size_t)(c * 128 + i);
#pragma unroll
            for (int et = 0; et < 2; ++et) {
                const int e = e0 + 16 * et + 4 * fq;
                *(u32x2*)(RG + row * DM + h * 256 + e) = pack4((y[m][et] - mean) * rstd * unpack4(gsw[m][et]));
            }
        }
    }
}

__device__ __forceinline__ void run_phase(const Ctx& C, LAS unsigned char* lds, int ph) {
    if (ph == 0) { phase_p0(C, lds); phase_rows(C, -1, 0); return; }
    const int q = ph - 1, s = q / 19, r = q % 19;
    if (r == 18) { phase_rows(C, s, s < 2 ? s + 1 : -1); return; }
    const int layer = r / 9, st = r % 9, cur = layer, G = C.G, bid = C.bid;
    pg8::StaticOrder S;
    switch (st) {
    case 0: { pg8::Gemm g{C.XB(cur), C.W(layer, W_IN), SEQ, INW, DM}; S.init(SEQ, INW, G, bid, 2);
              { const int t_ = C.ftid(); if ((t_ & 63) == 0) ((LAS int*)(lds + LDS_RSTAG))[t_ >> 6] = -1; }
              EpiZ E{C.Z(), C.SS(cur), C.COS(), C.SIN(), lds}; pg8::gemm_phase(C.ftid(), lds, g, S, E);
              if (s == 0 && G == 256 && bid >= 128) conv_range(C, layer, 4, 8, (bid - 128) * 512 + C.ftid(), 128 * 512); } break;
    case 1: phase_a(C, lds, layer); break;
    case 2: phase_b(C, layer); break;
    case 3: phase_c(C, lds, layer); break;
    case 4: { S.init(SEQ, DM, G, bid);
              { pg8::Gemm g{C.PA(), C.W(layer, W_PO), SEQ, DM, 512}; EpiGen<0> E{C.TMP(), nullptr, C.Z() + 3584, nullptr}; pg8::gemm_phase(C.ftid(), lds, g, S, E); }
              { pg8::Gemm g{C.RG(), C.W(layer, W_RO), SEQ, DM, DM}; EpiGen<1> E{C.MG(), C.TMP(), C.Z() + 3584 + 1024, nullptr}; pg8::gemm_phase(C.ftid(), lds, g, S, E); } } break;
    case 5: { pg8::Gemm g{C.MG(), C.W(layer, W_O), SEQ, DM, DM}; S.init(SEQ, DM, G, bid);
              if (layer == 0) { EpiResid<false, true> E{C.xin(s), nullptr, C.XB(cur ^ 1), C.SS(cur ^ 1), nullptr}; pg8::gemm_phase(C.ftid(), lds, g, S, E); }
              else { EpiResid<false, false> E{nullptr, C.XB(cur), C.XB(cur ^ 1), C.SS(cur ^ 1), nullptr}; pg8::gemm_phase(C.ftid(), lds, g, S, E); } } break;
    case 6: { pg8::Gemm g{C.XB(cur ^ 1), C.W(layer, W_FFI), SEQ, INW, DM}; S.init(SEQ, INW, G, bid);
              { const int t_ = C.ftid(); if ((t_ & 63) == 0) ((LAS int*)(lds + LDS_RSTAG))[t_ >> 6] = -1; }
              EpiSwiGLU E{C.Z(), C.SS(cur ^ 1), lds}; pg8::gemm_phase(C.ftid(), lds, g, S, E);
              if (s == 0 && layer == 0 && G == 256 && bid >= 128) conv_range(C, 1, 0, 4, (bid - 128) * 512 + C.ftid(), 128 * 512); } break;
    case 7: { pg8::Gemm g{C.Z(), C.W(layer, W_FFO), SEQ, DM, DFF}; S.init(SEQ, DM, G, bid);
              EpiResid<false, false> E{nullptr, C.XB(cur ^ 1), C.XB(cur), C.SS(cur), nullptr}; pg8::gemm_phase(C.ftid(), lds, g, S, E); } break;
    default: { S.init(SEQ, DM, G, bid);
              { pg8::Gemm g{C.XB(cur), C.W(layer, W_PG), SEQ, DM, DM}; EpiGen<2> E{C.TMP(), nullptr, nullptr, C.SS(cur)}; pg8::gemm_phase(C.ftid(), lds, g, S, E); }
              { pg8::Gemm g{C.PB(layer), C.W(layer, W_PP), SEQ, DM, PLE}; EpiResid<true, false> E{nullptr, C.XB(cur), C.XB(cur ^ 1), C.SS(cur ^ 1), C.TMP()}; pg8::gemm_phase(C.ftid(), lds, g, S, E); } } break;
    }
}


#define XB_TMO      128
#define XB_XCNT(j)  (256  + 64 * (j))
#define XB_XSUB(j)  (1280 + 64 * (j))
#define XB_XGEN(j)  (2304 + 64 * (j))
#define XB_TOP      3328
#define XB_TOPGEN   3392
#define XCD_BAR_WORDS 3456
#define XB_SPIN_CAP (1u << 18)
__device__ __forceinline__ unsigned xb_ld(unsigned* p)              { return __hip_atomic_load(p, __ATOMIC_RELAXED, __HIP_MEMORY_SCOPE_AGENT); }
__device__ __forceinline__ unsigned xb_add(unsigned* p, unsigned v) { return __hip_atomic_fetch_add(p, v, __ATOMIC_RELAXED, __HIP_MEMORY_SCOPE_AGENT); }
__device__ __forceinline__ unsigned xb_xcc_id() { return (unsigned)__builtin_amdgcn_s_getreg((3 << 11) | 20) & 0xFu; }
#define XB_SPIN(cond, bar) do { unsigned _sp = 0; while (cond) { __builtin_amdgcn_s_sleep(1); \
    if ((++_sp & 255u) == 0u) { if (xb_ld(&(bar)[XB_TMO])) break; if (_sp > XB_SPIN_CAP) { atomicAdd(&(bar)[XB_TMO], 1u); break; } } } } while (0)
struct XcdBarrier { unsigned* bar; unsigned x; volatile LAS unsigned* st; };
__device__ __forceinline__ XcdBarrier xcd_barrier_post(unsigned* bar, volatile LAS unsigned* st, bool leader) {
    XcdBarrier b; b.bar = bar; b.x = xb_xcc_id(); b.st = st;
    if (leader) (void)xb_add(&bar[XB_XCNT(b.x)], 1u);
    return b;
}
__device__ __forceinline__ void xcd_barrier_complete(unsigned* bar, unsigned x, unsigned& nloc, unsigned& nx) {
    const unsigned G = gridDim.x * gridDim.y * gridDim.z;
    unsigned sum, cnt, mine, sp = 0u;
    for (;;) {
        sum = 0u; cnt = 0u; mine = 0u;
#pragma unroll
        for (unsigned j = 0; j < 16; ++j) { const unsigned c = xb_ld(&bar[XB_XCNT(j)]); sum += c; cnt += (c > 0u) ? 1u : 0u; mine = (j == x) ? c : mine; }
        if (sum == G) break;
        __builtin_amdgcn_s_sleep(1);
        if ((++sp & 255u) == 0u) { if (xb_ld(&bar[XB_TMO])) break; if (sp > XB_SPIN_CAP) { atomicAdd(&bar[XB_TMO], 1u); break; } }
    }
    nloc = mine > 0u ? mine : 1u; nx = cnt > 0u ? cnt : 1u;
}
__device__ __forceinline__ void xcd_barrier(const XcdBarrier& b, int wv) {
    asm volatile("s_waitcnt vmcnt(0)" ::: "memory");
    __syncthreads();
    if (wv == 0 && lane_now() == 0) {
        unsigned* bar = b.bar;
        __builtin_amdgcn_s_waitcnt(0);
        unsigned nloc = b.st[0], nx = b.st[1];
        if (nloc == 0u) { xcd_barrier_complete(bar, b.x, nloc, nx); b.st[0] = nloc; b.st[1] = nx; }
        const unsigned old = xb_add(&bar[XB_XSUB(b.x)], 1u);
        const unsigned gen = old / nloc;
        if (old + 1u == (gen + 1u) * nloc) {
            __builtin_amdgcn_fence(__ATOMIC_RELEASE, "agent");
            asm volatile("s_waitcnt vmcnt(0)" ::: "memory");
            const unsigned og = xb_add(&bar[XB_TOP], 1u);
            const unsigned tg = og / nx;
            if (og + 1u == (tg + 1u) * nx) xb_add(&bar[XB_TOPGEN], 1u);
            else XB_SPIN(xb_ld(&bar[XB_TOPGEN]) == tg, bar);
            __builtin_amdgcn_fence(__ATOMIC_ACQUIRE, "agent");
            xb_add(&bar[XB_XGEN(b.x)], 1u);
            asm volatile("s_waitcnt vmcnt(0)" ::: "memory");
        } else {
            XB_SPIN(xb_ld(&bar[XB_XGEN(b.x)]) == gen, bar);
            __builtin_amdgcn_fence(__ATOMIC_ACQUIRE, "agent");
            asm volatile("s_waitcnt vmcnt(0)" ::: "memory");
        }
    }
    __syncthreads();
}

__global__ void __launch_bounds__(512, 2) mk_fwd(Params P) {
    extern __shared__ __attribute__((aligned(16))) unsigned char lds_raw[];
    LAS unsigned char* lds = (LAS unsigned char*)lds_raw;
    const int wv0 = __builtin_amdgcn_readfirstlane((int)threadIdx.x >> 6);
    const bool leader0 = (threadIdx.x == 0);
    volatile LAS unsigned* bst = (volatile LAS unsigned*)(lds + LDS_BYTES - 16);
    XcdBarrier bar; bar.bar = (unsigned*)(P.ws + WS_END); bar.x = 0; bar.st = bst;
    if (P.ph_hi - P.ph_lo > 1) {
        if (leader0) { bst[0] = 0u; bst[1] = 0u; }
        __syncthreads();
        bar = xcd_barrier_post((unsigned*)(P.ws + WS_END), bst, leader0);
    }
    for (int ph = P.ph_lo; ph < P.ph_hi; ++ph) {
        int wv = wv0, bid = blockIdx.x, G = gridDim.x;
        asm volatile("" : "+s"(wv), "+s"(bid), "+s"(G));
        KPtr pp = (KPtr)__builtin_amdgcn_kernarg_segment_ptr();
        asm volatile("" : "+s"(pp));
        Ctx C{pp, pp->out, pp->ws, wv, bid, G};
        run_phase(C, lds, ph);
#if REP_MASK
        { int cls; if (ph == 0) cls = 10; else { const int r = (ph - 1) % 19; cls = (r == 18) ? 9 : (r % 9); }
          if ((REP_MASK >> cls) & 1) { __syncthreads(); run_phase(C, lds, ph); } }
#endif
        if (ph + 1 < P.ph_hi) { if (ph == P.ph_lo) cg::this_grid().sync(); else xcd_barrier(bar, wv0); }
    }
}

extern "C" void kernel_launch(void* const* d_in, const int* in_sizes, int n_in, void* d_out, int out_size, void* d_ws, size_t ws_size, hipStream_t stream) {
    static int grid = 0;
    if (grid == 0) {
        if (n_in != 19 || ws_size < WS_END + XCD_BAR_WORDS * 4) { fprintf(stderr, "kernel_launch: unexpected n_in %d / ws %zu (need %zu)\n", n_in, ws_size, (size_t)WS_END); grid = -1; return; }
        int dev = 0, cus = 0, per_cu = 0;
        hipGetDevice(&dev); hipDeviceGetAttribute(&cus, hipDeviceAttributeMultiprocessorCount, dev);
        hipFuncSetAttribute((const void*)mk_fwd, hipFuncAttributeMaxDynamicSharedMemorySize, LDS_BYTES);
        hipOccupancyMaxActiveBlocksPerMultiprocessor(&per_cu, (const void*)mk_fwd, 512, LDS_BYTES);
        if (per_cu < 1) per_cu = 1;
        (void)hipGetLastError();
        grid = cus * per_cu;
    }
    if (grid < 0) return;
    if (hipMemsetAsync((char*)d_ws + WS_END, 0, XCD_BAR_WORDS * 4, stream) != hipSuccess) { fprintf(stderr, "kernel_launch: memset of barrier words failed\n"); return; }
    Params p{};
    for (int i = 0; i < 19; ++i) p.in[i] = (const float*)d_in[i];
    p.out = (float*)d_out; p.ws = (unsigned char*)d_ws;
#if MULTI_LAUNCH
    for (int ph = 0; ph < NPH; ++ph) { p.ph_lo = ph; p.ph_hi = ph + 1; hipLaunchKernelGGL(mk_fwd, dim3(grid), dim3(512), LDS_BYTES, stream, p); }
#else
    p.ph_lo = 0; p.ph_hi = NPH;
    void* args[] = {&p};
    hipError_t e = hipLaunchCooperativeKernel((const void*)mk_fwd, dim3(grid), dim3(512), args, LDS_BYTES, stream);
    if (e != hipSuccess) fprintf(stderr, "cooperative launch failed: %s (grid %d)\n", hipGetErrorString(e), grid);
#endif
}
```

```cpp
#include <hip/hip_runtime.h>
#include <hip/hip_cooperative_groups.h>
#include <cstdio>
namespace cg = cooperative_groups;

#ifndef SLOW_TR
#define SLOW_TR 0
#endif
#ifndef REP_MASK
#define REP_MASK 0
#endif
#ifndef MULTI_LAUNCH
#define MULTI_LAUNCH 0
#endif

#define LAS __attribute__((address_space(3)))
typedef unsigned short bf16_t;
typedef short bf16x8 __attribute__((ext_vector_type(8)));
typedef short s16x4 __attribute__((ext_vector_type(4)));
typedef float f32x4 __attribute__((ext_vector_type(4)));
typedef unsigned u32x4 __attribute__((ext_vector_type(4)));
typedef unsigned u32x2 __attribute__((ext_vector_type(2)));

constexpr int SEQ = 16384, DM = 1024, INW = 5632, DFF = 2816, PLE = 256;
constexpr int NPH = 58;
constexpr size_t W_IN = 0, W_PO = W_IN + (size_t)INW * DM * 2, W_RO = W_PO + (size_t)DM * 512 * 2, W_O = W_RO + (size_t)DM * DM * 2,
                 W_FFI = W_O + (size_t)DM * DM * 2, W_FFO = W_FFI + (size_t)INW * DM * 2, W_PG = W_FFO + (size_t)DM * DFF * 2,
                 W_PP = W_PG + (size_t)DM * DM * 2, W_PW = W_PP + (size_t)DM * PLE * 2, W_LAYER = W_PW + (size_t)4 * 128 * 128 * 2;
constexpr size_t WS_W = 0, WS_COS = WS_W + 2 * W_LAYER, WS_SIN = WS_COS + (size_t)SEQ * 64 * 4, WS_XB = WS_SIN + (size_t)SEQ * 64 * 4,
                 WS_SS = WS_XB + 2 * (size_t)SEQ * DM * 2, WS_Z = WS_SS + 2 * (size_t)SEQ * 16 * 4, WS_KV = WS_Z + (size_t)SEQ * INW * 2,
                 WS_PA = WS_KV + (size_t)128 * 4 * 2 * 256 * 128 * 2, WS_RG = WS_PA + (size_t)SEQ * 512 * 2, WS_PB = WS_RG + (size_t)SEQ * DM * 2,
                 WS_END = WS_PB + 2 * (size_t)SEQ * PLE * 2;
constexpr int LDS_BYTES = 147456 + 64;
constexpr int LDS_RS = 131072, LDS_RSTAG = 131072 + 16384;

typedef float f32x2_t __attribute__((ext_vector_type(2)));
typedef __bf16 bf16x2_t __attribute__((ext_vector_type(2)));
__device__ __forceinline__ unsigned cvt_pk_bf16(float lo, float hi) { const f32x2_t v = {lo, hi}; return __builtin_bit_cast(unsigned, __builtin_convertvector(v, bf16x2_t)); }
__device__ __forceinline__ float bf_lo(unsigned u) { return __uint_as_float(u << 16); }
__device__ __forceinline__ float bf_hi(unsigned u) { return __uint_as_float(u & 0xffff0000u); }
__device__ __forceinline__ float sigmoid_f(float x) { return __builtin_amdgcn_rcpf(1.0f + __expf(-x)); }
__device__ __forceinline__ float sigmoid_sc(float v, float nrl) { return __builtin_amdgcn_rcpf(1.0f + __builtin_amdgcn_exp2f(v * nrl)); }
__device__ __forceinline__ float sigmoid_scm(float v, float nrl, float ic) { return __builtin_amdgcn_rcpf(__builtin_fmaf(__builtin_amdgcn_exp2f(v * nrl), ic, ic)); }
__device__ __forceinline__ float silu_f(float x) { return x * sigmoid_f(x); }
__device__ __forceinline__ u32x2 pack4(f32x4 v) { u32x2 w; w.x = cvt_pk_bf16(v[0], v[1]); w.y = cvt_pk_bf16(v[2], v[3]); return w; }
__device__ __forceinline__ u32x4 pack8(f32x4 a, f32x4 b) { u32x4 w; w.x = cvt_pk_bf16(a[0], a[1]); w.y = cvt_pk_bf16(a[2], a[3]); w.z = cvt_pk_bf16(b[0], b[1]); w.w = cvt_pk_bf16(b[2], b[3]); return w; }
__device__ __forceinline__ f32x4 unpack_lo4(u32x4 w) { return (f32x4){bf_lo(w.x), bf_hi(w.x), bf_lo(w.y), bf_hi(w.y)}; }
__device__ __forceinline__ f32x4 unpack_hi4(u32x4 w) { return (f32x4){bf_lo(w.z), bf_hi(w.z), bf_lo(w.w), bf_hi(w.w)}; }
__device__ __forceinline__ f32x4 unpack4(u32x2 w) { return (f32x4){bf_lo(w.x), bf_hi(w.x), bf_lo(w.y), bf_hi(w.y)}; }
__device__ __forceinline__ float log2g(const float* logit) {
    const float x = *logit, u = __expf(-x);
    float l = u * (1.f - u * (0.5f - u * (0.33333334f - u * (0.25f - u * (0.2f - u * 0.16666667f)))));
    if (u > 0.0625f) l = __logf(1.0f + u);
    return -l * 1.4426950408889634f;
}
__device__ __forceinline__ float rstd_from_ss(const float* ss) {
    const f32x4* sp = (const f32x4*)ss; const f32x4 a = sp[0], b = sp[1], c = sp[2], d = sp[3];
    const f32x4 t = (a + b) + (c + d); const float s = (t[0] + t[1]) + (t[2] + t[3]);
    return __builtin_amdgcn_rsqf(s * (1.0f / 1024.0f) + 1e-6f);
}

__device__ __forceinline__ float shx(float v, int lane, int m) { return __int_as_float(__builtin_amdgcn_ds_bpermute((lane ^ m) << 2, __float_as_int(v))); }
__device__ __forceinline__ int lane_now() { int l; asm volatile("v_mbcnt_lo_u32_b32 %0, -1, 0\n\tv_mbcnt_hi_u32_b32 %0, -1, %0" : "=v"(l)); return l; }
namespace pg8 {
constexpr int BM = 256, BK = 64, HALF = 128, HTB = HALF * BK * 2, STAGE_BYTES = 8 * HTB, NXCD = 8, WGM = 8;
__host__ __device__ __forceinline__ int lds_byte(int r, int c) { const int st = (r >> 4) * 2 + (c >> 5), rr = r & 15, cc = c & 31, ob = rr * 64 + cc * 2; return st * 1024 + (ob ^ (((ob >> 9) & 1) << 5)); }
__host__ __device__ __forceinline__ void stage_rc(int b, int& R, int& C) { const int st = b / 1024, sb = b % 1024, swz = sb ^ (((sb >> 9) & 1) << 5); R = (st >> 1) * 16 + swz / 64; C = (st & 1) * 32 + (swz % 64) / 2; }
__host__ __device__ __forceinline__ int perm32(int rho) { const int n = rho >> 4, i = rho & 15; return 8 * (i >> 2) + 4 * n + (i & 3); }
struct Unit { int pm, pn; };
struct Gemm { const bf16_t* A; const bf16_t* Bt; int M, N, K; };
struct StaticOrder {
    int nM, nN, nwg, G, c, rot;
    __device__ void init(int M, int N, int G_, int c_, int rot_ = 0) { nM = M / BM; nN = N / BM; nwg = nM * nN; G = G_; c = c_; rot = rot_; }
    __device__ bool next(int i, Unit& u) const {
        const long L = (long)i * G + c; if (L >= nwg) return false;
        int wgid = (int)L; { const int q = nwg / NXCD, r = nwg % NXCD, xcd = wgid % NXCD, off = wgid / NXCD; wgid = (xcd < r ? xcd * (q + 1) : r * (q + 1) + (xcd - r) * q) + off; }
        const int nig = WGM * nN, gid = wgid / nig, fm = gid * WGM, gsz = (nM - fm) < WGM ? (nM - fm) : WGM;
        u.pm = fm + ((wgid % nig) % gsz); { const int p = (wgid % nig) / gsz + rot; u.pn = p >= nN ? p - nN : p; } return true;
    }
};
template <class Epi>
__device__ __forceinline__ void gemm_phase(const int tid, LAS unsigned char* lds, const Gemm g, const StaticOrder& S, const Epi& E) {
    const int wid = __builtin_amdgcn_readfirstlane(tid >> 6), lane = tid & 63, wr = wid >> 2, wc = wid & 3, fr = lane & 15, fq = lane >> 4;
    const int K = g.K, nt = K / BK;
    unsigned voffA[2], voffB[2];
#pragma unroll
    for (int i = 0; i < 2; ++i) { int R, C; stage_rc(tid * 16 + i * 8192, R, C); const int Rb = Epi::PERM ? ((R & ~31) + perm32(R & 31)) : R;
        voffA[i] = (unsigned)(R * K + C) * 2u; voffB[i] = (unsigned)(Rb * K + C) * 2u; }
    const size_t kstep = (size_t)(BK * 2);
    const size_t hstep = (size_t)HALF * K * 2;
    const size_t tstep = 2 * hstep;
    const unsigned ldsw = (unsigned)wid * 1024u;
    const int aoff = lds_byte(wr * 64 + fr, fq * 8), boff = lds_byte(wc * 32 + fr, fq * 8);
#define PG8_SA(b, h) (((b) * 2 + (h)) * HTB)
#define PG8_SB(b, h) ((4 + (b) * 2 + (h)) * HTB)
#define PG8_STAGE(bufoff, gbase, voff) do { _Pragma("unroll") for (int _i = 0; _i < 2; ++_i) { unsigned _vo = (voff)[_i]; asm volatile("" : "+v"(_vo)); \
        __builtin_amdgcn_global_load_lds((const unsigned*)((const char*)(gbase) + _vo), (LAS unsigned*)(lds + (bufoff) + ldsw + _i * 8192), 16, 0, 0); } } while (0)
#define PG8_LDA(dst, b, h) do { _Pragma("unroll") for (int m = 0; m < 4; ++m) _Pragma("unroll") for (int k = 0; k < 2; ++k) dst[m][k] = *(const LAS bf16x8*)(lds + PG8_SA(b, h) + aoff + m * 2048 + k * 1024); } while (0)
#define PG8_LDB(dst, b, h) do { _Pragma("unroll") for (int n = 0; n < 2; ++n) _Pragma("unroll") for (int k = 0; k < 2; ++k) dst[n][k] = *(const LAS bf16x8*)(lds + PG8_SB(b, h) + boff + n * 2048 + k * 1024); } while (0)
#define PG8_MMA(ai, bj, At, Bt) do { __builtin_amdgcn_s_setprio(1); _Pragma("unroll") for (int m = 0; m < 4; ++m) _Pragma("unroll") for (int n = 0; n < 2; ++n) _Pragma("unroll") for (int k = 0; k < 2; ++k) \
        acc[ai][bj][m][n] = __builtin_amdgcn_mfma_f32_16x16x32_bf16(Bt[n][k], At[m][k], acc[ai][bj][m][n], 0, 0, 0); __builtin_amdgcn_s_setprio(0); } while (0)
#define PG8_WAIT_V(n) asm volatile("s_waitcnt vmcnt(" #n ")" ::: "memory")
#define PG8_WAIT_L(n) asm volatile("s_waitcnt lgkmcnt(" #n ")" ::: "memory")
#define PG8_BAR __builtin_amdgcn_s_barrier()
#define PG8_SCHED __builtin_amdgcn_sched_barrier(0)
    Unit cur, nxt; int ui = 0;
    if (!S.next(0, cur)) return;
    f32x4 acc[2][2][4][2];
#pragma unroll
    for (int a = 0; a < 2; ++a)
#pragma unroll
        for (int b = 0; b < 2; ++b)
#pragma unroll
            for (int m = 0; m < 4; ++m)
#pragma unroll
                for (int n = 0; n < 2; ++n) acc[a][b][m][n] = (f32x4){0.f, 0.f, 0.f, 0.f};
    bf16x8 At[4][2], B0[2][2], B1[2][2];
    const char* cA = (const char*)g.A + (size_t)cur.pm * tstep; const char* cB = (const char*)g.Bt + (size_t)cur.pn * tstep;
    PG8_STAGE(PG8_SB(0, 0), cB, voffB); PG8_STAGE(PG8_SA(0, 0), cA, voffA); PG8_STAGE(PG8_SB(0, 1), cB + hstep, voffB); PG8_STAGE(PG8_SA(0, 1), cA + hstep, voffA);
    if (wr == 1) PG8_BAR;
    PG8_WAIT_V(4); PG8_BAR;
    PG8_STAGE(PG8_SB(1, 0), cB + kstep, voffB); PG8_STAGE(PG8_SA(1, 0), cA + kstep, voffA); PG8_STAGE(PG8_SB(1, 1), cB + hstep + kstep, voffB);
    if constexpr (Epi::PREADD) E.preadd(acc, cur, wr, wc);
    PG8_WAIT_V(6); PG8_BAR;
    for (;;) {
        const bool has_next = S.next(ui + 1, nxt);
        const char* nA = has_next ? (const char*)g.A + (size_t)nxt.pm * tstep : cA; const char* nB = has_next ? (const char*)g.Bt + (size_t)nxt.pn * tstep : cB;
        for (int t = 0; t < nt; t += 2) {
            const bool last = (t == nt - 2);
            const char* a1 = cA + (size_t)(t + 1) * kstep;
            const char* a2 = last ? nA : cA + (size_t)(t + 2) * kstep; const char* b2 = last ? nB : cB + (size_t)(t + 2) * kstep;
            const char* a3 = a2 + kstep; const char* b3 = b2 + kstep;
            PG8_LDB(B0, 0, 0); PG8_SCHED; PG8_LDA(At, 0, 0); PG8_STAGE(PG8_SA(1, 1), a1 + hstep, voffA);
            PG8_WAIT_L(8); PG8_BAR; PG8_WAIT_L(0); PG8_MMA(0, 0, At, B0); PG8_BAR; PG8_SCHED;
            PG8_LDB(B1, 0, 1); PG8_STAGE(PG8_SB(0, 0), b2, voffB);
            PG8_BAR; PG8_WAIT_L(0); PG8_MMA(0, 1, At, B1); PG8_BAR;
            PG8_LDA(At, 0, 1); PG8_STAGE(PG8_SA(0, 0), a2, voffA);
            PG8_BAR; PG8_WAIT_L(0); PG8_MMA(1, 0, At, B0); PG8_BAR; PG8_SCHED;
            PG8_STAGE(PG8_SB(0, 1), b2 + hstep, voffB);
            PG8_WAIT_V(6); PG8_BAR; PG8_MMA(1, 1, At, B1); PG8_BAR;
            PG8_LDB(B0, 1, 0); PG8_SCHED; PG8_LDA(At, 1, 0); PG8_STAGE(PG8_SA(0, 1), a2 + hstep, voffA);
            PG8_WAIT_L(8); PG8_BAR; PG8_WAIT_L(0); PG8_MMA(0, 0, At, B0); PG8_BAR; PG8_SCHED;
            PG8_LDB(B1, 1, 1); PG8_STAGE(PG8_SB(1, 0), b3, voffB);
            PG8_BAR; PG8_WAIT_L(0); PG8_MMA(0, 1, At, B1); PG8_BAR;
            PG8_LDA(At, 1, 1); PG8_STAGE(PG8_SA(1, 0), a3, voffA);
            PG8_BAR; PG8_WAIT_L(0); PG8_MMA(1, 0, At, B0); PG8_BAR; PG8_SCHED;
            PG8_STAGE(PG8_SB(1, 1), b3 + hstep, voffB);
            PG8_WAIT_V(6); PG8_BAR; PG8_MMA(1, 1, At, B1); PG8_BAR;
        }
        E(acc, cur, wr, wc, fr, fq);
        if (!has_next) break;
#pragma unroll
        for (int a = 0; a < 2; ++a)
#pragma unroll
            for (int b = 0; b < 2; ++b)
#pragma unroll
                for (int m = 0; m < 4; ++m)
#pragma unroll
                    for (int n = 0; n < 2; ++n) acc[a][b][m][n] = (f32x4){0.f, 0.f, 0.f, 0.f};
        cur = nxt; cA = nA; cB = nB; ++ui;
        if constexpr (Epi::PREADD) E.preadd(acc, cur, wr, wc);
    }
    PG8_WAIT_V(0);
    if (wr == 0) PG8_BAR;
    PG8_BAR;
#undef PG8_SA
#undef PG8_SB
#undef PG8_STAGE
#undef PG8_LDA
#undef PG8_LDB
#undef PG8_MMA
#undef PG8_WAIT_V
#undef PG8_WAIT_L
#undef PG8_BAR
#undef PG8_SCHED
}
}
using pg8::Unit;

__device__ __forceinline__ void load_rstd8(const float* SS, int row0, int fr, int fq, float (&rstd)[8]) {
    const int ln = fq * 16 + fr;
    f32x4 q[8];
#pragma unroll
    for (int i = 0; i < 8; ++i) q[i] = *(const f32x4*)(SS + (size_t)(row0 + (i >> 2) * 128 + (i & 3) * 16) * 16 + fq * 4);
#pragma unroll
    for (int i = 0; i < 8; ++i) { float s = (q[i][0] + q[i][1]) + (q[i][2] + q[i][3]); s += shx(s, ln, 16); s += shx(s, ln, 32); rstd[i] = __builtin_amdgcn_rsqf(s * (1.0f / 1024.0f) + 1e-6f); }
}

__device__ __forceinline__ void cached_rstd8(LAS unsigned char* lds, const float* SS, int pm, int wave, int row0, int fr, int fq, float (&rs)[8]) {
    LAS float* slot = (LAS float*)(lds + LDS_RS) + (wave * 64 + fq * 16 + fr) * 8;
    LAS int* tag = (LAS int*)(lds + LDS_RSTAG) + wave;
    if (*tag == pm) {
        const f32x4 a = *(const LAS f32x4*)slot, b = *(const LAS f32x4*)(slot + 4);
        rs[0] = a[0]; rs[1] = a[1]; rs[2] = a[2]; rs[3] = a[3]; rs[4] = b[0]; rs[5] = b[1]; rs[6] = b[2]; rs[7] = b[3];
    } else {
        load_rstd8(SS, row0, fr, fq, rs);
        *(LAS f32x4*)slot = (f32x4){rs[0], rs[1], rs[2], rs[3]}; *(LAS f32x4*)(slot + 4) = (f32x4){rs[4], rs[5], rs[6], rs[7]};
        if (fq * 16 + fr == 0) *tag = pm;
    }
}

struct EpiZ {
    static constexpr bool PERM = true, PREADD = false;
    bf16_t* Z; const float* SS; const float* COS; const float* SIN; LAS unsigned char* lds;
    __device__ __forceinline__ void operator()(const f32x4 (&acc)[2][2][4][2], const Unit& u, int wr, int wc, int fr, int fq) const {
        { const int l_ = lane_now(); fr = l_ & 15; fq = l_ >> 4; }
        const int row0 = u.pm * 256 + wr * 64 + fr, pn = u.pn, colw = wc * 32 + 8 * fq;
        float rs[8]; cached_rstd8(lds, SS, u.pm, wr * 4 + wc, row0, fr, fq, rs);
#pragma unroll
        for (int ai = 0; ai < 2; ++ai)
#pragma unroll
            for (int m = 0; m < 4; ++m) {
                const int row = row0 + ai * 128 + m * 16;
                const float rstd = rs[ai * 4 + m];
                bf16_t* rowp = Z + (size_t)row * INW + pn * 256 + colw;
                if (pn >= 2 && pn < 6) {
                    const int i1 = 16 * wc + 4 * fq;
                    const f32x4 cs = *(const f32x4*)(COS + (size_t)row * 64 + i1), sn = *(const f32x4*)(SIN + (size_t)row * 64 + i1);
                    const float sc = rstd * (pn >= 4 ? 0.08838834764831845f : 1.0f);
#pragma unroll
                    for (int bj = 0; bj < 2; ++bj) {
                        const f32x4 x1 = acc[ai][bj][m][0] * sc, x2 = acc[ai][bj][m][1] * sc;
                        const f32x4 o1 = x1 * cs - x2 * sn, o2 = x1 * sn + x2 * cs;
                        *(u32x4*)(rowp + bj * 128) = pack8(o1, o2);
                    }
                } else {
#pragma unroll
                    for (int bj = 0; bj < 2; ++bj) {
                        f32x4 v0 = acc[ai][bj][m][0], v1 = acc[ai][bj][m][1];
                        const float nrl = rstd * -1.4426950408889634f;
                        if (pn >= 14) {
#pragma unroll
                            for (int j = 0; j < 4; ++j) { v0[j] = sigmoid_sc(v0[j], nrl); v1[j] = sigmoid_sc(v1[j], nrl); }
                        } else if (pn >= 10) {
                            { const float ir = __builtin_amdgcn_rcpf(rstd);
#pragma unroll
                            for (int j = 0; j < 4; ++j) { v0[j] = v0[j] * sigmoid_scm(v0[j], nrl, ir); v1[j] = v1[j] * sigmoid_scm(v1[j], nrl, ir); } }
                        } else { v0 = v0 * rstd; v1 = v1 * rstd; }
                        *(u32x4*)(rowp + bj * 128) = pack8(v0, v1);
                    }
                }
            }
    }
};
struct EpiSwiGLU {
    static constexpr bool PERM = true, PREADD = false;
    bf16_t* ACT; const float* SS; LAS unsigned char* lds;
    __device__ __forceinline__ void operator()(const f32x4 (&acc)[2][2][4][2], const Unit& u, int wr, int wc, int fr, int fq) const {
        { const int l_ = lane_now(); fr = l_ & 15; fq = l_ >> 4; }
        const int row0 = u.pm * 256 + wr * 64 + fr, col = u.pn * 128 + wc * 32 + 8 * fq;
        float rs[8]; cached_rstd8(lds, SS, u.pm, wr * 4 + wc, row0, fr, fq, rs);
#pragma unroll
        for (int ai = 0; ai < 2; ++ai)
#pragma unroll
            for (int m = 0; m < 4; ++m) {
                const int row = row0 + ai * 128 + m * 16;
                const float rstd = rs[ai * 4 + m];
                f32x4 o[2];
                const float ir2 = __builtin_amdgcn_rcpf(rstd * rstd), nrl = rstd * -1.4426950408889634f;
#pragma unroll
                for (int n = 0; n < 2; ++n) { const f32x4 gt = acc[ai][0][m][n], up = acc[ai][1][m][n];
#pragma unroll
                    for (int j = 0; j < 4; ++j) o[n][j] = (gt[j] * up[j]) * sigmoid_scm(gt[j], nrl, ir2); }
                *(u32x4*)(ACT + (size_t)row * DFF + col) = pack8(o[0], o[1]);
            }
    }
};
template <int MODE> struct EpiGen {
    static constexpr bool PERM = true, PREADD = false;
    bf16_t* O; const bf16_t* T; const bf16_t* G; const float* SS;
    __device__ __forceinline__ void operator()(const f32x4 (&acc)[2][2][4][2], const Unit& u, int wr, int wc, int fr, int fq) const {
        { const int l_ = lane_now(); fr = l_ & 15; fq = l_ >> 4; }
        const int row0 = u.pm * 256 + wr * 64 + fr, col0 = u.pn * 256 + wc * 32 + 8 * fq;
        if (MODE == 2) {
            float rs[8]; load_rstd8(SS, row0, fr, fq, rs);
#pragma unroll
            for (int rg = 0; rg < 8; ++rg) {
                const int ai = rg >> 2, m = rg & 3, row = row0 + ai * 128 + m * 16; const float rstd = rs[rg];
#pragma unroll
                for (int bj = 0; bj < 2; ++bj) {
                    f32x4 v0 = acc[ai][bj][m][0], v1 = acc[ai][bj][m][1];
#pragma unroll
                    for (int j = 0; j < 4; ++j) { v0[j] = sigmoid_sc(v0[j], rstd * -1.4426950408889634f); v1[j] = sigmoid_sc(v1[j], rstd * -1.4426950408889634f); }
                    *(u32x4*)(O + (size_t)row * DM + col0 + bj * 128) = pack8(v0, v1);
                }
            }
        } else {
            constexpr int NB = (MODE == 1) ? 2 : 1, RGP = 8 / NB;
#pragma unroll
            for (int b = 0; b < NB; ++b) {
                u32x4 gw[RGP][2], tw[RGP][2];
#pragma unroll
                for (int q = 0; q < RGP; ++q)
#pragma unroll
                    for (int bj = 0; bj < 2; ++bj) {
                        const int rg = b * RGP + q, row = row0 + (rg >> 2) * 128 + (rg & 3) * 16, col = col0 + bj * 128;
                        gw[q][bj] = *(const u32x4*)(G + (size_t)row * INW + col);
                        if (MODE == 1) tw[q][bj] = *(const u32x4*)(T + (size_t)row * DM + col);
                    }
#pragma unroll
                for (int q = 0; q < RGP; ++q)
#pragma unroll
                    for (int bj = 0; bj < 2; ++bj) {
                        const int rg = b * RGP + q, ai = rg >> 2, m = rg & 3, row = row0 + ai * 128 + m * 16, col = col0 + bj * 128;
                        f32x4 v0 = acc[ai][bj][m][0] * unpack_lo4(gw[q][bj]), v1 = acc[ai][bj][m][1] * unpack_hi4(gw[q][bj]);
                        if (MODE == 1) { v0 = v0 + unpack_lo4(tw[q][bj]); v1 = v1 + unpack_hi4(tw[q][bj]); }
                        *(u32x4*)(O + (size_t)row * DM + col) = pack8(v0, v1);
                    }
                asm volatile("" ::: "memory");
            }
        }
    }
};
template <bool MUL, bool SRC32> struct EpiResid {
    static constexpr bool PERM = true, PREADD = !MUL;
    __device__ __forceinline__ void preadd(f32x4 (&acc)[2][2][4][2], const Unit& u, int wr, int wc) const {
        const int l_ = lane_now(), fr = l_ & 15, fq = l_ >> 4;
        const int row0 = u.pm * 256 + wr * 64 + fr, col0 = u.pn * 256 + wc * 32 + 8 * fq;
        if (SRC32) {
#pragma unroll
            for (int rg = 0; rg < 8; ++rg)
#pragma unroll
                for (int bj = 0; bj < 2; ++bj) { const float* p = x32 + (size_t)(row0 + (rg >> 2) * 128 + (rg & 3) * 16) * DM + col0 + bj * 128;
                    acc[rg >> 2][bj][rg & 3][0] = *(const f32x4*)p; acc[rg >> 2][bj][rg & 3][1] = *(const f32x4*)(p + 4); }
            return;
        }
        u32x4 xw[8][2];
#pragma unroll
        for (int rg = 0; rg < 8; ++rg)
#pragma unroll
            for (int bj = 0; bj < 2; ++bj) xw[rg][bj] = *(const u32x4*)(xb + (size_t)(row0 + (rg >> 2) * 128 + (rg & 3) * 16) * DM + col0 + bj * 128);
#pragma unroll
        for (int rg = 0; rg < 8; ++rg)
#pragma unroll
            for (int bj = 0; bj < 2; ++bj) { acc[rg >> 2][bj][rg & 3][0] = unpack_lo4(xw[rg][bj]); acc[rg >> 2][bj][rg & 3][1] = unpack_hi4(xw[rg][bj]); }
    }
    const float* x32; const bf16_t* xb; bf16_t* XBo; float* SSo; const bf16_t* T;
    __device__ __forceinline__ void operator()(const f32x4 (&acc)[2][2][4][2], const Unit& u, int wr, int wc, int fr, int fq) const {
        { const int l_ = lane_now(); fr = l_ & 15; fq = l_ >> 4; }
        const int row0 = u.pm * 256 + wr * 64 + fr, col0 = u.pn * 256 + wc * 32 + 8 * fq;
        constexpr int NB = PREADD ? 1 : (SRC32 ? 4 : 2), RG_PER = 8 / NB;
#pragma unroll
        for (int b = 0; b < NB; ++b) {
            f32x4 xr[RG_PER][2][2]; u32x4 xw[RG_PER][2], tw[RG_PER][2];
#pragma unroll
            for (int q = 0; q < RG_PER; ++q)
#pragma unroll
                for (int bj = 0; bj < 2; ++bj) {
                    const int rg = b * RG_PER + q;
                    const size_t off = (size_t)(row0 + (rg >> 2) * 128 + (rg & 3) * 16) * DM + col0 + bj * 128;
                    if (!PREADD) { if (SRC32) { xr[q][bj][0] = *(const f32x4*)(x32 + off); xr[q][bj][1] = *(const f32x4*)(x32 + off + 4); } else xw[q][bj] = *(const u32x4*)(xb + off); }
                    if (MUL) tw[q][bj] = *(const u32x4*)(T + off);
                }
#pragma unroll
            for (int q = 0; q < RG_PER; ++q) {
                const int rg = b * RG_PER + q, ai = rg >> 2, m = rg & 3, row = row0 + ai * 128 + m * 16;
                float ss = 0.f;
#pragma unroll
                for (int bj = 0; bj < 2; ++bj) {
                    const size_t off = (size_t)row * DM + col0 + bj * 128;
                    f32x4 v0 = acc[ai][bj][m][0], v1 = acc[ai][bj][m][1];
                    if (MUL) { v0 = v0 * unpack_lo4(tw[q][bj]); v1 = v1 * unpack_hi4(tw[q][bj]); }
                    if (!PREADD) { if (SRC32) { v0 = v0 + xr[q][bj][0]; v1 = v1 + xr[q][bj][1]; } else { v0 = v0 + unpack_lo4(xw[q][bj]); v1 = v1 + unpack_hi4(xw[q][bj]); } }
                    *(u32x4*)(XBo + off) = pack8(v0, v1);
                    ss += (v0[0] * v0[0] + v0[1] * v0[1]) + (v0[2] * v0[2] + v0[3] * v0[3]) + (v1[0] * v1[0] + v1[1] * v1[1]) + (v1[2] * v1[2] + v1[3] * v1[3]);
                }
                { const int ln = fq * 16 + fr; ss += shx(ss, ln, 16); ss += shx(ss, ln, 32); }
                if (fq == 0) SSo[(size_t)row * 16 + u.pn * 4 + wc] = ss;
            }
            asm volatile("" ::: "memory");
        }
    }
};

struct Params { const float* in[19]; float* out; unsigned char* ws; int ph_lo, ph_hi; };
typedef const __attribute__((address_space(4))) Params* KPtr;
struct Ctx {
    KPtr P; float* out; unsigned char* ws; int wv, bid, G;
    __device__ __forceinline__ int ftid() const { return wv * 64 + lane_now(); }
    __device__ __forceinline__ bf16_t* W(int layer, size_t off) const { return (bf16_t*)(ws + WS_W + (size_t)layer * W_LAYER + off); }
    __device__ __forceinline__ float* COS() const { return (float*)(ws + WS_COS); }
    __device__ __forceinline__ float* SIN() const { return (float*)(ws + WS_SIN); }
    __device__ __forceinline__ bf16_t* XB(int i) const { return (bf16_t*)(ws + WS_XB + (size_t)i * SEQ * DM * 2); }
    __device__ __forceinline__ float* SS(int i) const { return (float*)(ws + WS_SS + (size_t)i * SEQ * 16 * 4); }
    __device__ __forceinline__ bf16_t* Z() const { return (bf16_t*)(ws + WS_Z); }
    __device__ __forceinline__ bf16_t* KV() const { return (bf16_t*)(ws + WS_KV); }
    __device__ __forceinline__ bf16_t* TMP() const { return (bf16_t*)(ws + WS_KV); }
    __device__ __forceinline__ bf16_t* MG() const { return (bf16_t*)(ws + WS_KV + (size_t)SEQ * DM * 2); }
    __device__ __forceinline__ bf16_t* PA() const { return (bf16_t*)(ws + WS_PA); }
    __device__ __forceinline__ bf16_t* RG() const { return (bf16_t*)(ws + WS_RG); }
    __device__ __forceinline__ bf16_t* PB(int layer) const { return (bf16_t*)(ws + WS_PB + (size_t)layer * SEQ * PLE * 2); }
    __device__ __forceinline__ const float* xin(int s) const { return s == 0 ? P->in[0] : P->in[1] + (size_t)(s - 1) * SEQ * DM; }
    __device__ __forceinline__ const float* pin(int s, int layer) const { return s == 0 ? P->in[2] + (size_t)layer * SEQ * PLE : P->in[3] + (size_t)(layer * 2 + (s - 1)) * SEQ * PLE; }
    __device__ __forceinline__ float* xout(int s) const { return out + (size_t)s * SEQ * DM; }
};

__device__ __forceinline__ int dperm(int c) { return ((c >> 2) & 1) * 64 + 16 * (c >> 5) + 4 * ((c >> 3) & 3) + (c & 3); }
struct MatDesc { const float* W; int ldw, K, N; bf16_t* out; const float* gk; const float* gn; int cm; };
__device__ __forceinline__ MatDesc mat_desc(const Ctx& C, int l, int j) {
    switch (j) {
    case 0: return MatDesc{C.P->in[5] + (size_t)l * DM * INW, INW, DM, INW, C.W(l, W_IN), C.P->in[4] + l * DM, nullptr, 1};
    case 1: return MatDesc{C.P->in[9] + (size_t)l * 512 * DM, DM, 512, DM, C.W(l, W_PO), nullptr, nullptr, 0};
    case 2: return MatDesc{C.P->in[10] + (size_t)l * DM * DM, DM, DM, DM, C.W(l, W_RO), nullptr, nullptr, 0};
    case 3: return MatDesc{C.P->in[11] + (size_t)l * DM * DM, DM, DM, DM, C.W(l, W_O), nullptr, nullptr, 0};
    case 4: return MatDesc{C.P->in[13] + (size_t)l * DM * INW, INW, DM, INW, C.W(l, W_FFI), C.P->in[12] + l * DM, nullptr, 2};
    case 5: return MatDesc{C.P->in[14] + (size_t)l * DFF * DM, DM, DFF, DM, C.W(l, W_FFO), nullptr, nullptr, 0};
    case 6: return MatDesc{C.P->in[16] + (size_t)l * DM * DM, DM, DM, DM, C.W(l, W_PG), C.P->in[15] + l * DM, nullptr, 0};
    case 7: return MatDesc{C.P->in[17] + (size_t)l * PLE * DM, DM, PLE, DM, C.W(l, W_PP), nullptr, nullptr, 0};
    default: { const int g = j - 8; return MatDesc{C.P->in[6] + (size_t)(l * 4 + g) * 128 * 128, 128, 128, 128, C.W(l, W_PW) + g * 128 * 128, nullptr, C.P->in[7] + l * 512 + g * 128, 0}; }
    }
}
__device__ __forceinline__ int mat_items(int j) { return (j == 0 || j == 4) ? (DM / 32) * INW : (j == 1) ? (512 / 32) * DM : (j == 5) ? (DFF / 32) * DM : (j == 7) ? (PLE / 32) * DM : (j >= 8) ? (128 / 32) * 128 : (DM / 32) * DM; }
__device__ void conv_range(const Ctx& C, int l, int jlo, int jhi, int w, int nw) {
    int total = 0;
    for (int j = jlo; j < jhi; ++j) total += mat_items(j);
    for (int it0 = w; it0 < total; it0 += nw) {
        int it = it0, j = jlo;
        for (; j < jhi - 1; ++j) { const int cnt = mat_items(j); if (it < cnt) break; it -= cnt; }
        const MatDesc md = mat_desc(C, l, j);
        const int N = md.N, K = md.K, kb = it / N, n = it - kb * N, k0 = kb * 32;
        int src = n;
        if (md.cm == 1) { if (n >= 512 && n < 1536) { const int sec = (n - 512) >> 7, c = (n - 512) & 127; src = 512 + sec * 128 + dperm(c); } }
        if (md.cm == 2) { const int pn = n >> 8, r = n & 255; src = (r < 128) ? (128 * pn + r) : (DFF + 128 * pn + (r - 128)); }
        const float sn = md.gn ? md.gn[n] : 1.0f;
        const float* wp = md.W + (size_t)k0 * md.ldw + src;
        float v[32];
#pragma unroll
        for (int i = 0; i < 32; ++i) v[i] = wp[(size_t)i * md.ldw];
        if (md.gk) {
#pragma unroll
            for (int i = 0; i < 32; i += 4) { const f32x4 g4 = *(const f32x4*)(md.gk + k0 + i); v[i] *= g4[0]; v[i + 1] *= g4[1]; v[i + 2] *= g4[2]; v[i + 3] *= g4[3]; }
        }
        u32x4* op = (u32x4*)(md.out + (size_t)n * K + k0);
#pragma unroll
        for (int i = 0; i < 4; ++i) { u32x4 wv; wv.x = cvt_pk_bf16(v[8 * i] * sn, v[8 * i + 1] * sn); wv.y = cvt_pk_bf16(v[8 * i + 2] * sn, v[8 * i + 3] * sn);
            wv.z = cvt_pk_bf16(v[8 * i + 4] * sn, v[8 * i + 5] * sn); wv.w = cvt_pk_bf16(v[8 * i + 6] * sn, v[8 * i + 7] * sn); op[i] = wv; }
    }
}
__device__ void phase_p0(const Ctx& C, LAS unsigned char* lds) {
    (void)lds;
    {
        const int w = C.bid * 512 + C.ftid(), nw = C.G * 512;
        conv_range(C, 0, 0, 4, w, nw); conv_range(C, 0, 8, 12, w, nw); conv_range(C, 1, 8, 12, w, nw);
        if (C.G != 256) { conv_range(C, 0, 4, 8, w, nw); conv_range(C, 1, 0, 8, w, nw); }
    }
    float* COS = C.COS(); float* SIN = C.SIN();
    for (int e = C.bid * 512 + C.ftid(); e < SEQ * 64; e += C.G * 512) {
        const int pos = e >> 6, i = e & 63;
        double inv = 1.0; for (int k = 0; k < i; ++k) inv *= 0.8659643233600653;
        const double x = (double)pos * inv;
        const double n = rint(x * 0.15915494309189535);
        const double r = fma(-n, 2.4492935982947064e-16, fma(-n, 6.283185307179586, x));
        const double r2 = r * r;
        double s = 1.0, c = 1.0;
#pragma unroll
        for (int k = 17; k >= 1; --k) { s = 1.0 - s * r2 * (1.0 / (double)((2 * k) * (2 * k + 1))); c = 1.0 - c * r2 * (1.0 / (double)((2 * k - 1) * (2 * k))); }
        COS[e] = (float)c; SIN[e] = (float)(s * r);
    }
}
__device__ void phase_rows(const Ctx& C, int s_fin, int s_pre) {
    const int tid0 = C.ftid(), wid = tid0 >> 6, lane = tid0 & 63;
    float* SS0 = C.SS(0); bf16_t* XB0 = C.XB(0);
    for (int row = C.bid * 8 + wid; row < SEQ; row += C.G * 8) {
        if (s_fin >= 0) {
            float* x = C.xout(s_fin) + (size_t)row * DM; const float* gf = C.P->in[18];
            const float rstd = rstd_from_ss(SS0 + (size_t)row * 16);
#pragma unroll
            for (int i = 0; i < 4; ++i) { const int col = lane * 4 + 256 * i; const f32x4 v = unpack4(*(const u32x2*)(XB0 + (size_t)row * DM + col)), g = *(const f32x4*)(gf + col); *(f32x4*)(x + col) = v * rstd * g; }
        }
        if (s_pre >= 0) {
            const float* x = C.xin(s_pre) + (size_t)row * DM; float ss = 0.f;
#pragma unroll
            for (int i = 0; i < 4; ++i) { const int col = lane * 4 + 256 * i; const f32x4 v = *(const f32x4*)(x + col);
                ss += (v[0] * v[0] + v[1] * v[1]) + (v[2] * v[2] + v[3] * v[3]); *(u32x2*)(XB0 + (size_t)row * DM + col) = pack4(v); }
#pragma unroll
            for (int o = 32; o >= 1; o >>= 1) ss += shx(ss, lane, o);
            if (lane < 16) SS0[(size_t)row * 16 + lane] = (lane == 0) ? ss : 0.f;
#pragma unroll
            for (int l = 0; l < 2; ++l) { const f32x4 v = *(const f32x4*)(C.pin(s_pre, l) + (size_t)row * PLE + lane * 4); *(u32x2*)(C.PB(l) + (size_t)row * PLE + lane * 4) = pack4(v); }
        }
    }
}

__device__ __forceinline__ bf16x8 tr_frag(const LAS bf16_t* T, int pitch, int r0, int c0, int fr, int fq) {
#if SLOW_TR
    bf16x8 f;
#pragma unroll
    for (int j = 0; j < 8; ++j) f[j] = (short)T[(r0 + 8 * fq + j) * pitch + c0 + fr];
    return f;
#endif
    const int q = fr >> 2, p = fr & 3;
    const LAS bf16_t* a = T + (r0 + 8 * fq + q) * pitch + c0 + 4 * p;
    const s16x4 lo = __builtin_amdgcn_ds_read_tr16_b64_v4i16((LAS s16x4*)a);
    const s16x4 hi = __builtin_amdgcn_ds_read_tr16_b64_v4i16((LAS s16x4*)(a + 4 * pitch));
    return __builtin_shufflevector(lo, hi, 0, 1, 2, 3, 4, 5, 6, 7);
}
__device__ __forceinline__ bf16x8 tr_frag_cs(const LAS bf16_t* T, int pitch, int r0, int c0, int fr, int fq) {
    const int q = fr >> 2, p = fr & 3;
    const LAS bf16_t* a = T + (r0 + 8 * fq + q) * pitch + c0 + 8 * p;
    const s16x4 lo = __builtin_amdgcn_ds_read_tr16_b64_v4i16((LAS s16x4*)a);
    const s16x4 hi = __builtin_amdgcn_ds_read_tr16_b64_v4i16((LAS s16x4*)(a + 4 * pitch));
    return __builtin_shufflevector(lo, hi, 0, 1, 2, 3, 4, 5, 6, 7);
}
#define MFMA16(a, b, c) __builtin_amdgcn_mfma_f32_16x16x32_bf16((a), (b), (c), 0, 0, 0)

template <int W2> __device__ __forceinline__ void pool_window(const bf16_t* col, int tpos, f32x4& s0, f32x4& s1) {
    u32x4 d[2 * W2];
#pragma unroll
    for (int k = 0; k < 2 * W2; ++k) { const int sp = tpos - W2 + k; const int sc = ((unsigned)sp < (unsigned)SEQ) ? sp : tpos; d[k] = *(const u32x4*)(col + (size_t)sc * INW); }
#pragma unroll
    for (int k = 0; k < 2 * W2; ++k) { const int sp = tpos - W2 + k; const float m = ((unsigned)sp < (unsigned)SEQ) ? 1.0f : 0.0f; s0 = s0 + unpack_lo4(d[k]) * m; s1 = s1 + unpack_hi4(d[k]) * m; }
}
__device__ void phase_a(const Ctx& C, LAS unsigned char* lds, int layer) {
    const int tid = C.ftid(), wid = __builtin_amdgcn_readfirstlane(tid >> 6), lane = tid & 63, fr = lane & 15, fq = lane >> 4;
    LAS bf16_t* Vs = (LAS bf16_t*)lds;
    LAS bf16_t* Kf = Vs + 128 * 264;
    LAS bf16_t* Kb = Kf + 128 * 136;
    const bf16_t* Z = C.Z();
    for (int t = C.bid; t < 1024; t += C.G) {
        __syncthreads();
        if (t < 512) {
            const int c = t >> 2, h = t & 3;
            const float lgf = log2g(C.P->in[8] + layer * 8 + h), lgb = log2g(C.P->in[8] + layer * 8 + 4 + h);
            const bf16_t* zrow = Z + (size_t)(c * 128) * INW;
#pragma unroll
            for (int i = 0; i < 8; ++i) { const int idx = tid + i * 512, r = idx >> 5, v = idx & 31;
                *(LAS u32x4*)(Vs + r * 264 + v * 8) = *(const u32x4*)(zrow + (size_t)r * INW + 1536 + h * 256 + v * 8); }
#pragma unroll
            for (int i = 0; i < 4; ++i) { const int idx = tid + i * 512, r = idx >> 4, v = idx & 15;
                const u32x4 d = *(const u32x4*)(zrow + (size_t)r * INW + 1024 + h * 128 + v * 8);
                const float wf = __builtin_amdgcn_exp2f(lgf * (float)(127 - r)), wb = __builtin_amdgcn_exp2f(lgb * (float)r);
                const f32x4 a = unpack_lo4(d), b = unpack_hi4(d);
                *(LAS u32x4*)(Kf + r * 136 + v * 8) = pack8(a * wf, b * wf);
                *(LAS u32x4*)(Kb + r * 136 + v * 8) = pack8(a * wb, b * wb); }
            __syncthreads();
            const int eq = wid & 3, dh = wid >> 2;
            f32x4 acc[2][4][4];
#pragma unroll
            for (int a = 0; a < 2; ++a)
#pragma unroll
                for (int b = 0; b < 4; ++b)
#pragma unroll
                    for (int e4 = 0; e4 < 4; ++e4) acc[a][b][e4] = (f32x4){0.f, 0.f, 0.f, 0.f};
#pragma unroll 1
            for (int kk = 0; kk < 4; ++kk) {
                int fr = lane & 15, fq = lane >> 4; asm volatile("" : "+v"(fr), "+v"(fq));
                bf16x8 vf[4];
#pragma unroll
                for (int et = 0; et < 4; ++et) vf[et] = tr_frag(Vs, 264, 32 * kk, 64 * eq + 16 * et, fr, fq);
#pragma unroll
                for (int dir = 0; dir < 2; ++dir)
#pragma unroll
                    for (int dt = 0; dt < 4; ++dt) {
                        const bf16x8 kf = tr_frag_cs(dir ? Kb : Kf, 136, 32 * kk, 64 * dh + 32 * (dt >> 1) + 4 * (dt & 1), fr, fq);
#pragma unroll
                        for (int et = 0; et < 4; ++et) acc[dir][dt][et] = MFMA16(kf, vf[et], acc[dir][dt][et]);
                    }
            }
            bf16_t* KV = C.KV();
#pragma unroll
            for (int dir = 0; dir < 2; ++dir)
#pragma unroll
                for (int j = 0; j < 2; ++j)
#pragma unroll
                    for (int et = 0; et < 4; ++et) {
                        const int e = 64 * eq + 16 * et + fr, d = 64 * dh + 32 * j + 8 * fq;
                        *(u32x4*)(KV + ((size_t)(((c * 4 + h) * 2 + dir) * 256 + e)) * 128 + d) = pack8(acc[dir][2 * j][et], acc[dir][2 * j + 1][et]);
                    }
        } else {
            const int pt = t - 512, tb = pt >> 2, g = (pt >= 256) ? 3 - (pt & 3) : (pt & 3), w2 = 1 << g;
            LAS bf16_t* Ds = (LAS bf16_t*)lds;
#pragma unroll 1
            for (int i = 0; i < 4; ++i) {
                const int idx = tid + i * 512, r = idx >> 4, v = idx & 15, tpos = tb * 128 + r;
                const int lo = max(tpos - w2, 0), hi = min(tpos + w2, SEQ);
                const bf16_t* col = Z + g * 128 + v * 8;
                f32x4 s0 = (f32x4){0.f, 0.f, 0.f, 0.f}, s1 = s0;
                if (g == 3) pool_window<8>(col, tpos, s0, s1); else if (g == 2) pool_window<4>(col, tpos, s0, s1); else if (g == 1) pool_window<2>(col, tpos, s0, s1); else pool_window<1>(col, tpos, s0, s1);
                const float inv = 1.0f / (float)(hi - lo);
                const u32x4 d = *(const u32x4*)(col + (size_t)tpos * INW);
                *(LAS u32x4*)(Ds + r * 136 + v * 8) = pack8(s0 * inv - unpack_lo4(d), s1 * inv - unpack_hi4(d));
            }
            __syncthreads();
            const bf16_t* PW = C.W(layer, W_PW) + g * 128 * 128;
            f32x4 acc[8];
#pragma unroll
            for (int dt = 0; dt < 8; ++dt) acc[dt] = (f32x4){0.f, 0.f, 0.f, 0.f};
#pragma unroll 1
            for (int kk = 0; kk < 4; ++kk) {
                const bf16x8 df = *(const LAS bf16x8*)(Ds + (16 * wid + fr) * 136 + 32 * kk + 8 * fq);
#pragma unroll
                for (int dt = 0; dt < 8; ++dt) { const bf16x8 wf = *(const bf16x8*)(PW + (16 * dt + fr) * 128 + 32 * kk + 8 * fq); acc[dt] = MFMA16(wf, df, acc[dt]); }
            }
            bf16_t* PA = C.PA();
            const int row = tb * 128 + 16 * wid + fr;
#pragma unroll
            for (int dt = 0; dt < 8; ++dt) *(u32x2*)(PA + (size_t)row * 512 + g * 128 + 16 * dt + 4 * fq) = pack4(acc[dt]);
        }
    }
}
__device__ void phase_b(const Ctx& C, int layer) {
    u32x4* KV = (u32x4*)C.KV();
    const int tid = C.ftid();
    if (tid >= 128) return;
    for (int it = C.bid * 128 + tid; it < 32768; it += C.G * 128) {
        const int idx = it * 8, h = idx >> 16, dir = (idx >> 15) & 1;
        const float cd = __builtin_amdgcn_exp2f(log2g(C.P->in[8] + layer * 8 + dir * 4 + h) * 128.0f);
        u32x4* base = KV + it;
        f32x4 ra = (f32x4){0.f, 0.f, 0.f, 0.f}, rb = ra;
        const int c0 = dir ? 127 : 0, st = dir ? -1 : 1;
        for (int cc = 0; cc < 128; cc += 8) { u32x4 v[8];
#pragma unroll
            for (int i = 0; i < 8; ++i) v[i] = base[(size_t)(c0 + st * (cc + i)) * 32768];
#pragma unroll
            for (int i = 0; i < 8; ++i) { base[(size_t)(c0 + st * (cc + i)) * 32768] = pack8(ra, rb); ra = ra * cd + unpack_lo4(v[i]); rb = rb * cd + unpack_hi4(v[i]); } }
    }
}
__device__ void phase_c(const Ctx& C, LAS unsigned char* lds, int layer) {
    const int tid0 = C.ftid(), wid = __builtin_amdgcn_readfirstlane(tid0 >> 6), lane = tid0 & 63;
    LAS bf16_t* Qs = (LAS bf16_t*)lds;
    LAS bf16_t* Ps = Qs + 128 * 136;
    LAS bf16_t* Vs = Ps + 128 * 136;
    LAS float* St = (LAS float*)(Vs + 128 * 264);
    const bf16_t* Z = C.Z(); const bf16_t* KV = C.KV(); bf16_t* RG = C.RG();
    for (int t = C.bid; t < 512; t += C.G) {
        const int c = t >> 2, h = t & 3;
        const float lgf = log2g(C.P->in[8] + layer * 8 + h), lgb = log2g(C.P->in[8] + layer * 8 + 4 + h);
        const bf16_t* zrow = Z + (size_t)(c * 128) * INW;
        const int e0 = 32 * wid;
        int fr = lane & 15, fq = lane >> 4;
        asm volatile("" : "+v"(fr), "+v"(fq));
        bf16x8 sf[2][2][4];
#pragma unroll
        for (int dir = 0; dir < 2; ++dir) {
            const bf16_t* sb = KV + (size_t)(((c * 4 + h) * 2 + dir) * 256) * 128;
#pragma unroll
            for (int et = 0; et < 2; ++et)
#pragma unroll
                for (int kk = 0; kk < 4; ++kk) sf[dir][et][kk] = *(const bf16x8*)(sb + (size_t)(e0 + 16 * et + fr) * 128 + 32 * kk + 8 * fq);
        }
        __syncthreads();
        { const int tid = C.ftid();
#pragma unroll
        for (int i = 0; i < 8; ++i) { const int idx = tid + i * 512, r = idx >> 5, v = idx & 31;
            *(LAS u32x4*)(Vs + r * 264 + v * 8) = *(const u32x4*)(zrow + (size_t)r * INW + 1536 + h * 256 + v * 8); }
#pragma unroll
        for (int i = 0; i < 4; ++i) { const int idx = tid + i * 512, r = idx >> 4, v = idx & 15;
            *(LAS u32x4*)(Qs + r * 136 + v * 8) = *(const u32x4*)(zrow + (size_t)r * INW + 512 + h * 128 + v * 8);
            *(LAS u32x4*)(Ps + r * 136 + v * 8) = *(const u32x4*)(zrow + (size_t)r * INW + 1024 + h * 128 + v * 8); }
        }
        __syncthreads();
        asm volatile("" : "+v"(fr), "+v"(fq));
        f32x4 sc[8];
        {
            const int i0 = 16 * wid;
            bf16x8 qf[4];
#pragma unroll
            for (int kk = 0; kk < 4; ++kk) qf[kk] = *(const LAS bf16x8*)(Qs + (i0 + fr) * 136 + 32 * kk + 8 * fq);
#pragma unroll
            for (int jt = 0; jt < 8; ++jt) {
                f32x4 a = (f32x4){0.f, 0.f, 0.f, 0.f};
#pragma unroll
                for (int kk = 0; kk < 4; ++kk) { const bf16x8 kf = *(const LAS bf16x8*)(Ps + (16 * jt + fr) * 136 + 32 * kk + 8 * fq); a = MFMA16(kf, qf[kk], a); }
                const int i = i0 + fr;
#pragma unroll
                for (int r = 0; r < 4; ++r) { const int j = 16 * jt + 4 * fq + r, dl = i - j; a[r] *= (dl >= 0) ? __builtin_amdgcn_exp2f(lgf * (float)dl) : __builtin_amdgcn_exp2f(lgb * (float)(-dl)); }
                sc[jt] = a;
            }
        }
        __syncthreads();
        {
            const int i = 16 * wid + fr;
#pragma unroll
            for (int jt = 0; jt < 8; ++jt) *(LAS u32x2*)(Ps + i * 136 + 16 * jt + 4 * fq) = pack4(sc[jt]);
        }
        __syncthreads();
        asm volatile("" : "+v"(fr), "+v"(fq));
        f32x4 y[8][2];
#pragma unroll
        for (int m = 0; m < 8; ++m) { y[m][0] = (f32x4){0.f, 0.f, 0.f, 0.f}; y[m][1] = (f32x4){0.f, 0.f, 0.f, 0.f}; }
#pragma unroll 1
        for (int kk = 0; kk < 4; ++kk) {
            bf16x8 vf[2];
#pragma unroll
            for (int et = 0; et < 2; ++et) vf[et] = tr_frag(Vs, 264, 32 * kk, e0 + 16 * et, fr, fq);
#pragma unroll
            for (int m = 0; m < 8; ++m) { const bf16x8 pf = *(const LAS bf16x8*)(Ps + (16 * m + fr) * 136 + 32 * kk + 8 * fq);
                y[m][0] = MFMA16(vf[0], pf, y[m][0]); y[m][1] = MFMA16(vf[1], pf, y[m][1]); }
        }
#pragma unroll
        for (int dir = 0; dir < 2; ++dir) {
            asm volatile("" : "+v"(fr), "+v"(fq));
#pragma unroll
            for (int m = 0; m < 8; ++m) {
                f32x4 t0 = (f32x4){0.f, 0.f, 0.f, 0.f}, t1 = t0;
#pragma unroll
                for (int kk = 0; kk < 4; ++kk) { const bf16x8 qq = *(const LAS bf16x8*)(Qs + (16 * m + fr) * 136 + 32 * kk + 8 * fq); t0 = MFMA16(sf[dir][0][kk], qq, t0); t1 = MFMA16(sf[dir][1][kk], qq, t1); }
                const int i = 16 * m + fr;
                const float scl = (dir == 0) ? __builtin_amdgcn_exp2f(lgf * (float)(i + 1)) : __builtin_amdgcn_exp2f(lgb * (float)(128 - i));
                y[m][0] = y[m][0] + t0 * scl; y[m][1] = y[m][1] + t1 * scl;
                if (m & 1) asm volatile("" ::: "memory");
            }
        }
        asm volatile("" : "+v"(fr), "+v"(fq));
        u32x2 gsw[8][2];
#pragma unroll
        for (int m = 0; m < 8; ++m)
#pragma unroll
            for (int et = 0; et < 2; ++et) gsw[m][et] = *(const u32x2*)(zrow + (size_t)(16 * m + fr) * INW + 2560 + h * 256 + e0 + 16 * et + 4 * fq);
#pragma unroll
        for (int m = 0; m < 8; ++m) {
            const f32x4 a = y[m][0], b = y[m][1];
            float s = (a[0] + a[1]) + (a[2] + a[3]) + (b[0] + b[1]) + (b[2] + b[3]);
            float q = (a[0] * a[0] + a[1] * a[1]) + (a[2] * a[2] + a[3] * a[3]) + (b[0] * b[0] + b[1] * b[1]) + (b[2] * b[2] + b[3] * b[3]);
            { const int ln = fq * 16 + fr; s += shx(s, ln, 16); s += shx(s, ln, 32); q += shx(q, ln, 16); q += shx(q, ln, 32); }
            if (fq == 0) { St[(16 * m + fr) * 16 + wid * 2] = s; St[(16 * m + fr) * 16 + wid * 2 + 1] = q; }
        }
        __syncthreads();
#pragma unroll
        for (int m = 0; m < 8; ++m) {
            const int i = 16 * m + fr;
            const LAS f32x4* sp = (const LAS f32x4*)(St + i * 16);
            const f32x4 p0 = sp[0], p1 = sp[1], p2 = sp[2], p3 = sp[3];
            const float s = (p0[0] + p0[2]) + (p1[0] + p1[2]) + (p2[0] + p2[2]) + (p3[0] + p3[2]);
            const float q = (p0[1] + p0[3]) + (p1[1] + p1[3]) + (p2[1] + p2[3]) + (p3[1] + p3[3]);
            const float mean = s * (1.0f / 256.0f), var = fmaxf(q * (1.0f / 256.0f) - mean * mean, 0.f);
            const float rstd = __builtin_amdgcn_rsqf(var + 1e-5f);
            const size_t row = (size_t)(c * 128 + i);
#pragma unroll
            for (int et = 0; et < 2; ++et) {
                const int e = e0 + 16 * et + 4 * fq;
                *(u32x2*)(RG + row * DM + h * 256 + e) = pack4((y[m][et] - mean) * rstd * unpack4(gsw[m][et]));
            }
        }
    }
}

__device__ __forceinline__ void run_phase(const Ctx& C, LAS unsigned char* lds, int ph) {
    if (ph == 0) { phase_p0(C, lds); phase_rows(C, -1, 0); return; }
    const int q = ph - 1, s = q / 19, r = q % 19;
    if (r == 18) { phase_rows(C, s, s < 2 ? s + 1 : -1); return; }
    const int layer = r / 9, st = r % 9, cur = layer, G = C.G, bid = C.bid;
    pg8::StaticOrder S;
    switch (st) {
    case 0: { pg8::Gemm g{C.XB(cur), C.W(layer, W_IN), SEQ, INW, DM}; S.init(SEQ, INW, G, bid, 2);
              { const int t_ = C.ftid(); if ((t_ & 63) == 0) ((LAS int*)(lds + LDS_RSTAG))[t_ >> 6] = -1; }
              EpiZ E{C.Z(), C.SS(cur), C.COS(), C.SIN(), lds}; pg8::gemm_phase(C.ftid(), lds, g, S, E);
              if (s == 0 && G == 256 && bid >= 128) conv_range(C, layer, 4, 8, (bid - 128) * 512 + C.ftid(), 128 * 512); } break;
    case 1: phase_a(C, lds, layer); break;
    case 2: phase_b(C, layer); break;
    case 3: phase_c(C, lds, layer); break;
    case 4: { S.init(SEQ, DM, G, bid);
              { pg8::Gemm g{C.PA(), C.W(layer, W_PO), SEQ, DM, 512}; EpiGen<0> E{C.TMP(), nullptr, C.Z() + 3584, nullptr}; pg8::gemm_phase(C.ftid(), lds, g, S, E); }
              { pg8::Gemm g{C.RG(), C.W(layer, W_RO), SEQ, DM, DM}; EpiGen<1> E{C.MG(), C.TMP(), C.Z() + 3584 + 1024, nullptr}; pg8::gemm_phase(C.ftid(), lds, g, S, E); } } break;
    case 5: { pg8::Gemm g{C.MG(), C.W(layer, W_O), SEQ, DM, DM}; S.init(SEQ, DM, G, bid);
              if (layer == 0) { EpiResid<false, true> E{C.xin(s), nullptr, C.XB(cur ^ 1), C.SS(cur ^ 1), nullptr}; pg8::gemm_phase(C.ftid(), lds, g, S, E); }
              else { EpiResid<false, false> E{nullptr, C.XB(cur), C.XB(cur ^ 1), C.SS(cur ^ 1), nullptr}; pg8::gemm_phase(C.ftid(), lds, g, S, E); } } break;
    case 6: { pg8::Gemm g{C.XB(cur ^ 1), C.W(layer, W_FFI), SEQ, INW, DM}; S.init(SEQ, INW, G, bid);
              { const int t_ = C.ftid(); if ((t_ & 63) == 0) ((LAS int*)(lds + LDS_RSTAG))[t_ >> 6] = -1; }
              EpiSwiGLU E{C.Z(), C.SS(cur ^ 1), lds}; pg8::gemm_phase(C.ftid(), lds, g, S, E);
              if (s == 0 && layer == 0 && G == 256 && bid >= 128) conv_range(C, 1, 0, 4, (bid - 128) * 512 + C.ftid(), 128 * 512); } break;
    case 7: { pg8::Gemm g{C.Z(), C.W(layer, W_FFO), SEQ, DM, DFF}; S.init(SEQ, DM, G, bid);
              EpiResid<false, false> E{nullptr, C.XB(cur ^ 1), C.XB(cur), C.SS(cur), nullptr}; pg8::gemm_phase(C.ftid(), lds, g, S, E); } break;
    default: { S.init(SEQ, DM, G, bid);
              { pg8::Gemm g{C.XB(cur), C.W(layer, W_PG), SEQ, DM, DM}; EpiGen<2> E{C.TMP(), nullptr, nullptr, C.SS(cur)}; pg8::gemm_phase(C.ftid(), lds, g, S, E); }
              { pg8::Gemm g{C.PB(layer), C.W(layer, W_PP), SEQ, DM, PLE}; EpiResid<true, false> E{nullptr, C.XB(cur), C.XB(cur ^ 1), C.SS(cur ^ 1), C.TMP()}; pg8::gemm_phase(C.ftid(), lds, g, S, E); } } break;
    }
}


#define XB_TMO      128
#define XB_XCNT(j)  (256  + 64 * (j))
#define XB_XSUB(j)  (1280 + 64 * (j))
#define XB_XGEN(j)  (2304 + 64 * (j))
#define XB_TOP      3328
#define XB_TOPGEN   3392
#define XCD_BAR_WORDS 3456
#define XB_SPIN_CAP (1u << 18)
__device__ __forceinline__ unsigned xb_ld(unsigned* p)              { return __hip_atomic_load(p, __ATOMIC_RELAXED, __HIP_MEMORY_SCOPE_AGENT); }
__device__ __forceinline__ unsigned xb_add(unsigned* p, unsigned v) { return __hip_atomic_fetch_add(p, v, __ATOMIC_RELAXED, __HIP_MEMORY_SCOPE_AGENT); }
__device__ __forceinline__ unsigned xb_xcc_id() { return (unsigned)__builtin_amdgcn_s_getreg((3 << 11) | 20) & 0xFu; }
#define XB_SPIN(cond, bar) do { unsigned _sp = 0; while (cond) { __builtin_amdgcn_s_sleep(1); \
    if ((++_sp & 255u) == 0u) { if (xb_ld(&(bar)[XB_TMO])) break; if (_sp > XB_SPIN_CAP) { atomicAdd(&(bar)[XB_TMO], 1u); break; } } } } while (0)
struct XcdBarrier { unsigned* bar; unsigned x; volatile LAS unsigned* st; };
__device__ __forceinline__ XcdBarrier xcd_barrier_post(unsigned* bar, volatile LAS unsigned* st, bool leader) {
    XcdBarrier b; b.bar = bar; b.x = xb_xcc_id(); b.st = st;
    if (leader) (void)xb_add(&bar[XB_XCNT(b.x)], 1u);
    return b;
}
__device__ __forceinline__ void xcd_barrier_complete(unsigned* bar, unsigned x, unsigned& nloc, unsigned& nx) {
    const unsigned G = gridDim.x * gridDim.y * gridDim.z;
    unsigned sum, cnt, mine, sp = 0u;
    for (;;) {
        sum = 0u; cnt = 0u; mine = 0u;
#pragma unroll
        for (unsigned j = 0; j < 16; ++j) { const unsigned c = xb_ld(&bar[XB_XCNT(j)]); sum += c; cnt += (c > 0u) ? 1u : 0u; mine = (j == x) ? c : mine; }
        if (sum == G) break;
        __builtin_amdgcn_s_sleep(1);
        if ((++sp & 255u) == 0u) { if (xb_ld(&bar[XB_TMO])) break; if (sp > XB_SPIN_CAP) { atomicAdd(&bar[XB_TMO], 1u); break; } }
    }
    nloc = mine > 0u ? mine : 1u; nx = cnt > 0u ? cnt : 1u;
}
__device__ __forceinline__ void xcd_barrier(const XcdBarrier& b, int wv) {
    asm volatile("s_waitcnt vmcnt(0)" ::: "memory");
    __syncthreads();
    if (wv == 0 && lane_now() == 0) {
        unsigned* bar = b.bar;
        __builtin_amdgcn_s_waitcnt(0);
        unsigned nloc = b.st[0], nx = b.st[1];
        if (nloc == 0u) { xcd_barrier_complete(bar, b.x, nloc, nx); b.st[0] = nloc; b.st[1] = nx; }
        const unsigned old = xb_add(&bar[XB_XSUB(b.x)], 1u);
        const unsigned gen = old / nloc;
        if (old + 1u == (gen + 1u) * nloc) {
            __builtin_amdgcn_fence(__ATOMIC_RELEASE, "agent");
            asm volatile("s_waitcnt vmcnt(0)" ::: "memory");
            const unsigned og = xb_add(&bar[XB_TOP], 1u);
            const unsigned tg = og / nx;
            if (og + 1u == (tg + 1u) * nx) xb_add(&bar[XB_TOPGEN], 1u);
            else XB_SPIN(xb_ld(&bar[XB_TOPGEN]) == tg, bar);
            __builtin_amdgcn_fence(__ATOMIC_ACQUIRE, "agent");
            xb_add(&bar[XB_XGEN(b.x)], 1u);
            asm volatile("s_waitcnt vmcnt(0)" ::: "memory");
        } else {
            XB_SPIN(xb_ld(&bar[XB_XGEN(b.x)]) == gen, bar);
            __builtin_amdgcn_fence(__ATOMIC_ACQUIRE, "agent");
            asm volatile("s_waitcnt vmcnt(0)" ::: "memory");
        }
    }
    __syncthreads();
}

__global__ void __launch_bounds__(512, 2) mk_fwd(Params P) {
    extern __shared__ __attribute__((aligned(16))) unsigned char lds_raw[];
    LAS unsigned char* lds = (LAS unsigned char*)lds_raw;
    const int wv0 = __builtin_amdgcn_readfirstlane((int)threadIdx.x >> 6);
    const bool leader0 = (threadIdx.x == 0);
    volatile LAS unsigned* bst = (volatile LAS unsigned*)(lds + LDS_BYTES - 16);
    XcdBarrier bar; bar.bar = (unsigned*)(P.ws + WS_END); bar.x = 0; bar.st = bst;
    if (P.ph_hi - P.ph_lo > 1) {
        if (leader0) { bst[0] = 0u; bst[1] = 0u; }
        __syncthreads();
        bar = xcd_barrier_post((unsigned*)(P.ws + WS_END), bst, leader0);
    }
    for (int ph = P.ph_lo; ph < P.ph_hi; ++ph) {
        int wv = wv0, bid = blockIdx.x, G = gridDim.x;
        asm volatile("" : "+s"(wv), "+s"(bid), "+s"(G));
        KPtr pp = (KPtr)__builtin_amdgcn_kernarg_segment_ptr();
        asm volatile("" : "+s"(pp));
        Ctx C{pp, pp->out, pp->ws, wv, bid, G};
        run_phase(C, lds, ph);
#if REP_MASK
        { int cls; if (ph == 0) cls = 10; else { const int r = (ph - 1) % 19; cls = (r == 18) ? 9 : (r % 9); }
          if ((REP_MASK >> cls) & 1) { __syncthreads(); run_phase(C, lds, ph); } }
#endif
        if (ph + 1 < P.ph_hi) { if (ph == P.ph_lo) cg::this_grid().sync(); else xcd_barrier(bar, wv0); }
    }
}

extern "C" void kernel_launch(void* const* d_in, const int* in_sizes, int n_in, void* d_out, int out_size, void* d_ws, size_t ws_size, hipStream_t stream) {
    static int grid = 0;
    if (grid == 0) {
        if (n_in != 19 || ws_size < WS_END + XCD_BAR_WORDS * 4) { fprintf(stderr, "kernel_launch: unexpected n_in %d / ws %zu (need %zu)\n", n_in, ws_size, (size_t)WS_END); grid = -1; return; }
        int dev = 0, cus = 0, per_cu = 0;
        hipGetDevice(&dev); hipDeviceGetAttribute(&cus, hipDeviceAttributeMultiprocessorCount, dev);
        hipFuncSetAttribute((const void*)mk_fwd, hipFuncAttributeMaxDynamicSharedMemorySize, LDS_BYTES);
        hipOccupancyMaxActiveBlocksPerMultiprocessor(&per_cu, (const void*)mk_fwd, 512, LDS_BYTES);
        if (per_cu < 1) per_cu = 1;
        (void)hipGetLastError();
        grid = cus * per_cu;
    }
    if (grid < 0) return;
    if (hipMemsetAsync((char*)d_ws + WS_END, 0, XCD_BAR_WORDS * 4, stream) != hipSuccess) { fprintf(stderr, "kernel_launch: memset of barrier words failed\n"); return; }
    Params p{};
    for (int i = 0; i < 19; ++i) p.in[i] = (const float*)d_in[i];
    p.out = (float*)d_out; p.ws = (unsigned char*)d_ws;
#if MULTI_LAUNCH
    for (int ph = 0; ph < NPH; ++ph) { p.ph_lo = ph; p.ph_hi = ph + 1; hipLaunchKernelGGL(mk_fwd, dim3(grid), dim3(512), LDS_BYTES, stream, p); }
#else
    p.ph_lo = 0; p.ph_hi = NPH;
    void* args[] = {&p};
    hipError_t e = hipLaunchCooperativeKernel((const void*)mk_fwd, dim3(grid), dim3(512), args, LDS_BYTES, stream);
    if (e != hipSuccess) fprintf(stderr, "cooperative launch failed: %s (grid %d)\n", hipGetErrorString(e), grid);
#endif
}
```
